# Optimizing an MI355X kernel written in HIP

```python
import numpy as np
import jax
import jax.numpy as jnp
from jax import lax

D_MODEL = 4096
BATCH = 1
SEQ = 16384
DEPTH = 2

GRID_W = 64
CTX_LEN = 256
EPS = 1e-6
ROPE_BASE = 10000.0
NEG = -1e30
BLOCK = 128

W_GROUP = D_MODEL // 4
D_MIX = 4 * W_GROUP

LRU_W = W_GROUP
LRU_BLOCKS = 8
LRU_BS = LRU_W // LRU_BLOCKS
LRU_CONV = 4
LRU_C = 8.0

SWA_HEADS = 8
SWA_KV_HEADS = 2
SWA_HD = W_GROUP // SWA_HEADS
SWA_WINDOW = 128

MLA_HEADS = 8
MLA_NOPE = 128
MLA_ROPE = 64
MLA_V = W_GROUP // MLA_HEADS
MLA_Q_RANK = 768
MLA_KV_RANK = 256

ML_HEADS = 8
ML_HD = W_GROUP // ML_HEADS
ML_CHUNK = 128

IN_SIZES = (LRU_W, LRU_W,
            SWA_HEADS * SWA_HD, SWA_KV_HEADS * SWA_HD, SWA_KV_HEADS * SWA_HD, W_GROUP,
            MLA_Q_RANK, MLA_KV_RANK, MLA_ROPE, W_GROUP,
            W_GROUP, W_GROUP, W_GROUP, W_GROUP, 4 * ML_HEADS, W_GROUP)
N_IN = sum(IN_SIZES)

kernel_name = 'hybrid_group_diffusion_block'


def rms_norm(x, g):
    xf = x.astype(jnp.float32)
    y = xf * lax.rsqrt(jnp.mean(xf * xf, axis=-1, keepdims=True) + EPS)
    return (y * g.astype(jnp.float32)).astype(x.dtype)


def split_cols(p):
    return jnp.split(p, np.cumsum(IN_SIZES)[:-1].tolist(), axis=-1)


def grid_positions(n_tok):
    rows = n_tok // GRID_W
    row = jnp.repeat(jnp.arange(rows, dtype=jnp.int32), GRID_W)
    col = jnp.tile(jnp.arange(GRID_W, dtype=jnp.int32), rows)
    return row, col


def rope_1d(x, pos):
    half = x.shape[-1] // 2
    freqs = jnp.power(ROPE_BASE, -jnp.arange(half, dtype=jnp.float32) / half)
    ang = pos.astype(jnp.float32)[:, None] * freqs[None, :]
    cos, sin = jnp.cos(ang), jnp.sin(ang)
    xf = x.astype(jnp.float32)
    x1, x2 = xf[..., :half], xf[..., half:]
    return jnp.concatenate([x1 * cos - x2 * sin, x2 * cos + x1 * sin], axis=-1).astype(x.dtype)


def rope_2d(x, row, col):
    h = x.shape[-1] // 2
    return jnp.concatenate([rope_1d(x[..., :h], row), rope_1d(x[..., h:], col)], axis=-1)


def centred_conv(x, w, b):
    k_w = w.shape[0]
    left = k_w // 2
    right = k_w - 1 - left
    t = x.shape[1]
    xp = jnp.pad(x, ((0, 0), (left, right), (0, 0)))
    out = b
    for j in range(k_w):
        out = out + xp[:, j:j + t, :] * w[j]
    return out


def block_diag(u, w, b):
    bsz, t, _ = u.shape
    ub = u.reshape(bsz, t, LRU_BLOCKS, LRU_BS)
    y = jnp.einsum('btnk,nkj->btnj', ub, w.astype(jnp.float32)).reshape(bsz, t, LRU_W)
    return y + b.astype(jnp.float32)


def rglru_coeffs(u, lam, wa, ba, wx, bx):
    r = jax.nn.sigmoid(block_diag(u, wa, ba))
    i = jax.nn.sigmoid(block_diag(u, wx, bx))
    log_a = -LRU_C * r * jax.nn.softplus(-lam.astype(jnp.float32))
    a = jnp.exp(log_a)
    return a, jnp.sqrt(-jnp.expm1(2.0 * log_a)) * (i * u)


def linear_scan(a, b, h0, reverse):
    idx = -1 if reverse else 0
    b = b.at[:, idx].add(a[:, idx] * h0)

    def combine(left, right):
        a_l, b_l = left
        a_r, b_r = right
        return a_l * a_r, a_r * b_l + b_r

    return lax.associative_scan(combine, (a, b), reverse=reverse, axis=1)[1]


def rglru_mixer(u, uc, conv_w, conv_b, lam, wa, ba, wx, bx, need_ctx):
    u = centred_conv(u, conv_w, conv_b).astype(jnp.float32)
    uc = centred_conv(uc, conv_w, conv_b).astype(jnp.float32)
    zero = jnp.zeros((u.shape[0], LRU_W), jnp.float32)
    ys, ycs = [], []
    for d in range(2):
        rev = d == 1
        a_c, b_c = rglru_coeffs(uc, lam[d], wa[d], ba[d], wx[d], bx[d])
        h_c = linear_scan(a_c, b_c, zero, rev)
        h0 = h_c[:, 0] if rev else h_c[:, -1]
        a, b = rglru_coeffs(u, lam[d], wa[d], ba[d], wx[d], bx[d])
        ys.append(linear_scan(a, b, h0, rev))
        ycs.append(h_c)
    y = ys[0] + ys[1]
    yc = ycs[0] + ycs[1] if need_ctx else None
    return y, yc


def swa_mixer(q, k, v, qc, kc, vc, sink, row, col, need_ctx):
    bsz, s, _ = q.shape
    grp = SWA_HEADS // SWA_KV_HEADS
    nblk = s // BLOCK
    scale = SWA_HD ** -0.5

    def heads_q(t):
        return t.reshape(bsz, t.shape[1], SWA_KV_HEADS, grp, SWA_HD).transpose(0, 2, 3, 1, 4)

    def heads_kv(t):
        return t.reshape(bsz, t.shape[1], SWA_KV_HEADS, SWA_HD).transpose(0, 2, 1, 3)

    ql = rope_2d(heads_q(q), row, col)
    kl = rope_2d(heads_kv(k), row, col)
    vl = heads_kv(v)
    kcx, vcx = heads_kv(kc), heads_kv(vc)
    n_ctx = kcx.shape[2]
    sink_l = sink.reshape(SWA_KV_HEADS, grp).astype(jnp.float32)

    def band(t):
        tp = jnp.pad(t, ((0, 0), (0, 0), (BLOCK, BLOCK), (0, 0)))
        tb = tp.reshape(bsz, SWA_KV_HEADS, nblk + 2, BLOCK, SWA_HD)
        return jnp.concatenate([tb[:, :, :-2], tb[:, :, 1:-1], tb[:, :, 2:]], axis=3)

    kw, vw = band(kl), band(vl)
    qb = ql.reshape(bsz, SWA_KV_HEADS, grp, nblk, BLOCK, SWA_HD)
    qi = jnp.arange(nblk)[:, None] * BLOCK + jnp.arange(BLOCK)[None, :]
    kj = (jnp.arange(nblk)[:, None] - 1) * BLOCK + jnp.arange(3 * BLOCK)[None, :]
    valid = ((jnp.abs(qi[:, :, None] - kj[:, None, :]) <= SWA_WINDOW)
             & (kj[:, None, :] >= 0) & (kj[:, None, :] < s))
    s_loc = jnp.einsum('bkgnqd,bkntd->bkgnqt', qb, kw).astype(jnp.float32) * scale
    s_loc = jnp.where(valid, s_loc, NEG)
    s_ctx = jnp.einsum('bkgnqd,bkcd->bkgnqc', qb, kcx).astype(jnp.float32) * scale
    s_sink = jnp.broadcast_to(sink_l[None, :, :, None, None, None], s_ctx.shape[:-1] + (1,))
    p = jax.nn.softmax(jnp.concatenate([s_loc, s_ctx, s_sink], axis=-1), axis=-1).astype(vl.dtype)
    t3 = 3 * BLOCK
    o = (jnp.einsum('bkgnqt,bkntd->bkgnqd', p[..., :t3], vw)
         + jnp.einsum('bkgnqc,bkcd->bkgnqd', p[..., t3:t3 + n_ctx], vcx))
    y = o.reshape(bsz, SWA_KV_HEADS, grp, s, SWA_HD).transpose(0, 3, 1, 2, 4).reshape(bsz, s, SWA_HEADS * SWA_HD)
    yc = None
    if need_ctx:
        qcx = heads_q(qc)
        sc = jnp.einsum('bkgqd,bkcd->bkgqc', qcx, kcx).astype(jnp.float32) * scale
        sc_sink = jnp.broadcast_to(sink_l[None, :, :, None, None], sc.shape[:-1] + (1,))
        pc = jax.nn.softmax(jnp.concatenate([sc, sc_sink], axis=-1), axis=-1).astype(vcx.dtype)
        oc = jnp.einsum('bkgqc,bkcd->bkgqd', pc[..., :n_ctx], vcx)
        yc = oc.transpose(0, 3, 1, 2, 4).reshape(bsz, n_ctx, SWA_HEADS * SWA_HD)
    return y, yc


def mla_mixer(cq, ckv, kr, cqc, ckvc, krc, q_norm, w_uq, kv_norm, w_ukv, row, col, need_ctx):
    bsz, s, _ = cq.shape
    nh = MLA_HEADS
    scale = (MLA_NOPE + MLA_ROPE) ** -0.5

    def q_heads(c_):
        t = c_.shape[1]
        qf = (rms_norm(c_, q_norm) @ w_uq).reshape(bsz, t, nh, MLA_NOPE + MLA_ROPE).transpose(0, 2, 1, 3)
        return qf[..., :MLA_NOPE], qf[..., MLA_NOPE:]

    def kv_heads(c_):
        t = c_.shape[1]
        kv = (rms_norm(c_, kv_norm) @ w_ukv).reshape(bsz, t, nh, MLA_NOPE + MLA_V).transpose(0, 2, 1, 3)
        return kv[..., :MLA_NOPE], kv[..., MLA_NOPE:]

    qn, qr = q_heads(cq)
    qr = rope_2d(qr, row, col)
    kn, vl = kv_heads(ckv)
    krl = rope_2d(kr, row, col)
    knc, vcx = kv_heads(ckvc)
    k_nope = jnp.concatenate([kn, knc], axis=2)
    v_all = jnp.concatenate([vl, vcx], axis=2)
    k_rope = jnp.concatenate([krl, krc], axis=1)

    def attend(blk):
        qn_b, qr_b = blk
        sc = (jnp.einsum('bhqd,bhkd->bhqk', qn_b, k_nope)
              + jnp.einsum('bhqd,bkd->bhqk', qr_b, k_rope)).astype(jnp.float32) * scale
        p = jax.nn.softmax(sc, axis=-1).astype(v_all.dtype)
        return jnp.einsum('bhqk,bhkd->bhqd', p, v_all)

    nblk = s // BLOCK

    def to_blocks(t):
        return t.reshape(bsz, nh, nblk, BLOCK, t.shape[-1]).transpose(2, 0, 1, 3, 4)

    o = lax.map(attend, (to_blocks(qn), to_blocks(qr)))
    y = o.transpose(1, 0, 3, 2, 4).reshape(bsz, s, nh * MLA_V)
    yc = None
    if need_ctx:
        qnc, qrc = q_heads(cqc)
        sc = (jnp.einsum('bhqd,bhkd->bhqk', qnc, knc)
              + jnp.einsum('bhqd,bkd->bhqk', qrc, krc)).astype(jnp.float32) * scale
        pc = jax.nn.softmax(sc, axis=-1).astype(vcx.dtype)
        oc = jnp.einsum('bhqk,bhkd->bhqd', pc, vcx)
        yc = oc.transpose(0, 2, 1, 3).reshape(bsz, oc.shape[2], nh * MLA_V)
    return y, yc


def mlstm_chunked(q, k, v, ig, lf, state):
    c0, n0, m0 = state
    bsz, nh, t, d = q.shape
    nc = t // ML_CHUNK

    def chunks(z):
        return z.reshape((bsz, nh, nc, ML_CHUNK) + z.shape[3:])

    qc, kc, vc, igc, lfc = chunks(q), chunks(k), chunks(v), chunks(ig), chunks(lf)
    b = jnp.cumsum(lfc, axis=-1)
    g = b[..., -1]
    w_log = g[..., None] - b + igc
    m_loc = jnp.max(w_log, axis=-1)
    w = jnp.exp(w_log - m_loc[..., None])
    c_loc = jnp.einsum('bhnl,bhnld,bhnle->bhnde', w, kc, vc)
    n_loc = jnp.einsum('bhnl,bhnld->bhnd', w, kc)

    def step(carry, inp):
        c_, n_, m_ = carry
        g_, m_l, c_l, n_l = inp
        m_new = jnp.maximum(g_ + m_, m_l)
        a = jnp.exp(g_ + m_ - m_new)
        e = jnp.exp(m_l - m_new)
        new = (a[..., None, None] * c_ + e[..., None, None] * c_l,
               a[..., None] * n_ + e[..., None] * n_l, m_new)
        return new, carry

    xs = tuple(jnp.moveaxis(z, 2, 0) for z in (g, m_loc, c_loc, n_loc))
    final, (c_in, n_in, m_in) = lax.scan(step, (c0, n0, m0), xs)
    c_in = jnp.moveaxis(c_in, 0, 2)
    n_in = jnp.moveaxis(n_in, 0, 2)
    m_in = jnp.moveaxis(m_in, 0, 2)
    tri = jnp.tril(jnp.ones((ML_CHUNK, ML_CHUNK), dtype=bool))
    dmat = jnp.where(tri, b[..., :, None] - b[..., None, :] + igc[..., None, :], NEG)
    inter = b + m_in[..., None]
    m_j = jnp.maximum(inter, jnp.max(dmat, axis=-1))
    p = jnp.exp(dmat - m_j[..., None]) * jnp.einsum('bhnjd,bhnsd->bhnjs', qc, kc)
    e = jnp.exp(inter - m_j)
    num = e[..., None] * jnp.einsum('bhnjd,bhnde->bhnje', qc, c_in) + jnp.einsum('bhnjs,bhnse->bhnje', p, vc)
    den = e * jnp.einsum('bhnjd,bhnd->bhnj', qc, n_in) + jnp.sum(p, axis=-1)
    h = num / jnp.maximum(jnp.abs(den), jnp.exp(-m_j))[..., None]
    return h.reshape(bsz, nh, t, d), final


def mlstm_mixer(q, k, v, o, g, qc, kc, vc, oc, gc, gate_b, head_norm, need_ctx):
    bsz = q.shape[0]
    k_scale = ML_HD ** -0.5

    def heads(t):
        return t.reshape(bsz, t.shape[1], ML_HEADS, ML_HD).transpose(0, 2, 1, 3).astype(jnp.float32)

    def gate_pre(gg):
        t = gg.shape[1]
        z = (gg.astype(jnp.float32).reshape(bsz, t, 4, ML_HEADS) + gate_b.astype(jnp.float32)).transpose(2, 0, 3, 1)
        return z[0], jax.nn.log_sigmoid(z[1]), z[2], jax.nn.log_sigmoid(z[3])

    def flip(t):
        return jnp.flip(t, axis=2)

    lat = (heads(q), heads(k) * k_scale, heads(v))
    con = (heads(qc), heads(kc) * k_scale, heads(vc))
    ig_f, lf_f, ig_b, lf_b = gate_pre(g)
    igc_f, lfc_f, igc_b, lfc_b = gate_pre(gc)
    zero_state = (jnp.zeros((bsz, ML_HEADS, ML_HD, ML_HD), jnp.float32),
                  jnp.zeros((bsz, ML_HEADS, ML_HD), jnp.float32),
                  jnp.zeros((bsz, ML_HEADS), jnp.float32))
    hc_f, st_f = mlstm_chunked(con[0], con[1], con[2], igc_f, lfc_f, zero_state)
    h_f, _ = mlstm_chunked(lat[0], lat[1], lat[2], ig_f, lf_f, st_f)
    hc_b, st_b = mlstm_chunked(flip(con[0]), flip(con[1]), flip(con[2]), flip(igc_b), flip(lfc_b), zero_state)
    h_b, _ = mlstm_chunked(flip(lat[0]), flip(lat[1]), flip(lat[2]), flip(ig_b), flip(lf_b), st_b)

    def finish(h, o_):
        t = h.shape[2]
        hn = rms_norm(h, head_norm.reshape(ML_HEADS, 1, ML_HD))
        hn = hn.transpose(0, 2, 1, 3).reshape(bsz, t, W_GROUP)
        return (jax.nn.sigmoid(o_.astype(jnp.float32)) * hn).astype(o_.dtype)

    y = finish(h_f + flip(h_b), o)
    yc = finish(hc_f + flip(hc_b), oc) if need_ctx else None
    return y, yc


def gated_concat(ys, gates):
    return jnp.concatenate([y.astype(gt.dtype) * jax.nn.silu(gt) for y, gt in zip(ys, gates)], axis=-1)


def setup_inputs(seed: int = 0) -> dict:
    key = jax.random.key(seed)
    ks = jax.random.split(key, 28)
    f32 = jnp.float32

    def nrm(k, shape, scale):
        return jax.random.normal(k, shape, f32) * scale

    x = nrm(ks[0], (BATCH, SEQ, D_MODEL), 1.0)
    c = nrm(ks[1], (BATCH, D_MODEL), 1.0)
    ctx = nrm(ks[2], (BATCH, CTX_LEN, D_MODEL), 1.0)
    c_ctx = nrm(ks[3], (D_MODEL,), 1.0)
    w_mod = nrm(ks[4], (DEPTH, D_MODEL, 3 * D_MODEL), 0.5 * D_MODEL ** -0.5)
    b_mod = nrm(ks[5], (DEPTH, 3 * D_MODEL), 0.02)
    g_pre = 1.0 + nrm(ks[6], (DEPTH, D_MODEL), 0.02)
    g_post = 1.0 + nrm(ks[7], (DEPTH, D_MODEL), 0.02)
    w_in = nrm(ks[8], (DEPTH, D_MODEL, N_IN), D_MODEL ** -0.5)
    w_out = nrm(ks[9], (DEPTH, D_MIX, D_MODEL), D_MIX ** -0.5)
    lru_conv_w = nrm(ks[10], (DEPTH, LRU_CONV, LRU_W), LRU_CONV ** -0.5)
    lru_conv_b = nrm(ks[11], (DEPTH, LRU_W), 0.02)
    u = jax.random.uniform(ks[12], (DEPTH, 2, LRU_W), f32, 0.9, 0.999)
    a0 = u ** (1.0 / LRU_C)
    lru_lambda = jnp.log(a0) - jnp.log1p(-a0)
    lru_wa = nrm(ks[13], (DEPTH, 2, LRU_BLOCKS, LRU_BS, LRU_BS), LRU_BS ** -0.5)
    lru_ba = nrm(ks[14], (DEPTH, 2, LRU_W), 0.02)
    lru_wx = nrm(ks[15], (DEPTH, 2, LRU_BLOCKS, LRU_BS, LRU_BS), LRU_BS ** -0.5)
    lru_bx = nrm(ks[16], (DEPTH, 2, LRU_W), 0.02)
    swa_sink = nrm(ks[17], (DEPTH, SWA_HEADS), 0.5)
    mla_q_norm = 1.0 + nrm(ks[18], (DEPTH, MLA_Q_RANK), 0.02)
    mla_w_uq = nrm(ks[19], (DEPTH, MLA_Q_RANK, MLA_HEADS * (MLA_NOPE + MLA_ROPE)), MLA_Q_RANK ** -0.5)
    mla_kv_norm = 1.0 + nrm(ks[20], (DEPTH, MLA_KV_RANK), 0.02)
    mla_w_ukv = nrm(ks[21], (DEPTH, MLA_KV_RANK, MLA_HEADS * (MLA_NOPE + MLA_V)), MLA_KV_RANK ** -0.5)
    ig_f = nrm(ks[22], (DEPTH, ML_HEADS), 0.1)
    fg_f = jax.random.uniform(ks[23], (DEPTH, ML_HEADS), f32, 3.0, 6.0)
    ig_b = nrm(ks[24], (DEPTH, ML_HEADS), 0.1)
    fg_b = jax.random.uniform(ks[25], (DEPTH, ML_HEADS), f32, 3.0, 6.0)
    ml_gate_b = jnp.stack([ig_f, fg_f, ig_b, fg_b], axis=1)
    ml_head_norm = 1.0 + nrm(ks[26], (DEPTH, W_GROUP), 0.02)
    return {'x': x, 'c': c, 'ctx': ctx, 'c_ctx': c_ctx, 'w_mod': w_mod, 'b_mod': b_mod,
            'g_pre': g_pre, 'g_post': g_post, 'w_in': w_in, 'w_out': w_out,
            'lru_conv_w': lru_conv_w, 'lru_conv_b': lru_conv_b, 'lru_lambda': lru_lambda,
            'lru_wa': lru_wa, 'lru_ba': lru_ba, 'lru_wx': lru_wx, 'lru_bx': lru_bx,
            'swa_sink': swa_sink, 'mla_q_norm': mla_q_norm, 'mla_w_uq': mla_w_uq,
            'mla_kv_norm': mla_kv_norm, 'mla_w_ukv': mla_w_ukv,
            'ml_gate_b': ml_gate_b, 'ml_head_norm': ml_head_norm}


def reference(x, c, ctx, c_ctx, w_mod, b_mod, g_pre, g_post, w_in, w_out,
              lru_conv_w, lru_conv_b, lru_lambda, lru_wa, lru_ba, lru_wx, lru_bx,
              swa_sink, mla_q_norm, mla_w_uq, mla_kv_norm, mla_w_ukv,
              ml_gate_b, ml_head_norm):
    row, col = grid_positions(x.shape[1])
    xc = ctx
    for l in range(DEPTH):
        need_ctx = l < DEPTH - 1
        mod = jax.nn.silu(c) @ w_mod[l] + b_mod[l]
        mod_c = jax.nn.silu(c_ctx) @ w_mod[l] + b_mod[l]
        shift, scale, gate = jnp.split(mod[:, None, :], 3, axis=-1)
        shift_c, scale_c, gate_c = jnp.split(mod_c, 3, axis=-1)
        h = rms_norm(x, g_pre[l]) * (1.0 + scale) + shift
        hc = rms_norm(xc, g_pre[l]) * (1.0 + scale_c) + shift_c
        p = split_cols(h @ w_in[l])
        pc = split_cols(hc @ w_in[l])
        y_a, yc_a = rglru_mixer(p[0], pc[0], lru_conv_w[l], lru_conv_b[l], lru_lambda[l],
                                lru_wa[l], lru_ba[l], lru_wx[l], lru_bx[l], need_ctx)
        y_b, yc_b = swa_mixer(p[2], p[3], p[4], pc[2], pc[3], pc[4], swa_sink[l], row, col, need_ctx)
        y_c, yc_c = mla_mixer(p[6], p[7], p[8], pc[6], pc[7], pc[8], mla_q_norm[l], mla_w_uq[l],
                              mla_kv_norm[l], mla_w_ukv[l], row, col, need_ctx)
        y_d, yc_d = mlstm_mixer(p[10], p[11], p[12], p[13], p[14], pc[10], pc[11], pc[12], pc[13], pc[14],
                                ml_gate_b[l], ml_head_norm[l], need_ctx)
        y = gated_concat((y_a, y_b, y_c, y_d), (p[1], p[5], p[9], p[15]))
        x = x + gate * rms_norm(y @ w_out[l], g_post[l])
        if need_ctx:
            yc = gated_concat((yc_a, yc_b, yc_c, yc_d), (pc[1], pc[5], pc[9], pc[15]))
            xc = xc + gate_c * rms_norm(yc @ w_out[l], g_post[l])
    return x
```

```cpp
#include <hip/hip_runtime.h>
#include <cstdio>
#include <cstdint>
#include <cmath>

#define LAS __attribute__((address_space(3)))
typedef unsigned short bf16_t;
typedef short bf16x8 __attribute__((ext_vector_type(8)));
typedef short s16x4 __attribute__((ext_vector_type(4)));
typedef float f32x2 __attribute__((ext_vector_type(2)));
typedef float f32x4 __attribute__((ext_vector_type(4)));
typedef float f32x16 __attribute__((ext_vector_type(16)));
typedef unsigned u32x2 __attribute__((ext_vector_type(2)));
typedef unsigned u32x4 __attribute__((ext_vector_type(4)));
typedef unsigned int u32x4v __attribute__((__vector_size__(16)));

constexpr int DM = 4096, SEQ = 16384, CTX = 256, T = SEQ + CTX  , DEPTH = 2;
constexpr int NIN = 11872;
constexpr int PW = 11776;
constexpr int NPAD = 12032;
constexpr int NCH = T / 128;
constexpr int S_LRU_U = 0, S_LRU_G = 1024, S_SWA_Q = 2048, S_SWA_K = 3072, S_SWA_V = 3328, S_SWA_G = 3584, S_CQ = 4608, S_CKV = 5376,
              S_MLA_G = 5632, S_ML_Q = 6656, S_ML_K = 7680, S_ML_V = 8704, S_ML_O = 9728, S_ML_G = 10752, S_MISC = 11776;
constexpr int O_LRU_U = 0, O_LRU_G = 1024, O_SWA_Q = 2048, O_SWA_K = 3072, O_SWA_V = 3328, O_SWA_G = 3584, O_CQ = 4608, O_CKV = 5376, O_KR = 5632,
              O_MLA_G = 5696, O_ML_Q = 6720, O_ML_K = 7744, O_ML_V = 8768, O_ML_O = 9792, O_ML_GT = 10816, O_ML_G = 10848;
constexpr float EPS = 1e-6f;

constexpr size_t al256(size_t x) { return (x + 255) / 256 * 256; }
constexpr size_t WS_CTL = 0;
constexpr size_t CTL_BYTES = 65536;
constexpr size_t WS_MOD = WS_CTL + CTL_BYTES;
constexpr size_t WS_TAB16 = WS_MOD + al256((size_t)2 * 2 * 12288 * 4);
constexpr size_t WS_TAB32 = WS_TAB16 + 256 * 16 * 2 * 4;
constexpr size_t WS_WIN = WS_TAB32 + 256 * 32 * 2 * 4;
constexpr size_t WS_WOUT = WS_WIN + (size_t)2 * NPAD * DM * 2;
constexpr size_t WS_WUQ = WS_WOUT + (size_t)2 * DM * DM * 2;
constexpr size_t WS_WUKV = WS_WUQ + (size_t)2 * 1536 * 768 * 2;
constexpr size_t WS_LRUW = WS_WUKV + (size_t)2 * 2048 * 256 * 2;
constexpr size_t WS_H = WS_LRUW + (size_t)2 * 2 * 2 * 8 * 128 * 128 * 2;
constexpr size_t WS_P = WS_H + (size_t)T * DM * 2;
constexpr size_t WS_KR = WS_P + (size_t)T * PW * 2;
constexpr size_t WS_G = WS_KR + (size_t)T * 64 * 2;
constexpr size_t WS_ST1 = WS_G + (size_t)T * 32 * 4;
constexpr size_t WS_QM = WS_ST1 + (size_t)T * 16 * 4;
constexpr int LDKV = 2112;
constexpr size_t WS_KV = WS_QM + (size_t)T * 1536 * 2;
constexpr size_t WS_Y = WS_KV + (size_t)T * LDKV * 2;
constexpr size_t WS_Z = WS_Y + (size_t)T * DM * 2;
constexpr size_t WS_ST2 = WS_Z + (size_t)T * DM * 2;
constexpr size_t WS_XC = WS_ST2 + (size_t)T * 64 * 4;
constexpr size_t WS_LSUM = WS_XC + (size_t)CTX * DM * 4;
constexpr size_t WS_LCAR = WS_LSUM + (size_t)NCH * 2 * 2 * 1024 * 4;
constexpr size_t WS_CLOC = WS_LCAR + (size_t)NCH * 2 * 1024 * 4;
constexpr size_t WS_NLOC = WS_CLOC + (size_t)NCH * 16 * 16384 * 4;
constexpr size_t WS_GM = WS_NLOC + (size_t)NCH * 16 * 128 * 4;
constexpr size_t WS_CIN = WS_GM + al256((size_t)NCH * 16 * 2 * 4);
constexpr size_t WS_NIN = WS_CIN + (size_t)NCH * 16 * 16384 * 2;
constexpr size_t WS_MIN = WS_NIN + (size_t)NCH * 16 * 128 * 4;
constexpr size_t WS_END = WS_MIN + al256((size_t)NCH * 16 * 4);

__device__ __forceinline__ unsigned cvt_pk_bf16(float lo, float hi) { unsigned r; asm volatile("v_cvt_pk_bf16_f32 %0, %1, %2" : "=v"(r) : "v"(lo), "v"(hi)); return r; }
__device__ __forceinline__ bf16_t f2bf(float x) { return (bf16_t)(cvt_pk_bf16(x, x) & 0xffffu); }
__device__ __forceinline__ float bf2f(bf16_t u) { return __uint_as_float(((unsigned)u) << 16); }
__device__ __forceinline__ float bflo(unsigned w) { return __uint_as_float(w << 16); }
__device__ __forceinline__ float bfhi(unsigned w) { return __uint_as_float(w & 0xffff0000u); }
__device__ __forceinline__ float sigmoidf_(float x) { return __builtin_amdgcn_rcpf(1.f + __expf(-x)); }
__device__ __forceinline__ float siluf_(float x) { return x * __builtin_amdgcn_rcpf(1.f + __expf(-x)); }
__device__ __forceinline__ float log_sigmoidf_(float x) { return fminf(x, 0.f) - log1pf(__expf(-fabsf(x))); }
__device__ __forceinline__ float softplusf_(float x) { return fmaxf(x, 0.f) + log1pf(__expf(-fabsf(x))); }

#define XB_TMO      128
#define XB_XCNT(j)  (256  + 64 * (j))
#define XB_XSUB(j)  (1280 + 64 * (j))
#define XB_XGEN(j)  (2304 + 64 * (j))
#define XB_TOP      3328
#define XB_TOPGEN   3392
#define XCD_BAR_WORDS 3456
#define XB_SPIN_CAP (1u << 24)
__device__ __forceinline__ unsigned xb_ld(unsigned* p)              { return __hip_atomic_load(p, __ATOMIC_RELAXED, __HIP_MEMORY_SCOPE_AGENT); }
__device__ __forceinline__ unsigned xb_add(unsigned* p, unsigned v) { return __hip_atomic_fetch_add(p, v, __ATOMIC_RELAXED, __HIP_MEMORY_SCOPE_AGENT); }
__device__ __forceinline__ unsigned xb_xcc_id() { return (unsigned)__builtin_amdgcn_s_getreg((3 << 11) | 20) & 0xFu; }
#define XB_SPIN(cond, bar) do { unsigned _sp = 0; while (cond) { __builtin_amdgcn_s_sleep(1); \
    if ((++_sp & 255u) == 0u) { if (xb_ld(&(bar)[XB_TMO])) break; if (_sp > XB_SPIN_CAP) { atomicAdd(&(bar)[XB_TMO], 1u); break; } } } } while (0)
struct XcdBarrier { unsigned* bar; unsigned x; volatile LAS unsigned* st; };
__device__ __forceinline__ XcdBarrier xcd_barrier_post(unsigned* bar, volatile LAS unsigned* st) {
    XcdBarrier b; b.bar = bar; b.x = xb_xcc_id(); b.st = st;
    if (threadIdx.x == 0) (void)xb_add(&bar[XB_XCNT(b.x)], 1u);
    return b;
}
__device__ __forceinline__ void xcd_barrier_complete(unsigned* bar, unsigned x, unsigned& nloc, unsigned& nx) {
    const unsigned G = gridDim.x * gridDim.y * gridDim.z;
    unsigned sum, cnt, mine, sp = 0u;
    for (;;) {
        sum = 0u; cnt = 0u; mine = 0u;
#pragma unroll
        for (unsigned j = 0; j < 16; ++j) { const unsigned c = xb_ld(&bar[XB_XCNT(j)]); sum += c; cnt += (c > 0u) ? 1u : 0u; mine = (j == x) ? c : mine; }
        if (sum == G) break;
        __builtin_amdgcn_s_sleep(1);
        if ((++sp & 255u) == 0u) { if (xb_ld(&bar[XB_TMO])) break; if (sp > XB_SPIN_CAP) { atomicAdd(&bar[XB_TMO], 1u); break; } }
    }
    nloc = mine > 0u ? mine : 1u; nx = cnt > 0u ? cnt : 1u;
}
__device__ __forceinline__ void xcd_barrier(const XcdBarrier& b) {
    asm volatile("s_waitcnt vmcnt(0)" ::: "memory");
    __syncthreads();
    if (threadIdx.x == 0) {
        unsigned* bar = b.bar;
        __builtin_amdgcn_s_waitcnt(0);
        unsigned nloc = b.st[0], nx = b.st[1];
        if (nloc == 0u) { xcd_barrier_complete(bar, b.x, nloc, nx); b.st[0] = nloc; b.st[1] = nx; }
        const unsigned old = xb_add(&bar[XB_XSUB(b.x)], 1u);
        const unsigned gen = old / nloc;
        if (old + 1u == (gen + 1u) * nloc) {
            __builtin_amdgcn_fence(__ATOMIC_RELEASE, "agent");
            asm volatile("s_waitcnt vmcnt(0)" ::: "memory");
            const unsigned og = xb_add(&bar[XB_TOP], 1u);
            const unsigned tg = og / nx;
            if (og + 1u == (tg + 1u) * nx) xb_add(&bar[XB_TOPGEN], 1u);
            else XB_SPIN(xb_ld(&bar[XB_TOPGEN]) == tg, bar);
            __builtin_amdgcn_fence(__ATOMIC_ACQUIRE, "agent");
            xb_add(&bar[XB_XGEN(b.x)], 1u);
            asm volatile("s_waitcnt vmcnt(0)" ::: "memory");
        } else {
            XB_SPIN(xb_ld(&bar[XB_XGEN(b.x)]) == gen, bar);
            __builtin_amdgcn_fence(__ATOMIC_ACQUIRE, "agent");
            asm volatile("s_waitcnt vmcnt(0)" ::: "memory");
        }
    }
    __syncthreads();
}

namespace pg8 {
constexpr int BM = 256, BK = 64, HALF = 128, HTB = HALF * BK * 2, STAGE_BYTES = 8 * HTB, NXCD = 8, WGM = 8;
__host__ __device__ __forceinline__ int lds_byte(int r, int c) { const int st = (r >> 4) * 2 + (c >> 5), rr = r & 15, cc = c & 31, ob = rr * 64 + cc * 2; return st * 1024 + (ob ^ (((ob >> 9) & 1) << 5)); }
__host__ __device__ __forceinline__ void stage_rc(int b, int& R, int& C) { const int st = b / 1024, sb = b % 1024, swz = sb ^ (((sb >> 9) & 1) << 5); R = (st >> 1) * 16 + swz / 64; C = (st & 1) * 32 + (swz % 64) / 2; }
__host__ __device__ __forceinline__ int perm32(int rho) { const int n = rho >> 4, i = rho & 15; return 8 * (i >> 2) + 4 * n + (i & 3); }
struct Unit { int pm, pn; };
struct Gemm { const bf16_t* A; const bf16_t* Bt; int M, N, K, lda, ldb; };
struct StaticOrder {
    int nM, nN, nwg, G, c;
    __host__ __device__ void init(int M, int N, int G_, int c_) { nM = M / BM; nN = N / BM; nwg = nM * nN; G = G_; c = c_; }
    __host__ __device__ bool next(int i, Unit& u) const {
        const long L = (long)i * G + c; if (L >= nwg) return false;
        int wgid = (int)L; { const int q = nwg / NXCD, r = nwg % NXCD, xcd = wgid % NXCD, off = wgid / NXCD; wgid = (xcd < r ? xcd * (q + 1) : r * (q + 1) + (xcd - r) * q) + off; }
        const int nig = WGM * nN, gid = wgid / nig, fm = gid * WGM, gsz = (nM - fm) < WGM ? (nM - fm) : WGM;
        u.pm = fm + ((wgid % nig) % gsz); u.pn = (wgid % nig) / gsz; return true;
    }
};
template <class Epi>
__device__ __forceinline__ void gemm_phase(LAS unsigned char* lds, const Gemm g, const StaticOrder& S, const Epi& E, const int tid) {
    const int wid = __builtin_amdgcn_readfirstlane(tid >> 6), lane = tid & 63, wr = wid >> 2, wc = wid & 3, fr = lane & 15, fq = lane >> 4;
    const int K = g.K, nt = K / BK;
    unsigned voffA[2], voffB[2], voffB1[2];
#pragma unroll
    for (int i = 0; i < 2; ++i) { int R, C; stage_rc(tid * 16 + i * 8192, R, C); const int Rb = 64 * (R >> 5) + perm32(R & 31);
        voffA[i] = (unsigned)(R * g.lda + C) * 2u; voffB[i] = (unsigned)(Rb * g.ldb + C) * 2u; voffB1[i] = (unsigned)((Rb + 32) * g.ldb + C) * 2u; }
    const size_t kstep = (size_t)(BK * 2);
    const size_t hstepA = (size_t)HALF * g.lda * 2, hstepB = (size_t)HALF * g.ldb * 2;
    const size_t tstepA = 2 * hstepA, tstepB = 2 * hstepB;
    const unsigned ldsw = (unsigned)wid * 1024u;
    const int aoff = lds_byte(wr * 64 + fr, fq * 8), boff = lds_byte(wc * 32 + fr, fq * 8);
#define PG8_SA(b, h) (((b) * 2 + (h)) * HTB)
#define PG8_SB(b, h) ((4 + (b) * 2 + (h)) * HTB)
#define PG8_STAGE(bufoff, gbase, voff) do { _Pragma("unroll") for (int _i = 0; _i < 2; ++_i) \
        __builtin_amdgcn_global_load_lds((const unsigned*)((const char*)(gbase) + (voff)[_i]), (LAS unsigned*)(lds + (bufoff) + ldsw + _i * 8192), 16, 0, 0); } while (0)
#define PG8_LDA(dst, b, h) do { _Pragma("unroll") for (int m = 0; m < 4; ++m) _Pragma("unroll") for (int k = 0; k < 2; ++k) dst[m][k] = *(const LAS bf16x8*)(lds + PG8_SA(b, h) + aoff + m * 2048 + k * 1024); } while (0)
#define PG8_LDB(dst, b, h) do { _Pragma("unroll") for (int n = 0; n < 2; ++n) _Pragma("unroll") for (int k = 0; k < 2; ++k) dst[n][k] = *(const LAS bf16x8*)(lds + PG8_SB(b, h) + boff + n * 2048 + k * 1024); } while (0)
#define PG8_MMA(ai, bj, At, Bt) do { __builtin_amdgcn_s_setprio(1); _Pragma("unroll") for (int m = 0; m < 4; ++m) _Pragma("unroll") for (int n = 0; n < 2; ++n) _Pragma("unroll") for (int k = 0; k < 2; ++k) \
        acc[ai][bj][m][n] = __builtin_amdgcn_mfma_f32_16x16x32_bf16(Bt[n][k], At[m][k], acc[ai][bj][m][n], 0, 0, 0); __builtin_amdgcn_s_setprio(0); } while (0)
#define PG8_WAIT_V(n) asm volatile("s_waitcnt vmcnt(" #n ")" ::: "memory")
#define PG8_WAIT_L(n) asm volatile("s_waitcnt lgkmcnt(" #n ")" ::: "memory")
#define PG8_BAR __builtin_amdgcn_s_barrier()
#define PG8_SCHED __builtin_amdgcn_sched_barrier(0)
    Unit cur, nxt; int ui = 0;
    if (!S.next(0, cur)) return;
    f32x4 acc[2][2][4][2];
#pragma unroll
    for (int a = 0; a < 2; ++a)
#pragma unroll
        for (int b = 0; b < 2; ++b)
#pragma unroll
            for (int m = 0; m < 4; ++m)
#pragma unroll
                for (int n = 0; n < 2; ++n) acc[a][b][m][n] = (f32x4){0.f, 0.f, 0.f, 0.f};
    bf16x8 At[4][2], B0[2][2], B1[2][2];
    const char* cA = (const char*)g.A + (size_t)cur.pm * tstepA; const char* cB = (const char*)g.Bt + (size_t)cur.pn * tstepB;
    PG8_STAGE(PG8_SB(0, 0), cB, voffB); PG8_STAGE(PG8_SA(0, 0), cA, voffA); PG8_STAGE(PG8_SB(0, 1), cB, voffB1); PG8_STAGE(PG8_SA(0, 1), cA + hstepA, voffA);
    if (wr == 1) PG8_BAR;
    PG8_WAIT_V(4); PG8_BAR;
    PG8_STAGE(PG8_SB(1, 0), cB + kstep, voffB); PG8_STAGE(PG8_SA(1, 0), cA + kstep, voffA); PG8_STAGE(PG8_SB(1, 1), cB + kstep, voffB1);
    PG8_WAIT_V(6); PG8_BAR;
    for (;;) {
        const bool has_next = S.next(ui + 1, nxt);
        const char* nA = has_next ? (const char*)g.A + (size_t)nxt.pm * tstepA : cA; const char* nB = has_next ? (const char*)g.Bt + (size_t)nxt.pn * tstepB : cB;
#pragma unroll 1
        for (int t = 0; t < nt; t += 2) {
            const bool last = (t == nt - 2);
            const char* a1 = cA + (size_t)(t + 1) * kstep;
            const char* a2 = last ? nA : cA + (size_t)(t + 2) * kstep; const char* b2 = last ? nB : cB + (size_t)(t + 2) * kstep;
            const char* a3 = a2 + kstep; const char* b3 = b2 + kstep;
            PG8_LDB(B0, 0, 0); PG8_SCHED; PG8_LDA(At, 0, 0); PG8_STAGE(PG8_SA(1, 1), a1 + hstepA, voffA);
            PG8_WAIT_L(8); PG8_BAR; PG8_WAIT_L(0); PG8_MMA(0, 0, At, B0); PG8_BAR; PG8_SCHED;
            PG8_LDB(B1, 0, 1); PG8_STAGE(PG8_SB(0, 0), b2, voffB);
            PG8_BAR; PG8_WAIT_L(0); PG8_MMA(0, 1, At, B1); PG8_BAR;
            PG8_LDA(At, 0, 1); PG8_STAGE(PG8_SA(0, 0), a2, voffA);
            PG8_BAR; PG8_WAIT_L(0); PG8_MMA(1, 0, At, B0); PG8_BAR; PG8_SCHED;
            PG8_STAGE(PG8_SB(0, 1), b2, voffB1);
            PG8_WAIT_V(6); PG8_BAR; PG8_MMA(1, 1, At, B1); PG8_BAR;
            PG8_LDB(B0, 1, 0); PG8_SCHED; PG8_LDA(At, 1, 0); PG8_STAGE(PG8_SA(0, 1), a2 + hstepA, voffA);
            PG8_WAIT_L(8); PG8_BAR; PG8_WAIT_L(0); PG8_MMA(0, 0, At, B0); PG8_BAR; PG8_SCHED;
            PG8_LDB(B1, 1, 1); PG8_STAGE(PG8_SB(1, 0), b3, voffB);
            PG8_BAR; PG8_WAIT_L(0); PG8_MMA(0, 1, At, B1); PG8_BAR;
            PG8_LDA(At, 1, 1); PG8_STAGE(PG8_SA(1, 0), a3, voffA);
            PG8_BAR; PG8_WAIT_L(0); PG8_MMA(1, 0, At, B0); PG8_BAR; PG8_SCHED;
            PG8_STAGE(PG8_SB(1, 1), b3, voffB1);
            PG8_WAIT_V(6); PG8_BAR; PG8_MMA(1, 1, At, B1); PG8_BAR;
        }
        E(acc, cur, wr, wc, fr, fq);
        if (!has_next) break;
#pragma unroll
        for (int a = 0; a < 2; ++a)
#pragma unroll
            for (int b = 0; b < 2; ++b)
#pragma unroll
                for (int m = 0; m < 4; ++m)
#pragma unroll
                    for (int n = 0; n < 2; ++n) acc[a][b][m][n] = (f32x4){0.f, 0.f, 0.f, 0.f};
        cur = nxt; cA = nA; cB = nB; ++ui;
    }
    PG8_WAIT_V(0);
    if (wr == 0) PG8_BAR;
    PG8_BAR;
#undef PG8_SA
#undef PG8_SB
#undef PG8_STAGE
#undef PG8_LDA
#undef PG8_LDB
#undef PG8_MMA
#undef PG8_WAIT_V
#undef PG8_WAIT_L
#undef PG8_BAR
#undef PG8_SCHED
}
}

constexpr int NTHR = 512, NWAVE = 8;
constexpr int LDS_MISC = 0;
constexpr int LDS_RING = 512;
constexpr int LDS_BYTES = 155648;
constexpr int RING_BYTES = LDS_BYTES - LDS_RING;

#ifndef REPMASK
#define REPMASK 0
#endif
#define REP(b) _Pragma("unroll 1") for (int rep_ = 0; rep_ < 1 + ((REPMASK >> (b)) & 1); ++rep_)
struct Args {
    const float* in[24]; float* out; unsigned char* ws;
    int ph_lo, ph_hi;
};
struct Frame {
    LAS unsigned char* lds; unsigned char* ws; int tid, lane, wave, G, bid;
    const float *x, *c, *ctx, *c_ctx, *w_mod, *b_mod, *g_pre, *g_post, *w_in, *w_out, *conv_w, *conv_b, *lam, *wa, *ba, *wx, *bx, *sink, *q_norm, *w_uq, *kv_norm, *w_ukv, *gate_b, *head_norm;
    float* out;
};
constexpr int LDS_PTRS = 64;
__device__ __forceinline__ const float* lds_ptr(LAS unsigned char* lds, int k) {
    const LAS unsigned* p = (const LAS unsigned*)(lds + LDS_PTRS) + 2 * k;
    const unsigned lo = __builtin_amdgcn_readfirstlane(p[0]), hi = __builtin_amdgcn_readfirstlane(p[1]);
    typedef __attribute__((address_space(1))) const float gcf_t;
    return (const float*)(gcf_t*)(((unsigned long long)hi << 32) | lo);
}
__device__ __forceinline__ bool ph_in(LAS unsigned char* lds, int k) {
    const int lo = __builtin_amdgcn_readfirstlane(((const LAS int*)(lds + LDS_MISC))[8]), hi = __builtin_amdgcn_readfirstlane(((const LAS int*)(lds + LDS_MISC))[9]);
    return lo <= k && k < hi;
}
__device__ __forceinline__ void grid_barrier(LAS unsigned char* lds) {
    XcdBarrier b; b.bar = (unsigned*)((unsigned char*)lds_ptr(lds, 25) + WS_CTL); b.x = xb_xcc_id(); b.st = (volatile LAS unsigned*)(lds + LDS_MISC);
    xcd_barrier(b);
}
__device__ __forceinline__ Frame load_frame(LAS unsigned char* lds, const int wave0) {
    Frame F; F.lds = lds;
    unsigned z0 = 0u; asm volatile("" : "+v"(z0));
    int t = wave0 * 64 + (int)__builtin_amdgcn_mbcnt_hi(~0u, __builtin_amdgcn_mbcnt_lo(~0u, z0)); asm volatile("" : "+v"(t));
    F.tid = t; F.lane = t & 63; F.wave = wave0; F.G = gridDim.x; F.bid = blockIdx.x;
    F.x = lds_ptr(lds, 0); F.c = lds_ptr(lds, 1); F.ctx = lds_ptr(lds, 2); F.c_ctx = lds_ptr(lds, 3); F.w_mod = lds_ptr(lds, 4); F.b_mod = lds_ptr(lds, 5); F.g_pre = lds_ptr(lds, 6); F.g_post = lds_ptr(lds, 7);
    F.w_in = lds_ptr(lds, 8); F.w_out = lds_ptr(lds, 9); F.conv_w = lds_ptr(lds, 10); F.conv_b = lds_ptr(lds, 11); F.lam = lds_ptr(lds, 12); F.wa = lds_ptr(lds, 13); F.ba = lds_ptr(lds, 14); F.wx = lds_ptr(lds, 15);
    F.bx = lds_ptr(lds, 16); F.sink = lds_ptr(lds, 17); F.q_norm = lds_ptr(lds, 18); F.w_uq = lds_ptr(lds, 19); F.kv_norm = lds_ptr(lds, 20); F.w_ukv = lds_ptr(lds, 21); F.gate_b = lds_ptr(lds, 22); F.head_norm = lds_ptr(lds, 23);
    F.out = (float*)lds_ptr(lds, 24); F.ws = (unsigned char*)lds_ptr(lds, 25);
    return F;
}
#define WSP(T_, off) ((T_*)(F.ws + (off)))

__device__ __forceinline__ void rope4(f32x4& x1, f32x4& x2, const float* tp) {
    const f32x4 a = *(const f32x4*)tp, b = *(const f32x4*)(tp + 4);
    const float c0 = a[0], s0 = a[1], c1 = a[2], s1 = a[3], c2 = b[0], s2 = b[1], c3 = b[2], s3 = b[3];
    f32x4 o1, o2;
    o1[0] = x1[0] * c0 - x2[0] * s0; o2[0] = x2[0] * c0 + x1[0] * s0;
    o1[1] = x1[1] * c1 - x2[1] * s1; o2[1] = x2[1] * c1 + x1[1] * s1;
    o1[2] = x1[2] * c2 - x2[2] * s2; o2[2] = x2[2] * c2 + x1[2] * s2;
    o1[3] = x1[3] * c3 - x2[3] * s3; o2[3] = x2[3] * c3 + x1[3] * s3;
    x1 = o1; x2 = o2;
}
__device__ __forceinline__ u32x4 pack8(const f32x4& v0, const f32x4& v1) {
    u32x4 w; w.x = cvt_pk_bf16(v0[0], v0[1]); w.y = cvt_pk_bf16(v0[2], v0[3]); w.z = cvt_pk_bf16(v1[0], v1[1]); w.w = cvt_pk_bf16(v1[2], v1[3]); return w;
}
__device__ __forceinline__ float dot4(const f32x4& v) { return v[0] * v[0] + v[1] * v[1] + v[2] * v[2] + v[3] * v[3]; }

struct EpiIn {
    static constexpr bool PERM = true;
    bf16_t* P; bf16_t* KR; float* G; float* ST1; const float* tab16; const float* tab32; const float* gate_b;
    __device__ __forceinline__ void operator()(const f32x4 (&acc)[2][2][4][2], const pg8::Unit& u, int wr, int wc, int fr, int fq) const {
        const int pn = u.pn, rowb = u.pm * 256 + wr * 64 + fr;
        if (pn < 46) {
            const bool rope = (pn >= 8 && pn <= 12) && (u.pm >= 1);
            const bool stat = (pn >= 18 && pn <= 21);
#pragma unroll
            for (int ai = 0; ai < 2; ++ai)
#pragma unroll
                for (int m = 0; m < 4; ++m) {
                    const int row = rowb + ai * 128 + m * 16, t = row - 256, trow = t >> 6, tcol = t & 63;
                    float ss = 0.f;
#pragma unroll
                    for (int bj = 0; bj < 2; ++bj) {
                        f32x4 v0 = acc[ai][bj][m][0], v1 = acc[ai][bj][m][1];
                        if (rope) { const int g = (2 * wc + bj) & 3, pos = (g < 2) ? trow : tcol; rope4(v0, v1, tab32 + (pos * 32 + 16 * (g & 1) + 4 * fq) * 2); }
                        if (stat) ss += dot4(v0) + dot4(v1);
                        *(u32x4*)(P + (size_t)row * PW + pn * 256 + wc * 64 + bj * 32 + 8 * fq) = pack8(v0, v1);
                    }
                    if (stat) { ss += __shfl_xor(ss, 16); ss += __shfl_xor(ss, 32); if (fq == 0) ST1[(size_t)row * 16 + (pn - 18) * 4 + wc] = ss; }
                }
        } else {
#pragma unroll
            for (int ai = 0; ai < 2; ++ai)
#pragma unroll
                for (int m = 0; m < 4; ++m) {
                    const int row = rowb + ai * 128 + m * 16, t = row - 256, trow = t >> 6, tcol = t & 63;
                    if (wc == 0) {
#pragma unroll
                        for (int bj = 0; bj < 2; ++bj) { f32x4 v0 = acc[ai][bj][m][0], v1 = acc[ai][bj][m][1];
                            if (u.pm >= 1) { const int pos = (bj == 0) ? trow : tcol; rope4(v0, v1, tab16 + (pos * 16 + 4 * fq) * 2); }
                            *(u32x4*)(KR + (size_t)row * LDKV + 2048 + 32 * bj + 8 * fq) = pack8(v0, v1); }
                    } else if (wc == 1) {
                        const f32x4 v0 = acc[ai][0][m][0], v1 = acc[ai][0][m][1];
                        const f32x4 b0 = *(const f32x4*)(gate_b + 8 * fq), b1 = *(const f32x4*)(gate_b + 8 * fq + 4);
                        *(f32x4*)(G + (size_t)row * 32 + 8 * fq) = v0 + b0; *(f32x4*)(G + (size_t)row * 32 + 8 * fq + 4) = v1 + b1;
                    }
                }
        }
    }
};
struct EpiUq {
    static constexpr bool PERM = true;
    bf16_t* QM; const float* ST1; const float* tab16;
    __device__ __forceinline__ void operator()(const f32x4 (&acc)[2][2][4][2], const pg8::Unit& u, int wr, int wc, int fr, int fq) const {
        const int pn = u.pn, rowb = u.pm * 256 + wr * 64 + fr;
#pragma unroll
        for (int ai = 0; ai < 2; ++ai)
#pragma unroll
            for (int m = 0; m < 4; ++m) {
                const int row = rowb + ai * 128 + m * 16, t = row - 256, trow = t >> 6, tcol = t & 63;
                const f32x4 s0 = *(const f32x4*)(ST1 + (size_t)row * 16), s1 = *(const f32x4*)(ST1 + (size_t)row * 16 + 4), s2 = *(const f32x4*)(ST1 + (size_t)row * 16 + 8);
                const float ssum = (s0[0] + s0[1] + s0[2] + s0[3]) + (s1[0] + s1[1] + s1[2] + s1[3]) + (s2[0] + s2[1] + s2[2] + s2[3]);
                const float rstd = rsqrtf(ssum * (1.f / 768.f) + EPS) * (0.07216878364870322f * 1.4426950408889634f);
#pragma unroll
                for (int bj = 0; bj < 2; ++bj) {
                    f32x4 v0 = acc[ai][bj][m][0] * rstd, v1 = acc[ai][bj][m][1] * rstd;
                    const int gi = 8 * pn + 2 * wc + bj, seg = gi % 6;
                    if (seg >= 4 && u.pm >= 1) { const int pos = (seg == 4) ? trow : tcol; rope4(v0, v1, tab16 + (pos * 16 + 4 * fq) * 2); }
                    *(u32x4*)(QM + (size_t)row * 1536 + pn * 256 + wc * 64 + bj * 32 + 8 * fq) = pack8(v0, v1);
                }
            }
    }
};
struct EpiUkv {
    static constexpr bool PERM = true;
    bf16_t* KV; const float* ST1;
    __device__ __forceinline__ void operator()(const f32x4 (&acc)[2][2][4][2], const pg8::Unit& u, int wr, int wc, int fr, int fq) const {
        const int pn = u.pn, rowb = u.pm * 256 + wr * 64 + fr;
#pragma unroll
        for (int ai = 0; ai < 2; ++ai)
#pragma unroll
            for (int m = 0; m < 4; ++m) {
                const int row = rowb + ai * 128 + m * 16;
                const f32x4 s0 = *(const f32x4*)(ST1 + (size_t)row * 16 + 12);
                const float rstd = rsqrtf((s0[0] + s0[1] + s0[2] + s0[3]) * (1.f / 256.f) + EPS);
#pragma unroll
                for (int bj = 0; bj < 2; ++bj) {
                    const f32x4 v0 = acc[ai][bj][m][0] * rstd, v1 = acc[ai][bj][m][1] * rstd;
                    *(u32x4*)(KV + (size_t)row * LDKV + pn * 256 + wc * 64 + bj * 32 + 8 * fq) = pack8(v0, v1);
                }
            }
    }
};
struct EpiOut {
    static constexpr bool PERM = true;
    bf16_t* Z; float* ST2; int row0;
    __device__ __forceinline__ void operator()(const f32x4 (&acc)[2][2][4][2], const pg8::Unit& u, int wr, int wc, int fr, int fq) const {
        const int pn = u.pn, rowb = row0 + u.pm * 256 + wr * 64 + fr;
#pragma unroll
        for (int ai = 0; ai < 2; ++ai)
#pragma unroll
            for (int m = 0; m < 4; ++m) {
                const int row = rowb + ai * 128 + m * 16;
                float ss = 0.f;
#pragma unroll
                for (int bj = 0; bj < 2; ++bj) {
                    const f32x4 v0 = acc[ai][bj][m][0], v1 = acc[ai][bj][m][1];
                    ss += dot4(v0) + dot4(v1);
                    *(u32x4*)(Z + (size_t)row * DM + pn * 256 + wc * 64 + bj * 32 + 8 * fq) = pack8(v0, v1);
                }
                ss += __shfl_xor(ss, 16); ss += __shfl_xor(ss, 32);
                if (fq == 0) ST2[(size_t)row * 64 + pn * 4 + wc] = ss;
            }
    }
};

__device__ __forceinline__ int swa_perm(int sh) { const int g = sh >> 5, fq = (sh >> 3) & 3, n = (sh >> 2) & 1, j = sh & 3; return 64 * (g >> 1) + 32 * n + 16 * (g & 1) + 4 * fq + j; }
__device__ __forceinline__ int rope64_perm(int s) { const int g = s >> 5, fq = (s >> 3) & 3, n = (s >> 2) & 1, j = s & 3; return 32 * g + 16 * n + 4 * fq + j; }
struct CmWin {
    __device__ __forceinline__ int operator()(int s, float& sc) const {
        if (s < S_SWA_Q) return s;
        if (s < S_SWA_K) { const int x = s - S_SWA_Q; sc = 0.08838834764831845f * 1.4426950408889634f; return O_SWA_Q + (x & ~127) + swa_perm(x & 127); }
        if (s < S_SWA_V) { const int x = s - S_SWA_K; return O_SWA_K + (x & ~127) + swa_perm(x & 127); }
        if (s < S_MLA_G) return s;
        if (s < S_ML_Q) return O_MLA_G + (s - S_MLA_G);
        if (s < S_ML_K) return O_ML_Q + (s - S_ML_Q);
        if (s < S_ML_V) { sc = 0.08838834764831845f; return O_ML_K + (s - S_ML_K); }
        if (s < S_ML_O) return O_ML_V + (s - S_ML_V);
        if (s < S_ML_G) return O_ML_O + (s - S_ML_O);
        if (s < S_MISC) return O_ML_G + (s - S_ML_G);
        const int x = s - S_MISC;
        if (x < 64) return O_KR + rope64_perm(x);
        if (x < 96) return O_ML_GT + (x - 64);
        return -1;
    }
};
struct CmId { __device__ __forceinline__ int operator()(int s, float&) const { return s; } };
struct CmUq { __device__ __forceinline__ int operator()(int s, float&) const { const int h = s / 192, x = s - h * 192; return x < 128 ? s : h * 192 + 128 + rope64_perm(x - 128); } };

template <int KT, class CM>
__device__ __forceinline__ void transpose_item(const Frame& F, const float* __restrict__ src, int ld_src, int K, bf16_t* __restrict__ dst, const float* __restrict__ rowscale, const CM& cm, int s0, int k0) {
    constexpr int PW_ = KT / 2 + 1, NJ = KT / 64;
    LAS unsigned* tile = (LAS unsigned*)(F.lds + LDS_RING);
    const int q = F.tid & 15, kp = F.tid >> 4;
    float sc = 1.f; const int col = cm(s0 + 4 * q, sc);
    f32x4 v0[NJ], v1[NJ];
#pragma unroll
    for (int j = 0; j < NJ; ++j) { v0[j] = (f32x4){0.f, 0.f, 0.f, 0.f}; v1[j] = v0[j]; }
    if (col >= 0) {
#pragma unroll
        for (int j = 0; j < NJ; ++j) { const int k = k0 + 2 * (kp + 32 * j);
            v0[j] = __builtin_nontemporal_load((const f32x4*)(src + (size_t)k * ld_src + col)); v1[j] = __builtin_nontemporal_load((const f32x4*)(src + (size_t)(k + 1) * ld_src + col)); }
#pragma unroll
        for (int j = 0; j < NJ; ++j) { const int k = k0 + 2 * (kp + 32 * j); float r0 = sc, r1 = sc; if (rowscale) { r0 *= rowscale[k]; r1 *= rowscale[k + 1]; } v0[j] *= r0; v1[j] *= r1; }
    }
#pragma unroll
    for (int j = 0; j < NJ; ++j)
#pragma unroll
        for (int e = 0; e < 4; ++e) tile[(4 * q + e) * PW_ + kp + 32 * j] = cvt_pk_bf16(v0[j][e], v1[j][e]);
    __syncthreads();
    const int sr = F.tid >> 3, c8 = F.tid & 7;
#pragma unroll
    for (int j = 0; j < NJ; ++j) { const int kc = (c8 + 8 * j) * 4;
        u32x4 w; w.x = tile[sr * PW_ + kc]; w.y = tile[sr * PW_ + kc + 1]; w.z = tile[sr * PW_ + kc + 2]; w.w = tile[sr * PW_ + kc + 3];
        *(u32x4*)(dst + (size_t)(s0 + sr) * K + k0 + 2 * kc) = w; }
    __syncthreads();
}

__device__ __forceinline__ void mod_item(const Frame& F, int item) {
    const int l = item / 384, r = item % 384, kh = r / 192, n0 = (r % 192) * 64;
    LAS float* sc = (LAS float*)(F.lds + LDS_RING); LAS float* red = sc + 4096;
    for (int i = F.tid; i < 2048; i += NTHR) { sc[i] = siluf_(F.c[kh * 2048 + i]); sc[2048 + i] = siluf_(F.c_ctx[kh * 2048 + i]); }
    __syncthreads();
    const int cq = F.lane & 15, kl = (F.lane >> 4) + 4 * F.wave;
    f32x4 a0 = {0.f, 0.f, 0.f, 0.f}, a1 = {0.f, 0.f, 0.f, 0.f};
    const float* wp = F.w_mod + ((size_t)l * DM + kh * 2048) * 12288 + n0 + 4 * cq;
#pragma unroll 8
    for (int i = 0; i < 64; ++i) { const int k = kl + 32 * i; const f32x4 w = __builtin_nontemporal_load((const f32x4*)(wp + (size_t)k * 12288)); a0 += w * sc[k]; a1 += w * sc[2048 + k]; }
#pragma unroll
    for (int j = 0; j < 4; ++j) { red[(kl * 64 + 4 * cq + j) * 2] = a0[j]; red[(kl * 64 + 4 * cq + j) * 2 + 1] = a1[j]; }
    __syncthreads();
    if (F.tid < 128) { const int col = F.tid & 63, v = F.tid >> 6; float s_ = 0.f;
        for (int k2 = 0; k2 < 32; ++k2) s_ += red[(k2 * 64 + col) * 2 + v];
        if (kh == 0) s_ += F.b_mod[l * 12288 + n0 + col];
        atomicAdd(WSP(float, WS_MOD) + (size_t)(l * 2 + v) * 12288 + n0 + col, s_); }
    __syncthreads();
}

__device__ __forceinline__ void rope_tables(const Frame& F) {
    if (F.tid < 48) {
        const bool is32 = F.tid >= 16; const int i = is32 ? F.tid - 16 : F.tid, half = is32 ? 32 : 16;
        const double r = is32 ? 0.7498942093324558 : 0.5623413251903491;
        double f = 1.0; for (int q = 0; q < i; ++q) f *= r;
        double cb = 1.0, sb = f, term_c = 1.0, term_s = f; const double f2 = f * f;
        for (int q = 1; q < 14; ++q) { term_c *= -f2 / (double)((2 * q - 1) * (2 * q)); term_s *= -f2 / (double)((2 * q) * (2 * q + 1)); cb += term_c; sb += term_s; }
        float* tab = is32 ? WSP(float, WS_TAB32) : WSP(float, WS_TAB16);
        double c = 1.0, s = 0.0;
        for (int pos = 0; pos < 256; ++pos) { tab[(pos * half + i) * 2] = (float)c; tab[(pos * half + i) * 2 + 1] = (float)s; const double c2 = c * cb - s * sb; s = s * cb + c * sb; c = c2; }
    }
}

constexpr int NB_WIN = 188 * 16, NB_WOUT = 64 * 16, NB_L = NB_WIN + NB_WOUT, NB_ALL = 2 * NB_L;
struct TDesc { const float* sp; bf16_t* dp; int ld; float sc; bool ok; };
__device__ __forceinline__ TDesc big_item(const Frame& F, int it, int q, int kp) {
    TDesc d; const int l = it / NB_L; int r = it - l * NB_L; d.sc = 1.f;
    if (r < NB_WIN) { const int s0 = (r >> 4) * 64, k0 = (r & 15) * 256; const int col = CmWin()(s0 + 4 * q, d.sc); d.ok = col >= 0; d.ld = NIN;
        d.sp = F.w_in + (size_t)l * DM * NIN + (size_t)(k0 + 2 * kp) * NIN + (col >= 0 ? col : 0); d.dp = WSP(bf16_t, WS_WIN) + (size_t)l * NPAD * DM + (size_t)s0 * DM + k0; }
    else { r -= NB_WIN; const int s0 = (r >> 4) * 64, k0 = (r & 15) * 256; d.ok = true; d.ld = DM;
        d.sp = F.w_out + (size_t)l * DM * DM + (size_t)(k0 + 2 * kp) * DM + s0 + 4 * q; d.dp = WSP(bf16_t, WS_WOUT) + (size_t)l * DM * DM + (size_t)s0 * DM + k0; }
    return d;
}
#define TLOAD(D, V0, V1) do { _Pragma("unroll") for (int j = 0; j < 4; ++j) { if ((D).ok) { V0[j] = __builtin_nontemporal_load((const f32x4*)((D).sp + (size_t)(64 * j) * (D).ld)); \
        V1[j] = __builtin_nontemporal_load((const f32x4*)((D).sp + (size_t)(64 * j + 1) * (D).ld)); } else { V0[j] = (f32x4){0.f, 0.f, 0.f, 0.f}; V1[j] = V0[j]; } } } while (0)
#define TSTEP(D, V0, V1, ITN) do { \
        _Pragma("unroll") for (int j = 0; j < 4; ++j) _Pragma("unroll") for (int e = 0; e < 4; ++e) tile[(4 * q + e) * 129 + kp + 32 * j] = cvt_pk_bf16(V0[j][e] * (D).sc, V1[j][e] * (D).sc); \
        __syncthreads(); \
        bf16_t* dp_ = (D).dp; const int itn_ = (ITN); \
        if (itn_ < NB_ALL) { (D) = big_item(F, itn_, q, kp); TLOAD(D, V0, V1); }       \
        _Pragma("unroll") for (int j = 0; j < 4; ++j) { const int kc = (c8 + 8 * j) * 4; \
            u32x4 w; w.x = tile[sr * 129 + kc]; w.y = tile[sr * 129 + kc + 1]; w.z = tile[sr * 129 + kc + 2]; w.w = tile[sr * 129 + kc + 3]; \
            *(u32x4*)(dp_ + (size_t)sr * DM + 2 * kc) = w; } \
        __syncthreads(); } while (0)
__device__ __forceinline__ void big_transposes(const Frame& F) {
    LAS unsigned* tile = (LAS unsigned*)(F.lds + LDS_RING);
    const int q = F.tid & 15, kp = F.tid >> 4, sr = F.tid >> 3, c8 = F.tid & 7;
    int it = F.bid; if (it >= NB_ALL) return;
    TDesc da = big_item(F, it, q, kp), db = da; f32x4 a0[4], a1[4], b0[4], b1[4];
    TLOAD(da, a0, a1);
    const bool hasb = it + F.G < NB_ALL;
    if (hasb) { db = big_item(F, it + F.G, q, kp); TLOAD(db, b0, b1); }
    for (; it < NB_ALL; it += 2 * F.G) {
        TSTEP(da, a0, a1, it + 2 * F.G);
        if (it + F.G < NB_ALL) TSTEP(db, b0, b1, it + 3 * F.G);
    }
}
#undef TLOAD
#undef TSTEP

__device__ __forceinline__ void p0_prologue(const Frame& F) {
    if (F.bid == 0) rope_tables(F);
    for (int it = F.bid; it < 768; it += F.G) mod_item(F, it);
    REP(14) big_transposes(F);
    constexpr int N_UQ = 24 * 3, N_UKV = 32, N_LRU = 32 * 4, N_L = N_UQ + N_UKV + N_LRU;
    for (int it = F.bid; it < 2 * N_L; it += F.G) {
        const int l = it / N_L; int r = it - l * N_L;
        if (r < N_UQ) { transpose_item<256>(F, F.w_uq + (size_t)l * 768 * 1536, 1536, 768, WSP(bf16_t, WS_WUQ) + (size_t)l * 1536 * 768, F.q_norm + l * 768, CmUq(), (r / 3) * 64, (r % 3) * 256); continue; }
        r -= N_UQ;
        if (r < N_UKV) { transpose_item<256>(F, F.w_ukv + (size_t)l * 256 * 2048, 2048, 256, WSP(bf16_t, WS_WUKV) + (size_t)l * 2048 * 256, F.kv_norm + l * 256, CmId(), r * 64, 0); continue; }
        r -= N_UKV;
        { const int mat = r >> 2, q = r & 3, gate = mat >> 4, db = mat & 15;
          const float* src = (gate ? F.wx : F.wa) + ((size_t)l * 16 + db) * 16384;
          bf16_t* dst = WSP(bf16_t, WS_LRUW) + (((size_t)l * 2 + (db >> 3)) * 2 + gate) * 8 * 16384 + (size_t)(db & 7) * 16384;
          transpose_item<64>(F, src, 128, 128, dst, nullptr, CmId(), (q >> 1) * 64, (q & 1) * 64); }
    }
}

__device__ __forceinline__ float wave_sum(float v) {
#pragma unroll
    for (int o = 32; o >= 1; o >>= 1) v += __shfl_xor(v, o);
    return v;
}
typedef unsigned int u32x2v __attribute__((__vector_size__(8)));
__device__ __forceinline__ __amdgpu_buffer_rsrc_t mk_rsrc(const void* p, size_t bytes) { return __builtin_amdgcn_make_buffer_rsrc((void*)p, (short)0, (int)bytes, 0x00020000); }
__device__ __forceinline__ f32x4 bld_f4(__amdgpu_buffer_rsrc_t r, unsigned vo, unsigned so) { const u32x4v v = __builtin_amdgcn_raw_buffer_load_b128(r, (int)vo, (int)so, 0); return __builtin_bit_cast(f32x4, v); }
__device__ __forceinline__ u32x2 bld_u2(__amdgpu_buffer_rsrc_t r, unsigned vo, unsigned so) { const u32x2v v = __builtin_amdgcn_raw_buffer_load_b64(r, (int)vo, (int)so, 0); return __builtin_bit_cast(u32x2, v); }
__device__ __forceinline__ void bst_f4(__amdgpu_buffer_rsrc_t r, unsigned vo, unsigned so, f32x4 x) { __builtin_amdgcn_raw_buffer_store_b128(__builtin_bit_cast(u32x4v, x), r, (int)vo, (int)so, 0); }
__device__ __forceinline__ void bst_u2(__amdgpu_buffer_rsrc_t r, unsigned vo, unsigned so, u32x2 x) { __builtin_amdgcn_raw_buffer_store_b64(__builtin_bit_cast(u32x2v, x), r, (int)vo, (int)so, 0); }
__device__ __forceinline__ void norm_phase(const Frame& F, int l, int row_lo, int row_hi, int blk0, int nblk) {
    if (F.bid < blk0 || F.bid >= blk0 + nblk || row_lo + (F.bid - blk0) * NWAVE >= row_hi) return;
    const float* MOD = WSP(float, WS_MOD);
    const __amdgpu_buffer_rsrc_t rZ = mk_rsrc(WSP(bf16_t, WS_Z), (size_t)T * DM * 2), rH = mk_rsrc(WSP(bf16_t, WS_H), (size_t)T * DM * 2);
    const __amdgpu_buffer_rsrc_t rXC = mk_rsrc(WSP(float, WS_XC), (size_t)CTX * DM * 4), rOut = mk_rsrc(F.out, (size_t)SEQ * DM * 4);
    const __amdgpu_buffer_rsrc_t rX = mk_rsrc(F.x, (size_t)SEQ * DM * 4), rCtx = mk_rsrc(F.ctx, (size_t)CTX * DM * 4);
    const unsigned vo = (unsigned)F.lane * 16u, vo2 = (unsigned)F.lane * 8u;
    LAS float* tab = (LAS float*)(F.lds + LDS_RING);
    { const int v_lo = (l == 0) ? 0 : (row_lo < CTX ? 1 : 0), v_hi = (l == 0) ? 1 : v_lo;
      for (int v = v_lo; v <= v_hi; ++v)
#pragma unroll
          for (int k = 0; k < 2; ++k) { const int c = (F.tid + NTHR * k) * 4;
              if (l < 2) { const f32x4 gp = *(const f32x4*)(F.g_pre + l * DM + c), sc = *(const f32x4*)(MOD + (size_t)(l * 2 + v) * 12288 + DM + c), sh = *(const f32x4*)(MOD + (size_t)(l * 2 + v) * 12288 + c);
                  *(LAS f32x4*)(tab + (v * 3 + 0) * DM + c) = gp * (sc + 1.f); *(LAS f32x4*)(tab + (v * 3 + 1) * DM + c) = sh; }
              if (l >= 1) { const f32x4 gt = *(const f32x4*)(MOD + (size_t)((l - 1) * 2 + v) * 12288 + 2 * DM + c), gq = *(const f32x4*)(F.g_post + (l - 1) * DM + c);
                  *(LAS f32x4*)(tab + (v * 3 + 2) * DM + c) = gt * gq; } } }
    __syncthreads();
    for (int row = row_lo + (F.bid - blk0) * NWAVE + F.wave; row < row_hi; row += nblk * NWAVE) {
        const bool is_ctx = row < CTX;
        const unsigned rr = (unsigned)(is_ctx ? row : row - CTX) * (unsigned)(DM * 4);
        const LAS float* tv = tab + (is_ctx ? 3 : 0) * DM + F.lane * 4;
        f32x4 xv[16];
        if (l <= 1) {
#pragma unroll
            for (int i = 0; i < 16; ++i) xv[i] = is_ctx ? bld_f4(rCtx, vo, rr + i * 1024u) : bld_f4(rX, vo, rr + i * 1024u);
        } else {
#pragma unroll
            for (int i = 0; i < 16; ++i) xv[i] = is_ctx ? bld_f4(rXC, vo, rr + i * 1024u) : bld_f4(rOut, vo, rr + i * 1024u);
        }
        if (l >= 1) {
            const float rstd_z = rsqrtf(wave_sum(WSP(float, WS_ST2)[(size_t)row * 64 + F.lane]) * (1.f / DM) + EPS);
            const unsigned zo = (unsigned)row * (unsigned)(DM * 2);
#pragma unroll
            for (int i = 0; i < 16; ++i) {
                const u32x2 zz = bld_u2(rZ, vo2, zo + i * 512u); const f32x4 g4 = *(const LAS f32x4*)(tv + 2 * DM + i * 256);
                xv[i][0] += g4[0] * (bflo(zz.x) * rstd_z); xv[i][1] += g4[1] * (bfhi(zz.x) * rstd_z);
                xv[i][2] += g4[2] * (bflo(zz.y) * rstd_z); xv[i][3] += g4[3] * (bfhi(zz.y) * rstd_z);
                if (is_ctx) bst_f4(rXC, vo, rr + i * 1024u, xv[i]); else bst_f4(rOut, vo, rr + i * 1024u, xv[i]); }
        }
        if (l < 2) {
            float ss = 0.f;
#pragma unroll
            for (int i = 0; i < 16; ++i) ss += dot4(xv[i]);
            const float rstd = rsqrtf(wave_sum(ss) * (1.f / DM) + EPS);
            const unsigned ho = (unsigned)row * (unsigned)(DM * 2);
#pragma unroll
            for (int i = 0; i < 16; ++i) {
                const f32x4 a4 = *(const LAS f32x4*)(tv + i * 256), b4 = *(const LAS f32x4*)(tv + DM + i * 256);
                const float h0 = xv[i][0] * rstd * a4[0] + b4[0], h1 = xv[i][1] * rstd * a4[1] + b4[1];
                const float h2 = xv[i][2] * rstd * a4[2] + b4[2], h3 = xv[i][3] * rstd * a4[3] + b4[3];
                u32x2 w; w.x = cvt_pk_bf16(h0, h1); w.y = cvt_pk_bf16(h2, h3); bst_u2(rH, vo2, ho + i * 512u, w); }
        }
    }
    __syncthreads();
}

#define SBAR() __builtin_amdgcn_sched_barrier(0)
__device__ __forceinline__ int crow(int r, int hi) { return (r & 3) + 8 * (r >> 2) + 4 * hi; }
__device__ __forceinline__ int v_st(int k, int c) { const int kk = (k & ~0xC) | ((k & 4) << 1) | ((k & 8) >> 1); return ((kk >> 3) * 4 + (c >> 5)) * 512 + ((kk & 7) * 32 + (c & 31)) * 2; }
__device__ __forceinline__ int v_rd_base(int lane) { return ((lane & 3) << 3) | (((lane >> 2) & 3) << 6) | (((lane >> 4) & 1) << 5) | (((lane >> 5) & 1) << 8); }
constexpr int v_rd_off(int d0, int ks, int half) { return d0 * 512 + ks * 4096 + half * 2048; }
template <int OFF> __device__ __forceinline__ s16x4 tr_read(int vb) {
    s16x4 r; asm volatile("ds_read_b64_tr_b16 %0, %1 offset:%2" : "=&v"(r) : "v"(vb), "i"(OFF) : "memory"); return r;
}
template <int S> __device__ __forceinline__ void pv_rd(int vb, s16x4& a, s16x4& b, s16x4& c, s16x4& d) {
    a = tr_read<v_rd_off(S >> 1, 2 * (S & 1), 0)>(vb); b = tr_read<v_rd_off(S >> 1, 2 * (S & 1), 1)>(vb);
    c = tr_read<v_rd_off(S >> 1, 2 * (S & 1) + 1, 0)>(vb); d = tr_read<v_rd_off(S >> 1, 2 * (S & 1) + 1, 1)>(vb);
}
#define PVPK(L, H) (bf16x8){L[0], L[1], L[2], L[3], H[0], H[1], H[2], H[3]}
#define PV_STEP(S, OD, PA, PB, CA, CB, CC, CD, NA, NB, NC, ND_) do { if (S < 7) pv_rd<(S < 7 ? S + 1 : 7)>(vb, NA, NB, NC, ND_); \
    if (S < 7) asm volatile("s_waitcnt lgkmcnt(4)" : "+v"(CA), "+v"(CB), "+v"(CC), "+v"(CD) :: "memory"); else asm volatile("s_waitcnt lgkmcnt(0)" : "+v"(CA), "+v"(CB), "+v"(CC), "+v"(CD) :: "memory"); \
    OD = __builtin_amdgcn_mfma_f32_32x32x16_bf16(PVPK(CA, CB), PA, OD, 0, 0, 0); OD = __builtin_amdgcn_mfma_f32_32x32x16_bf16(PVPK(CC, CD), PB, OD, 0, 0, 0); } while (0)
__device__ __forceinline__ void pv_d0(f32x16* o, int vb, bf16x8 pa0, bf16x8 pa1, bf16x8 pa2, bf16x8 pa3) {
    s16x4 a0, b0, c0, d0, a1, b1, c1, d1;
    pv_rd<0>(vb, a0, b0, c0, d0);
    PV_STEP(0, o[0], pa0, pa1, a0, b0, c0, d0, a1, b1, c1, d1);
    PV_STEP(1, o[0], pa2, pa3, a1, b1, c1, d1, a0, b0, c0, d0);
    PV_STEP(2, o[1], pa0, pa1, a0, b0, c0, d0, a1, b1, c1, d1);
    PV_STEP(3, o[1], pa2, pa3, a1, b1, c1, d1, a0, b0, c0, d0);
    PV_STEP(4, o[2], pa0, pa1, a0, b0, c0, d0, a1, b1, c1, d1);
    PV_STEP(5, o[2], pa2, pa3, a1, b1, c1, d1, a0, b0, c0, d0);
    PV_STEP(6, o[3], pa0, pa1, a0, b0, c0, d0, a1, b1, c1, d1);
    PV_STEP(7, o[3], pa2, pa3, a1, b1, c1, d1, a0, b0, c0, d0);
}
#undef PV_STEP
#undef PVPK
constexpr float THR2 = 11.5415603f;
template <int ABL = 0>
__device__ __forceinline__ void partialSM(f32x16& p0, f32x16& p1, float& m_reg, float& alpha) {
    if (ABL == 1) { alpha = 1.f; return; }
    float pmax = p0[0];
#pragma unroll
    for (int r = 1; r < 16; ++r) pmax = fmaxf(pmax, p0[r]);
#pragma unroll
    for (int r = 0; r < 16; ++r) pmax = fmaxf(pmax, p1[r]);
    { auto rr = __builtin_amdgcn_permlane32_swap(__float_as_uint(pmax), __float_as_uint(pmax), false, false);
      pmax = fmaxf(__uint_as_float(rr[0]), __uint_as_float(rr[1])); }
    if (__builtin_expect(__all(pmax <= THR2), 1)) { alpha = 1.f; }
    else { const float sh = fmaxf(pmax, 0.f); alpha = __builtin_amdgcn_exp2f(-sh); m_reg += sh;
#pragma unroll
        for (int r = 0; r < 16; ++r) { p0[r] -= sh; p1[r] -= sh; } }
#pragma unroll
    for (int r = 0; r < 16; ++r) p0[r] = __builtin_amdgcn_exp2f(p0[r]);
}
template <int ABL = 0>
__device__ __forceinline__ void finishSM(f32x16& p0, f32x16& p1, float alpha, float& l_reg, bf16x8& pa0, bf16x8& pa1, bf16x8& pa2, bf16x8& pa3) {
    if (ABL != 1) {
#pragma unroll
    for (int r = 0; r < 16; ++r) p1[r] = __builtin_amdgcn_exp2f(p1[r]); }
    float ps = 0;
    if (ABL != 1) {
#pragma unroll
    for (int r = 0; r < 16; ++r) ps += p0[r];
#pragma unroll
    for (int r = 0; r < 16; ++r) ps += p1[r]; }
    { auto rr = __builtin_amdgcn_permlane32_swap(__float_as_uint(ps), __float_as_uint(ps), false, false);
      ps = __uint_as_float(rr[0]) + __uint_as_float(rr[1]); }
    l_reg = l_reg * alpha + ps;
#define PK4(P, BASE, OUT) do { unsigned a0 = cvt_pk_bf16(P[BASE + 0], P[BASE + 1]), a1 = cvt_pk_bf16(P[BASE + 2], P[BASE + 3]);   \
    unsigned b0 = cvt_pk_bf16(P[BASE + 4], P[BASE + 5]), b1 = cvt_pk_bf16(P[BASE + 6], P[BASE + 7]);                              \
    auto r0 = __builtin_amdgcn_permlane32_swap(a0, b0, false, false); auto r1 = __builtin_amdgcn_permlane32_swap(a1, b1, false, false); \
    u32x4 w = {r0[0], r1[0], r0[1], r1[1]}; OUT = *reinterpret_cast<bf16x8*>(&w); } while (0)
    PK4(p0, 0, pa0); PK4(p0, 8, pa1); PK4(p1, 0, pa2); PK4(p1, 8, pa3);
#undef PK4
}

template <int N> __device__ __forceinline__ void sg_rmv() { if constexpr (N > 0) { __builtin_amdgcn_sched_group_barrier(0x008, 2, 0); __builtin_amdgcn_sched_group_barrier(0x100, 2, 0); sg_rmv<N - 1>(); } }
template <int N> __device__ __forceinline__ void sg_mv() { if constexpr (N > 0) { __builtin_amdgcn_sched_group_barrier(0x008, 2, 0); sg_mv<N - 1>(); } }
struct TsDense { __device__ __forceinline__ int row(int j) const { return 64 * j; } __device__ __forceinline__ int tok(int) const { return 0; } __device__ __forceinline__ bool masked(int) const { return false; } };
struct TsSwa {
    int tb;
    __device__ __forceinline__ int tok(int j) const { return tb + 64 * j; }
    __device__ __forceinline__ bool masked(int j) const { return j < 5 && (j == 0 || j == 4 || tb + 64 * j < 0 || tb + 64 * j + 64 > SEQ); }
    __device__ __forceinline__ int row(int j) const { if (j >= 5) return 64 * (j - 5); int t = tb + 64 * j; t = t < 0 ? 0 : (t > SEQ - 64 ? SEQ - 64 : t); return CTX + t; }
};

__device__ __forceinline__ bf16x8 buf_ld16(__amdgpu_buffer_rsrc_t rs, unsigned voff, unsigned soff) { const u32x4v v = __builtin_amdgcn_raw_buffer_load_b128(rs, (int)voff, (int)soff, 0); return __builtin_bit_cast(bf16x8, v); }
#ifndef ABL_KIND
#define ABL_KIND 0
#endif

constexpr int TLD = 136;
__device__ __forceinline__ bf16x8 frag_kc(const LAS bf16_t* base, int ld, int idx0, int k0, int lane) {
    return *(const LAS bf16x8*)(base + (idx0 + (lane & 15)) * ld + k0 + 8 * (lane >> 4));
}
struct TrFrag { s16x4 lo, hi; };
__device__ __forceinline__ void frag_tr_issue(TrFrag& f, const LAS bf16_t* base, int ld, int idx0, int k0, int lane) {
    const int g = lane >> 4, i = lane & 15, q = i >> 2, p = i & 3;
    const int a = (int)(uintptr_t)(base + (k0 + 8 * g + q) * ld + idx0 + 4 * p);
    asm volatile("ds_read_b64_tr_b16 %0, %1" : "=&v"(f.lo) : "v"(a) : "memory");
    asm volatile("ds_read_b64_tr_b16 %0, %1" : "=&v"(f.hi) : "v"(a + 4 * ld * 2) : "memory");
}
__device__ __forceinline__ void frag_tr_issue_p(TrFrag& f, const LAS bf16_t* base, int ld, int idx32, int nn, int k0, int lane) {
    const int g = lane >> 4, i = lane & 15, q = i >> 2, p = i & 3;
    const int a = (int)(uintptr_t)(base + (k0 + 8 * g + q) * ld + idx32 + 8 * p + 4 * nn);
    asm volatile("ds_read_b64_tr_b16 %0, %1" : "=&v"(f.lo) : "v"(a) : "memory");
    asm volatile("ds_read_b64_tr_b16 %0, %1" : "=&v"(f.hi) : "v"(a + 4 * ld * 2) : "memory");
}
#define TRGET(f) ((bf16x8){(f).lo[0], (f).lo[1], (f).lo[2], (f).lo[3], (f).hi[0], (f).hi[1], (f).hi[2], (f).hi[3]})
#define LDS_WAIT(n) asm volatile("s_waitcnt lgkmcnt(" #n ")" ::: "memory")
__device__ __forceinline__ void load_tile128(LAS bf16_t* dst, const bf16_t* __restrict__ src, size_t ld, int tid) {
#pragma unroll
    for (int i = 0; i < 4; ++i) { const int idx = tid + NTHR * i, r = idx >> 4, oc = idx & 15;
        *(LAS bf16x8*)(dst + r * TLD + oc * 8) = *(const bf16x8*)(src + (size_t)r * ld + oc * 8); }
}
__device__ __forceinline__ float wave_scan_add(float v, int lane) {
#pragma unroll
    for (int o = 1; o < 64; o <<= 1) { const float t = __shfl_up(v, o); if (lane >= o) v += t; }
    return v;
}
__device__ __forceinline__ float wave_scan_max(float v, int lane) {
#pragma unroll
    for (int o = 1; o < 64; o <<= 1) { const float t = __shfl_up(v, o); if (lane >= o) v = fmaxf(v, t); }
    return v;
}
__device__ __forceinline__ float wave_max(float v) {
#pragma unroll
    for (int o = 32; o >= 1; o >>= 1) v = fmaxf(v, __shfl_xor(v, o));
    return v;
}
__device__ __forceinline__ int chunk_at(int dir, int s) { return dir == 0 ? s : (s == 0 ? 1 : (s == 1 ? 0 : 131 - s)); }

constexpr int XLD = 68;
constexpr size_t WS_LH = WS_Z, WS_LA = WS_Z + (size_t)2 * T * 1024 * 2;
__device__ __forceinline__ float fast_sigmoid(float x) { return __builtin_amdgcn_rcpf(1.f + __expf(-x)); }
__device__ __forceinline__ float one_minus_sq(float la, float a) {
    const float x = 2.f * la;
    const float p = -x * (1.f + x * 0.5f * (1.f + x * (1.f / 3.f) * (1.f + x * 0.25f * (1.f + x * 0.2f))));
    return x < -0.25f ? 1.f - a * a : p;
}
template <int CTRL> __device__ __forceinline__ float dpp_f(float old, float v) {
    return __builtin_bit_cast(float, __builtin_amdgcn_update_dpp(__builtin_bit_cast(int, old), __builtin_bit_cast(int, v), CTRL, 0xF, 0xF, false));
}
template <int DIR, int K> __device__ __forceinline__ void lru_row_step(float& A, float& B) {
    constexpr int C = (DIR ? 0x100 : 0x110) + K;
    const float Ap = dpp_f<C>(1.f, A), Bp = dpp_f<C>(0.f, B);
    B = A * Bp + B; A = A * Ap;
}
template <int DIR>
__device__ __forceinline__ void lru_dir(const Frame& F, int l, int n, int blk, int hf, const LAS bf16_t* Ub, LAS float* seg, const LAS float* par, int wr, int wc, int li, int lq, int lane) {
    constexpr int dir = DIR;
    LAS float* segA = seg + dir * 512; LAS float* segH = segA + 256;
    const bf16_t* Wa = WSP(bf16_t, WS_LRUW) + ((((size_t)l * 2 + dir) * 2 + 0) * 8 + blk) * 16384;
    const bf16_t* Wx = WSP(bf16_t, WS_LRUW) + ((((size_t)l * 2 + dir) * 2 + 1) * 8 + blk) * 16384;
    f32x4 ar[2][2], ai[2][2];
#pragma unroll
    for (int m = 0; m < 2; ++m)
#pragma unroll
        for (int nn = 0; nn < 2; ++nn) { ar[m][nn] = (f32x4){0.f, 0.f, 0.f, 0.f}; ai[m][nn] = (f32x4){0.f, 0.f, 0.f, 0.f}; }
    bf16x8 fa[4][2], fx[4][2];
#pragma unroll
    for (int ks = 0; ks < 4; ++ks)
#pragma unroll
        for (int nn = 0; nn < 2; ++nn) { const int j = hf * 64 + 32 * wc + 16 * nn + li;
            fa[ks][nn] = *(const bf16x8*)(Wa + j * 128 + 32 * ks + 8 * lq); fx[ks][nn] = *(const bf16x8*)(Wx + j * 128 + 32 * ks + 8 * lq); }
#pragma unroll
    for (int ks = 0; ks < 4; ++ks) {
        bf16x8 fu[2];
#pragma unroll
        for (int m = 0; m < 2; ++m) fu[m] = frag_kc(Ub, TLD, 32 * wr + 16 * m, 32 * ks, lane);
#pragma unroll
        for (int m = 0; m < 2; ++m)
#pragma unroll
            for (int nn = 0; nn < 2; ++nn) { ar[m][nn] = __builtin_amdgcn_mfma_f32_16x16x32_bf16(fa[ks][nn], fu[m], ar[m][nn], 0, 0, 0);
                                             ai[m][nn] = __builtin_amdgcn_mfma_f32_16x16x32_bf16(fx[ks][nn], fu[m], ai[m][nn], 0, 0, 0); }
    }
    float A[2][2][4], B[2][2][4];
#pragma unroll
    for (int m = 0; m < 2; ++m)
#pragma unroll
        for (int nn = 0; nn < 2; ++nn) { const int tt = 32 * wr + 16 * m + li, chb = 32 * wc + 16 * nn + 4 * lq;
            const u32x2 uu = *(const LAS u32x2*)(Ub + tt * TLD + hf * 64 + chb); const float u4[4] = {bflo(uu.x), bfhi(uu.x), bflo(uu.y), bfhi(uu.y)};
            const f32x4 pa = *(const LAS f32x4*)(par + 128 + dir * 64 + chb), px = *(const LAS f32x4*)(par + 256 + dir * 64 + chb), ps = *(const LAS f32x4*)(par + dir * 64 + chb);
#pragma unroll
            for (int e = 0; e < 4; ++e) {
                const float r = fast_sigmoid(ar[m][nn][e] + pa[e]), ig = fast_sigmoid(ai[m][nn][e] + px[e]);
                const float la = -r * ps[e];
                const float a_ = __expf(la); A[m][nn][e] = a_; B[m][nn][e] = __builtin_amdgcn_sqrtf(fmaxf(one_minus_sq(la, a_), 0.f)) * (ig * u4[e]); } }
#pragma unroll
    for (int m = 0; m < 2; ++m)
#pragma unroll
        for (int nn = 0; nn < 2; ++nn)
#pragma unroll
            for (int e = 0; e < 4; ++e) { lru_row_step<DIR, 1>(A[m][nn][e], B[m][nn][e]); lru_row_step<DIR, 2>(A[m][nn][e], B[m][nn][e]); lru_row_step<DIR, 4>(A[m][nn][e], B[m][nn][e]); lru_row_step<DIR, 8>(A[m][nn][e], B[m][nn][e]); }
    constexpr int mf = DIR ? 1 : 0, ms = 1 - mf, last = DIR ? 0 : 15;
    const int srcl = (lane & 48) | last;
#pragma unroll
    for (int nn = 0; nn < 2; ++nn)
#pragma unroll
        for (int e = 0; e < 4; ++e) { const float tA = __shfl(A[mf][nn][e], srcl), tB = __shfl(B[mf][nn][e], srcl);
            B[ms][nn][e] = A[ms][nn][e] * tB + B[ms][nn][e]; A[ms][nn][e] *= tA; }
    if (li == last) {
#pragma unroll
        for (int nn = 0; nn < 2; ++nn) { const int chb = 32 * wc + 16 * nn + 4 * lq;
            *(LAS f32x4*)(segA + wr * 64 + chb) = (f32x4){A[ms][nn][0], A[ms][nn][1], A[ms][nn][2], A[ms][nn][3]};
            *(LAS f32x4*)(segH + wr * 64 + chb) = (f32x4){B[ms][nn][0], B[ms][nn][1], B[ms][nn][2], B[ms][nn][3]}; } }
    __syncthreads();
    const int pos = DIR ? 3 - wr : wr;
    f32x4 c[2], Pp[2];
#pragma unroll
    for (int nn = 0; nn < 2; ++nn) { c[nn] = (f32x4){0.f, 0.f, 0.f, 0.f}; Pp[nn] = (f32x4){1.f, 1.f, 1.f, 1.f}; }
    for (int s2 = 0; s2 < pos; ++s2) { const int w2 = DIR ? 3 - s2 : s2;
#pragma unroll
        for (int nn = 0; nn < 2; ++nn) { const int chb = 32 * wc + 16 * nn + 4 * lq; const f32x4 a = *(const LAS f32x4*)(segA + w2 * 64 + chb), h = *(const LAS f32x4*)(segH + w2 * 64 + chb);
            c[nn] = a * c[nn] + h; Pp[nn] = Pp[nn] * a; } }
    const size_t r0 = (size_t)n * 128;
    if (pos == 3 && li == last) {
        float* LS = WSP(float, WS_LSUM) + (((size_t)n * 2 + dir) * 2) * 1024 + blk * 128 + hf * 64;
#pragma unroll
        for (int nn = 0; nn < 2; ++nn) { const int chb = 32 * wc + 16 * nn + 4 * lq; f32x4 ta, th;
#pragma unroll
            for (int e = 0; e < 4; ++e) { ta[e] = Pp[nn][e] * A[ms][nn][e]; th[e] = A[ms][nn][e] * c[nn][e] + B[ms][nn][e]; }
            *(f32x4*)(LS + chb) = ta; *(f32x4*)(LS + 1024 + chb) = th; } }
#pragma unroll
    for (int m = 0; m < 2; ++m)
#pragma unroll
        for (int nn = 0; nn < 2; ++nn) { const int tt = 32 * wr + 16 * m + li, chb = 32 * wc + 16 * nn + 4 * lq;
            const size_t go = ((size_t)dir * T + r0 + tt) * 1024 + blk * 128 + hf * 64 + chb;
            u32x2 hw, aw;
            hw.x = cvt_pk_bf16(B[m][nn][0] + A[m][nn][0] * c[nn][0], B[m][nn][1] + A[m][nn][1] * c[nn][1]); hw.y = cvt_pk_bf16(B[m][nn][2] + A[m][nn][2] * c[nn][2], B[m][nn][3] + A[m][nn][3] * c[nn][3]);
            aw.x = cvt_pk_bf16(A[m][nn][0] * Pp[nn][0], A[m][nn][1] * Pp[nn][1]); aw.y = cvt_pk_bf16(A[m][nn][2] * Pp[nn][2], A[m][nn][3] * Pp[nn][3]);
            *(u32x2*)(WSP(bf16_t, WS_LH) + go) = hw; *(u32x2*)(WSP(bf16_t, WS_LA) + go) = aw; }
}
__device__ __forceinline__ void lru_item(const Frame& F, int l, int item) {
    const int n = item >> 4, blk = (item >> 1) & 7, hf = item & 1;
    const int tid = F.tid, lane = F.lane, wave = F.wave;
    LAS bf16_t* Ub = (LAS bf16_t*)(F.lds + LDS_RING);
    LAS float* segA = (LAS float*)(F.lds + LDS_RING + 34816);
    LAS float* par = segA + 1024;
    const bf16_t* P = WSP(bf16_t, WS_P);
    const int r0 = n * 128, seg_lo = (n < 2) ? 0 : CTX, seg_hi = (n < 2) ? CTX : T;
    if (tid < 128) { const int d = tid >> 6, ch = tid & 63, gc = blk * 128 + hf * 64 + ch;
        par[d * 64 + ch] = 8.f * softplusf_(-F.lam[(l * 2 + d) * 1024 + gc]);
        par[128 + d * 64 + ch] = F.ba[(l * 2 + d) * 1024 + gc]; par[256 + d * 64 + ch] = F.bx[(l * 2 + d) * 1024 + gc]; }
    { const int oc = tid & 15, tq = tid >> 4, c0 = blk * 128 + oc * 8;
      float w[4][8], bb[8];
#pragma unroll
      for (int j = 0; j < 4; ++j) { const f32x4 a = *(const f32x4*)(F.conv_w + ((size_t)l * 4 + j) * 1024 + c0), b = *(const f32x4*)(F.conv_w + ((size_t)l * 4 + j) * 1024 + c0 + 4);
          w[j][0] = a[0]; w[j][1] = a[1]; w[j][2] = a[2]; w[j][3] = a[3]; w[j][4] = b[0]; w[j][5] = b[1]; w[j][6] = b[2]; w[j][7] = b[3]; }
      { const f32x4 a = *(const f32x4*)(F.conv_b + l * 1024 + c0), b = *(const f32x4*)(F.conv_b + l * 1024 + c0 + 4);
          bb[0] = a[0]; bb[1] = a[1]; bb[2] = a[2]; bb[3] = a[3]; bb[4] = b[0]; bb[5] = b[1]; bb[6] = b[2]; bb[7] = b[3]; }
      float xin[7][8];
#pragma unroll
      for (int q = 0; q < 7; ++q) { const int r = r0 + tq * 4 - 2 + q;
          u32x4 v = {0u, 0u, 0u, 0u}; if (r >= seg_lo && r < seg_hi) v = *(const u32x4*)(P + (size_t)r * PW + S_LRU_U + c0);
          xin[q][0] = bflo(v.x); xin[q][1] = bfhi(v.x); xin[q][2] = bflo(v.y); xin[q][3] = bfhi(v.y); xin[q][4] = bflo(v.z); xin[q][5] = bfhi(v.z); xin[q][6] = bflo(v.w); xin[q][7] = bfhi(v.w); }
#pragma unroll
      for (int t4 = 0; t4 < 4; ++t4) { float o[8];
#pragma unroll
          for (int e = 0; e < 8; ++e) o[e] = bb[e] + w[0][e] * xin[t4][e] + w[1][e] * xin[t4 + 1][e] + w[2][e] * xin[t4 + 2][e] + w[3][e] * xin[t4 + 3][e];
          u32x4 pk; pk.x = cvt_pk_bf16(o[0], o[1]); pk.y = cvt_pk_bf16(o[2], o[3]); pk.z = cvt_pk_bf16(o[4], o[5]); pk.w = cvt_pk_bf16(o[6], o[7]);
          *(LAS u32x4*)(Ub + (tq * 4 + t4) * TLD + oc * 8) = pk; } }
    __syncthreads();
    const int wr = wave >> 1, wc = wave & 1, li = lane & 15, lq = lane >> 4;
    lru_dir<0>(F, l, n, blk, hf, Ub, segA, par, wr, wc, li, lq, lane);
    lru_dir<1>(F, l, n, blk, hf, Ub, segA, par, wr, wc, li, lq, lane);
}
__device__ __forceinline__ void lru_out(const Frame& F, int row_lo, int blk0) {
    const bf16_t* P = WSP(bf16_t, WS_P); bf16_t* Y = WSP(bf16_t, WS_Y); const bf16_t* LH = WSP(bf16_t, WS_LH); const bf16_t* LA = WSP(bf16_t, WS_LA); const float* LC = WSP(float, WS_LCAR);
    const long total = (long)(T - row_lo) * 128;
    if (F.bid < blk0) return;
    for (long i = (long)(F.bid - blk0) * NTHR + F.tid; i < total; i += (long)(F.G - blk0) * NTHR) {
        const int row = row_lo + (int)(i >> 7), c0 = (int)(i & 127) * 8, n = row >> 7;
        const u32x4 hf_ = *(const u32x4*)(LH + (size_t)row * 1024 + c0), af_ = *(const u32x4*)(LA + (size_t)row * 1024 + c0);
        const u32x4 hb_ = *(const u32x4*)(LH + ((size_t)T + row) * 1024 + c0), ab_ = *(const u32x4*)(LA + ((size_t)T + row) * 1024 + c0);
        const u32x4 gt_ = *(const u32x4*)(P + (size_t)row * PW + S_LRU_G + c0);
        const f32x4 cf0 = *(const f32x4*)(LC + ((size_t)n * 2 + 0) * 1024 + c0), cf1 = *(const f32x4*)(LC + ((size_t)n * 2 + 0) * 1024 + c0 + 4);
        const f32x4 cb0 = *(const f32x4*)(LC + ((size_t)n * 2 + 1) * 1024 + c0), cb1 = *(const f32x4*)(LC + ((size_t)n * 2 + 1) * 1024 + c0 + 4);
        const unsigned hw[4] = {hf_.x, hf_.y, hf_.z, hf_.w}, aw[4] = {af_.x, af_.y, af_.z, af_.w}, hbw[4] = {hb_.x, hb_.y, hb_.z, hb_.w}, abw[4] = {ab_.x, ab_.y, ab_.z, ab_.w}, gw[4] = {gt_.x, gt_.y, gt_.z, gt_.w};
        const float cf[8] = {cf0[0], cf0[1], cf0[2], cf0[3], cf1[0], cf1[1], cf1[2], cf1[3]}, cb[8] = {cb0[0], cb0[1], cb0[2], cb0[3], cb1[0], cb1[1], cb1[2], cb1[3]};
        unsigned ow[4];
#pragma unroll
        for (int e = 0; e < 4; ++e) {
            const float y0 = (bflo(hw[e]) + bflo(aw[e]) * cf[2 * e] + bflo(hbw[e]) + bflo(abw[e]) * cb[2 * e]) * siluf_(bflo(gw[e]));
            const float y1 = (bfhi(hw[e]) + bfhi(aw[e]) * cf[2 * e + 1] + bfhi(hbw[e]) + bfhi(abw[e]) * cb[2 * e + 1]) * siluf_(bfhi(gw[e]));
            ow[e] = cvt_pk_bf16(y0, y1); }
        u32x4 o; o.x = ow[0]; o.y = ow[1]; o.z = ow[2]; o.w = ow[3];
        *(u32x4*)(Y + (size_t)row * DM + c0) = o;
    }
}
__device__ __forceinline__ void lru_carry(const Frame& F, int chain) {
    const int dir = chain >> 10, c = chain & 1023; const float* LS = WSP(float, WS_LSUM); float* LC = WSP(float, WS_LCAR);
    float h = 0.f;
#pragma unroll 1
    for (int s0 = 0; s0 < NCH; s0 += 26) {
        float A[26], hh[26];
#pragma unroll
        for (int j = 0; j < 26; ++j) { const int n = chunk_at(dir, s0 + j); const size_t b = (((size_t)n * 2 + dir) * 2) * 1024 + c; A[j] = LS[b]; hh[j] = LS[b + 1024]; }
#pragma unroll
        for (int j = 0; j < 26; ++j) { const int n = chunk_at(dir, s0 + j); LC[((size_t)n * 2 + dir) * 1024 + c] = h; h = A[j] * h + hh[j]; }
    }
}

struct MlStats { float cum0, cum1, u0, u1; };
__device__ __forceinline__ MlStats ml_cum(const LAS float* lf, const LAS float* ig, int dir, int lane) {
    MlStats s;
    if (dir == 0) { const float e0 = lf[2 * lane], e1 = lf[2 * lane + 1]; const float inc = wave_scan_add(e0 + e1, lane), pre = inc - (e0 + e1);
        s.cum0 = pre + e0; s.cum1 = inc; }
    else { const float e0 = lf[127 - 2 * lane], e1 = lf[126 - 2 * lane]; const float inc = wave_scan_add(e0 + e1, lane), pre = inc - (e0 + e1);
        s.cum0 = pre + e0; s.cum1 = inc; }
    const int t0 = dir == 0 ? 2 * lane : 127 - 2 * lane, t1 = dir == 0 ? 2 * lane + 1 : 126 - 2 * lane;
    s.u0 = ig[t0] - s.cum0; s.u1 = ig[t1] - s.cum1;
    return s;
}

__device__ __forceinline__ void ml_cloc_item(const Frame& F, int item) {
    const int hd = item & 7, n = item >> 3; const int tid = F.tid, lane = F.lane, wave = F.wave;
    LAS bf16_t* Kt = (LAS bf16_t*)(F.lds + LDS_RING); LAS bf16_t* Vt = Kt + 128 * TLD; LAS bf16_t* WK0 = Vt + 128 * TLD; LAS bf16_t* WK1 = WK0 + 128 * TLD;
    LAS float* vec = (LAS float*)(WK1 + 128 * TLD);
    const bf16_t* P = WSP(bf16_t, WS_P); const float* G = WSP(float, WS_G);
    const size_t r0 = (size_t)n * 128;
    load_tile128(Kt, P + r0 * PW + S_ML_K + hd * 128, PW, tid); load_tile128(Vt, P + r0 * PW + S_ML_V + hd * 128, PW, tid);
    if (tid < 128) { const float* g = G + (r0 + tid) * 32; vec[tid] = log_sigmoidf_(g[8 + hd]); vec[128 + tid] = g[hd]; vec[256 + tid] = log_sigmoidf_(g[24 + hd]); vec[384 + tid] = g[16 + hd]; }
    __syncthreads();
    if (wave < 2) { const int dir = wave; const MlStats s = ml_cum(vec + dir * 256, vec + dir * 256 + 128, dir, lane);
        const float umax = wave_max(fmaxf(s.u0, s.u1));
        const int t0 = dir == 0 ? 2 * lane : 127 - 2 * lane, t1 = dir == 0 ? 2 * lane + 1 : 126 - 2 * lane;
        vec[512 + dir * 128 + t0] = __expf(s.u0 - umax); vec[512 + dir * 128 + t1] = __expf(s.u1 - umax);
        const float gtot = __shfl(s.cum1, 63);
        if (lane == 0) { float* gm = WSP(float, WS_GM) + ((size_t)n * 16 + dir * 8 + hd) * 2; gm[0] = gtot; gm[1] = gtot + umax; } }
    __syncthreads();
#pragma unroll
    for (int i = 0; i < 4; ++i) { const int idx = tid + NTHR * i, r = idx >> 4, oc = idx & 15; const u32x4 kv = *(const LAS u32x4*)(Kt + r * TLD + oc * 8);
        const float k0 = bflo(kv.x), k1 = bfhi(kv.x), k2 = bflo(kv.y), k3 = bfhi(kv.y), k4 = bflo(kv.z), k5 = bfhi(kv.z), k6 = bflo(kv.w), k7 = bfhi(kv.w);
#pragma unroll
        for (int dir = 0; dir < 2; ++dir) { const float w = vec[512 + dir * 128 + r]; u32x4 o; o.x = cvt_pk_bf16(w * k0, w * k1); o.y = cvt_pk_bf16(w * k2, w * k3); o.z = cvt_pk_bf16(w * k4, w * k5); o.w = cvt_pk_bf16(w * k6, w * k7);
            *(LAS u32x4*)((dir ? WK1 : WK0) + r * TLD + oc * 8) = o; } }
    { const int dir = tid >> 8, d = tid & 127, half = (tid >> 7) & 1; float s_ = 0.f;
#pragma unroll 8
        for (int q = 0; q < 64; ++q) s_ += vec[512 + dir * 128 + half * 64 + q] * bf2f(Kt[(half * 64 + q) * TLD + d]);
        vec[768 + tid] = s_; }
    __syncthreads();
    if (tid < 256) { const int dir = tid >> 7, d = tid & 127; WSP(float, WS_NLOC)[((size_t)n * 16 + dir * 8 + hd) * 128 + d] = vec[768 + dir * 256 + d] + vec[768 + dir * 256 + 128 + d]; }
    const int wr = wave >> 2, wc = wave & 3, li = lane & 15, lq = lane >> 4;
#pragma unroll 1
    for (int dir = 0; dir < 2; ++dir) {
        const LAS bf16_t* WK = dir ? WK1 : WK0;
        f32x4 acc[4][2];
#pragma unroll
        for (int m = 0; m < 4; ++m)
#pragma unroll
            for (int nn = 0; nn < 2; ++nn) acc[m][nn] = (f32x4){0.f, 0.f, 0.f, 0.f};
        TrFrag tk[2][4], tv[2][2];
#define CL_ISSUE(ks, st) do { _Pragma("unroll") for (int m = 0; m < 4; ++m) frag_tr_issue(tk[st][m], WK, TLD, 64 * wr + 16 * m, 32 * (ks), lane); \
            _Pragma("unroll") for (int nn = 0; nn < 2; ++nn) frag_tr_issue_p(tv[st][nn], Vt, TLD, 32 * wc, nn, 32 * (ks), lane); } while (0)
#define CL_MMA(st) do { SBAR(); _Pragma("unroll") for (int m = 0; m < 4; ++m) _Pragma("unroll") for (int nn = 0; nn < 2; ++nn) \
            acc[m][nn] = __builtin_amdgcn_mfma_f32_16x16x32_bf16(TRGET(tv[st][nn]), TRGET(tk[st][m]), acc[m][nn], 0, 0, 0); SBAR(); } while (0)
        CL_ISSUE(0, 0);
        CL_ISSUE(1, 1); LDS_WAIT(12); CL_MMA(0);
        CL_ISSUE(2, 0); LDS_WAIT(12); CL_MMA(1);
        CL_ISSUE(3, 1); LDS_WAIT(12); CL_MMA(0);
        LDS_WAIT(0); CL_MMA(1);
#undef CL_ISSUE
#undef CL_MMA
        bf16_t* CL = WSP(bf16_t, WS_CLOC) + ((size_t)n * 16 + dir * 8 + hd) * 16384;
#pragma unroll
        for (int m = 0; m < 4; ++m) *(u32x4*)(CL + (64 * wr + 16 * m + li) * 128 + 32 * wc + 8 * lq) = pack8(acc[m][0], acc[m][1]);
    }
    __syncthreads();
}

constexpr int SCB = 13;
__device__ __forceinline__ void ml_scan(const Frame& F, int chain, int q, const LAS float* sg, const LAS float* sml) {
    const int dir = chain >> 3;
    const bf16_t* CL = WSP(bf16_t, WS_CLOC) + (size_t)chain * 16384 + q * 8; bf16_t* CI = WSP(bf16_t, WS_CIN) + (size_t)chain * 16384 + q * 8; float* MI = WSP(float, WS_MIN) + chain;
    f32x4 C0 = {0.f, 0.f, 0.f, 0.f}, C1 = {0.f, 0.f, 0.f, 0.f}; float m = 0.f;
    u32x4 ca[SCB], cb[SCB];
#define SC_LOAD(buf, s0) do { _Pragma("unroll") for (int j = 0; j < SCB; ++j) { const int n = chunk_at(dir, (s0) + j); buf[j] = *(const u32x4*)(CL + (size_t)n * (16 * 16384)); } } while (0)
#define SC_STEP(buf, s0) do { _Pragma("unroll") for (int j = 0; j < SCB; ++j) { const int s = (s0) + j, n = chunk_at(dir, s); const float g = sg[s], ml = sml[s]; \
        *(u32x4*)(CI + (size_t)n * (16 * 16384)) = pack8(C0, C1); if (q == 0) MI[n * 16] = m; \
        const float mnew = fmaxf(g + m, ml), a = __expf(g + m - mnew), e = __expf(ml - mnew); const u32x4 cl = buf[j]; \
        const f32x4 l0 = {bflo(cl.x), bfhi(cl.x), bflo(cl.y), bfhi(cl.y)}, l1 = {bflo(cl.z), bfhi(cl.z), bflo(cl.w), bfhi(cl.w)}; \
        C0 = C0 * a + l0 * e; C1 = C1 * a + l1 * e; m = mnew; } } while (0)
    SC_LOAD(ca, 0);
#pragma unroll 1
    for (int s0 = 0; s0 < NCH - 2 * SCB; s0 += 2 * SCB) { SC_LOAD(cb, s0 + SCB); SC_STEP(ca, s0); SC_LOAD(ca, s0 + 2 * SCB); SC_STEP(cb, s0 + SCB); }
    SC_LOAD(cb, NCH - SCB); SC_STEP(ca, NCH - 2 * SCB); SC_STEP(cb, NCH - SCB);
#undef SC_LOAD
#undef SC_STEP
}
__device__ __forceinline__ void ml_nscan(const Frame& F, int chain, int q4, const LAS float* sg, const LAS float* sml) {
    const int dir = chain >> 3;
    const float* NL = WSP(float, WS_NLOC) + (size_t)chain * 128 + q4 * 4; float* NI = WSP(float, WS_NIN) + (size_t)chain * 128 + q4 * 4;
    f32x4 nv = {0.f, 0.f, 0.f, 0.f}; float m = 0.f;
#pragma unroll 1
    for (int s0 = 0; s0 < NCH; s0 += SCB) {
        f32x4 nl[SCB];
#pragma unroll
        for (int j = 0; j < SCB; ++j) { const int n = chunk_at(dir, s0 + j); nl[j] = *(const f32x4*)(NL + (size_t)n * 2048); }
#pragma unroll
        for (int j = 0; j < SCB; ++j) { const int s = s0 + j, n = chunk_at(dir, s); const float g = sg[s], ml = sml[s];
            *(f32x4*)(NI + (size_t)n * 2048) = nv;
            const float mnew = fmaxf(g + m, ml), a = __expf(g + m - mnew), e = __expf(ml - mnew);
            nv = nv * a + nl[j] * e; m = mnew; }
    }
}

struct MlPre { bf16x8 q[4], k[4], v[4], c[4]; float g[4], nin, min_; };
__device__ __forceinline__ void ml_pre_issue(MlPre& R, const Frame& F, int item, int tid, int wave, bool live = true) {
    const int hd = item & 7, n = item >> 3;
    const bf16_t* P = WSP(bf16_t, WS_P);
    const __amdgpu_buffer_rsrc_t rp = mk_rsrc(P + (size_t)n * 128 * PW + hd * 128, live ? (size_t)128 * PW * 2 : 0), rc = mk_rsrc(WSP(bf16_t, WS_CIN) + ((size_t)n * 16 + hd) * 16384, live ? 32768 : 0);
    const unsigned vp = (unsigned)((tid >> 4) * PW + (tid & 15) * 8) * 2u;
#pragma unroll
    for (int i = 0; i < 4; ++i) { R.q[i] = buf_ld16(rp, vp, (unsigned)(i * 32 * PW + S_ML_Q) * 2u); R.k[i] = buf_ld16(rp, vp, (unsigned)(i * 32 * PW + S_ML_K) * 2u);
        R.v[i] = buf_ld16(rp, vp, (unsigned)(i * 32 * PW + S_ML_V) * 2u); R.c[i] = buf_ld16(rc, (unsigned)tid * 16u, (unsigned)i * 8192u); }
    if (tid < 128) { const float* g = WSP(float, WS_G) + ((size_t)n * 128 + tid) * 32; R.g[0] = g[8 + hd]; R.g[1] = g[hd]; R.g[2] = g[24 + hd]; R.g[3] = g[16 + hd]; }
    if (tid < 256) R.nin = WSP(float, WS_NIN)[((size_t)n * 16 + (tid >> 7) * 8 + hd) * 128 + (tid & 127)];
    if (wave < 2) R.min_ = WSP(float, WS_MIN)[(size_t)n * 16 + wave * 8 + hd];
}
__device__ __forceinline__ void ml_pre_commit(const MlPre& R, LAS bf16_t* Qt, LAS float* vec, int tid) {
    LAS bf16_t* KP = Qt + 128 * TLD; LAS bf16_t* Vt = KP + 128 * TLD; LAS bf16_t* Ct = Vt + 128 * TLD;
#pragma unroll
    for (int i = 0; i < 4; ++i) { const int idx = tid + NTHR * i, o = (idx >> 4) * TLD + (idx & 15) * 8;
        *(LAS bf16x8*)(Qt + o) = R.q[i]; *(LAS bf16x8*)(KP + o) = R.k[i]; *(LAS bf16x8*)(Vt + o) = R.v[i]; *(LAS bf16x8*)(Ct + o) = R.c[i]; }
    if (tid < 128) { vec[tid] = log_sigmoidf_(R.g[0]); vec[128 + tid] = R.g[1]; vec[256 + tid] = log_sigmoidf_(R.g[2]); vec[384 + tid] = R.g[3]; }
    if (tid < 256) vec[2688 + tid] = R.nin;
}
__device__ __forceinline__ void ml_out_loop(const Frame& F, int l, int it0) {
  if (it0 >= NCH * 8) return;
  LAS bf16_t* Qt = (LAS bf16_t*)(F.lds + LDS_RING); LAS bf16_t* KP = Qt + 128 * TLD; LAS bf16_t* Vt = KP + 128 * TLD; LAS bf16_t* Ct = Vt + 128 * TLD;
  LAS float* vec = (LAS float*)(Ct + 128 * TLD);
  float m_cur;
  { MlPre R0; ml_pre_issue(R0, F, it0, F.tid, F.wave); ml_pre_commit(R0, Qt, vec, F.tid); m_cur = R0.min_; }
  __syncthreads();
#pragma unroll 1
  for (int item = it0; item < NCH * 8; item += F.G) {
    int tz_ = F.tid; asm volatile("" : "+v"(tz_));
    const int hd = item & 7, n = item >> 3; const int tid = tz_, lane = tz_ & 63, wave = F.wave;
    const bf16_t* P = WSP(bf16_t, WS_P);
    const size_t r0 = (size_t)n * 128;
    bf16x8 c1r[4];
    if (wave < 2) { const int dir = wave; const MlStats s = ml_cum(vec + dir * 256, vec + dir * 256 + 128, dir, lane);
        const float m_in = m_cur;
        const float inc = wave_scan_max(fmaxf(s.u0, s.u1), lane); float pre = __shfl_up(inc, 1); if (lane == 0) pre = -3.0e38f;
        const float M0 = fmaxf(pre, s.u0), M1 = inc;
        const float mu0 = fmaxf(m_in, M0), mu1 = fmaxf(m_in, M1);
        const int t0 = dir == 0 ? 2 * lane : 127 - 2 * lane, t1 = dir == 0 ? 2 * lane + 1 : 126 - 2 * lane;
        LAS float* v = vec + 512 + dir * 512;
        v[t0] = s.u0; v[t1] = s.u1; v[128 + t0] = mu0; v[128 + t1] = mu1; v[256 + t0] = __expf(m_in - mu0); v[256 + t1] = __expf(m_in - mu1);
        v[384 + t0] = __expf(-(s.cum0 + mu0)); v[384 + t1] = __expf(-(s.cum1 + mu1)); }
    const int wr = wave >> 2, wc = wave & 3, li = lane & 15, lq = lane >> 4;
    f32x4 sacc[4][2];
#pragma unroll
    for (int m = 0; m < 4; ++m)
#pragma unroll
        for (int nn = 0; nn < 2; ++nn) sacc[m][nn] = (f32x4){0.f, 0.f, 0.f, 0.f};
#pragma unroll
    for (int ks = 0; ks < 4; ++ks) {
        bf16x8 fq_[4], fk_[2];
#pragma unroll
        for (int m = 0; m < 4; ++m) fq_[m] = frag_kc(Qt, TLD, 64 * wr + 16 * m, 32 * ks, lane);
#pragma unroll
        for (int nn = 0; nn < 2; ++nn) fk_[nn] = frag_kc(KP, TLD, 32 * wc + 16 * nn, 32 * ks, lane);
#pragma unroll
        for (int m = 0; m < 4; ++m)
#pragma unroll
            for (int nn = 0; nn < 2; ++nn) sacc[m][nn] = __builtin_amdgcn_mfma_f32_16x16x32_bf16(fk_[nn], fq_[m], sacc[m][nn], 0, 0, 0);
    }
    __syncthreads();
    f32x4 hs[4][2];
#pragma unroll
    for (int m = 0; m < 4; ++m)
#pragma unroll
        for (int nn = 0; nn < 2; ++nn) hs[m][nn] = (f32x4){0.f, 0.f, 0.f, 0.f};
#pragma unroll 1
    for (int dir = 0; dir < 2; ++dir) {
        const LAS float* v = vec + 512 + dir * 512; const size_t cc = (size_t)n * 16 + dir * 8 + hd;
        if (dir == 1) { const __amdgpu_buffer_rsrc_t rc = __builtin_amdgcn_make_buffer_rsrc((void*)(WSP(bf16_t, WS_CIN) + cc * 16384), (short)0, 32768, 0x00020000);
#pragma unroll
            for (int i = 0; i < 4; ++i) c1r[i] = buf_ld16(rc, (unsigned)tid * 16u, (unsigned)i * 8192u); }
#pragma unroll
        for (int m = 0; m < 4; ++m) { const int j = 64 * wr + 16 * m + li; const float muj = v[128 + j]; float ps = 0.f;
#pragma unroll
            for (int nn = 0; nn < 2; ++nn) { const int s0 = 32 * wc + 16 * nn + 4 * lq; float pv[4];
#pragma unroll
                for (int e = 0; e < 4; ++e) { const int s = s0 + e; const bool ok = dir == 0 ? (s <= j) : (s >= j);
                    pv[e] = ok ? __expf(v[s] - muj) * sacc[m][nn][e] : 0.f; ps += pv[e]; }
                u32x2 w; w.x = cvt_pk_bf16(pv[0], pv[1]); w.y = cvt_pk_bf16(pv[2], pv[3]); *(LAS u32x2*)(KP + j * TLD + s0) = w; }
            ps += __shfl_xor(ps, 16); ps += __shfl_xor(ps, 32);
            if (lq == 0) vec[1664 + j * 4 + wc] = ps; }
        if (dir == 1) {
#pragma unroll
            for (int i = 0; i < 4; ++i) { const int idx = tid + NTHR * i, r = idx >> 4, oc = idx & 15; *(LAS bf16x8*)(Ct + r * TLD + oc * 8) = c1r[i]; } }
        { const int j = tid >> 2, qd = tid & 3; float s_ = 0.f;
          const LAS f32x4* np = (const LAS f32x4*)(vec + 2688 + dir * 128 + qd * 32);
#pragma unroll
          for (int d4 = 0; d4 < 8; ++d4) { const f32x4 nv = np[d4]; const u32x2 qq = *(const LAS u32x2*)(Qt + j * TLD + qd * 32 + d4 * 4);
              s_ += bflo(qq.x) * nv[0] + bfhi(qq.x) * nv[1] + bflo(qq.y) * nv[2] + bfhi(qq.y) * nv[3]; }
          s_ += __shfl_xor(s_, 1); s_ += __shfl_xor(s_, 2);
          if (qd == 0) vec[1536 + j] = s_; }
        __syncthreads();
        f32x4 acc[4][2];
#pragma unroll
        for (int m = 0; m < 4; ++m)
#pragma unroll
            for (int nn = 0; nn < 2; ++nn) acc[m][nn] = (f32x4){0.f, 0.f, 0.f, 0.f};
        { TrFrag tc[2][2]; bf16x8 fq_[4];
#define OC_ISSUE(ks, st) do { _Pragma("unroll") for (int nn = 0; nn < 2; ++nn) frag_tr_issue_p(tc[st][nn], Ct, TLD, 32 * wc, nn, 32 * (ks), lane); } while (0)
#define OC_STEP(ks, st, NW_) do { _Pragma("unroll") for (int m = 0; m < 4; ++m) fq_[m] = frag_kc(Qt, TLD, 64 * wr + 16 * m, 32 * (ks), lane); \
            if ((ks) < 3) OC_ISSUE((ks) + 1, 1 - (st)); if ((ks) < 3) LDS_WAIT(4); else LDS_WAIT(0); SBAR(); \
            _Pragma("unroll") for (int m = 0; m < 4; ++m) _Pragma("unroll") for (int nn = 0; nn < 2; ++nn) \
                acc[m][nn] = __builtin_amdgcn_mfma_f32_16x16x32_bf16(TRGET(tc[st][nn]), fq_[m], acc[m][nn], 0, 0, 0); SBAR(); } while (0)
          OC_ISSUE(0, 0); OC_STEP(0, 0, 0); OC_STEP(1, 1, 0); OC_STEP(2, 0, 0); OC_STEP(3, 1, 0);
#undef OC_ISSUE
#undef OC_STEP
        }
#pragma unroll
        for (int m = 0; m < 4; ++m) { const float ej = v[256 + 64 * wr + 16 * m + li];
#pragma unroll
            for (int nn = 0; nn < 2; ++nn) acc[m][nn] *= ej; }
        { TrFrag tv[2][2]; bf16x8 fp_[4];
#define OV_ISSUE(ks, st) do { _Pragma("unroll") for (int nn = 0; nn < 2; ++nn) frag_tr_issue_p(tv[st][nn], Vt, TLD, 32 * wc, nn, 32 * (ks), lane); } while (0)
#define OV_STEP(ks, st) do { _Pragma("unroll") for (int m = 0; m < 4; ++m) fp_[m] = frag_kc(KP, TLD, 64 * wr + 16 * m, 32 * (ks), lane); \
            if ((ks) < 3) OV_ISSUE((ks) + 1, 1 - (st)); if ((ks) < 3) LDS_WAIT(4); else LDS_WAIT(0); SBAR(); \
            _Pragma("unroll") for (int m = 0; m < 4; ++m) _Pragma("unroll") for (int nn = 0; nn < 2; ++nn) \
                acc[m][nn] = __builtin_amdgcn_mfma_f32_16x16x32_bf16(TRGET(tv[st][nn]), fp_[m], acc[m][nn], 0, 0, 0); SBAR(); } while (0)
          OV_ISSUE(0, 0); OV_STEP(0, 0); OV_STEP(1, 1); OV_STEP(2, 0); OV_STEP(3, 1);
#undef OV_ISSUE
#undef OV_STEP
        }
#pragma unroll
        for (int m = 0; m < 4; ++m) { const int j = 64 * wr + 16 * m + li;
            const float den = v[256 + j] * vec[1536 + j] + (vec[1664 + j * 4] + vec[1664 + j * 4 + 1] + vec[1664 + j * 4 + 2] + vec[1664 + j * 4 + 3]);
            const float inv = __builtin_amdgcn_rcpf(fmaxf(fabsf(den), v[384 + j]));
#pragma unroll
            for (int nn = 0; nn < 2; ++nn) hs[m][nn] += acc[m][nn] * inv; }
        __syncthreads();
    }
    const bool has_next = item + F.G < NCH * 8;
    MlPre R;
    ml_pre_issue(R, F, has_next ? item + F.G : item, tid, wave, has_next);
#pragma unroll
    for (int m = 0; m < 4; ++m) { float ss = dot4(hs[m][0]) + dot4(hs[m][1]); ss += __shfl_xor(ss, 16); ss += __shfl_xor(ss, 32);
        if (lq == 0) vec[2176 + (64 * wr + 16 * m + li) * 4 + wc] = ss; }
    __syncthreads();
    bf16_t* Y = WSP(bf16_t, WS_Y);
#pragma unroll
    for (int m = 0; m < 4; ++m) { const int j = 64 * wr + 16 * m + li; const size_t row = r0 + j;
        const float rstd = rsqrtf((vec[2176 + j * 4] + vec[2176 + j * 4 + 1] + vec[2176 + j * 4 + 2] + vec[2176 + j * 4 + 3]) * (1.f / 128.f) + EPS);
        { const int e0 = 32 * wc + 8 * lq;
            const f32x4 hn0 = *(const f32x4*)(F.head_norm + l * 1024 + hd * 128 + e0), hn1 = *(const f32x4*)(F.head_norm + l * 1024 + hd * 128 + e0 + 4);
            const u32x4 ov = *(const u32x4*)(P + row * PW + S_ML_O + hd * 128 + e0), gv = *(const u32x4*)(P + row * PW + S_ML_G + hd * 128 + e0);
            const float ow[8] = {bflo(ov.x), bfhi(ov.x), bflo(ov.y), bfhi(ov.y), bflo(ov.z), bfhi(ov.z), bflo(ov.w), bfhi(ov.w)};
            const float gw[8] = {bflo(gv.x), bfhi(gv.x), bflo(gv.y), bfhi(gv.y), bflo(gv.z), bfhi(gv.z), bflo(gv.w), bfhi(gv.w)};
            f32x4 y0, y1;
#pragma unroll
            for (int e = 0; e < 4; ++e) {
                y0[e] = (hs[m][0][e] * rstd * hn0[e]) * (gw[e] * __builtin_amdgcn_rcpf((1.f + __expf(-ow[e])) * (1.f + __expf(-gw[e]))));
                y1[e] = (hs[m][1][e] * rstd * hn1[e]) * (gw[4 + e] * __builtin_amdgcn_rcpf((1.f + __expf(-ow[4 + e])) * (1.f + __expf(-gw[4 + e])))); }
            *(u32x4*)(Y + row * DM + 3072 + hd * 128 + e0) = pack8(y0, y1); }
        __builtin_amdgcn_sched_barrier(0); }
    if (has_next) { ml_pre_commit(R, Qt, vec, tid); m_cur = R.min_; }
    __syncthreads();
  }
}

template <int DQK, int LDROW>
__device__ __forceinline__ unsigned dma_src_off(int c, int lane, int kcol, int vcol, int rcol) {
    constexpr int KP_ = DQK * 2 + 16, KB_ = 64 * KP_;
    const int B = 1024 * c + 16 * lane;
    if (B < KB_) { const int row = B / KP_, cb = B - row * KP_;
        const int col = cb < 256 ? kcol * 2 + cb : ((DQK == 192 && cb < 384) ? rcol * 2 + (cb - 256) : kcol * 2);
        return (unsigned)(row * (LDROW * 2) + col); }
    const int Bv = B - KB_, sid = Bv >> 9, w16 = (Bv & 511) >> 4, kk = (sid >> 2) * 8 + (w16 >> 2);
    const int key = (kk & ~0xC) | ((kk & 4) << 1) | ((kk & 8) >> 1), col = (sid & 3) * 32 + (w16 & 3) * 8;
    return (unsigned)(key * (LDROW * 2) + (vcol + col) * 2);
}
template <int DQK, bool MASK, int LDROW, class TS, int ABL, bool ODD = false>
__device__ __forceinline__ void attn_dma(const bf16_t* __restrict__ Qrow, const bf16_t* __restrict__ base, int kcol, int vcol, int rcol, const TS ts, int NT, float m_init, float l_init, int qtok,
                                         const bf16_t* __restrict__ Gb, int ldg, bf16_t* __restrict__ Ob, int ldo, LAS unsigned char* ldsb, const int tid_, const int wave) {
    constexpr int KP_ = DQK * 2 + 16, ND = DQK / 16, DMA_KB = 64 * KP_, DMA_STAGE = DMA_KB + 16384, DMA_NCH = DMA_STAGE / 1024, NPW = (DMA_NCH + 7) / 8;
    static_assert(DMA_KB % 1024 == 0, "K region must be whole 1 KiB chunks");
    int tl = tid_; asm volatile("" : "+v"(tl));
    const int tid = tl, lane = tid & 63, r32 = lane & 31, hi = lane >> 5;
    float m_reg = m_init, l_reg = l_init; f32x16 o[4] = {}; bf16x8 qr[ND];
    f32x16 negm;
#pragma unroll
    for (int r = 0; r < 16; ++r) negm[r] = -m_init;
    const bf16_t* Qw = Qrow + hi * 8;
#pragma unroll
    for (int d0 = 0; d0 < ND; ++d0) qr[d0] = *reinterpret_cast<const bf16x8*>(Qw + d0 * 16);
    const __amdgpu_buffer_rsrc_t rs = __builtin_amdgcn_make_buffer_rsrc((void*)base, (short)0, (int)((size_t)T * LDROW * 2), 0x00020000);
    unsigned vsrc[NPW];
#pragma unroll
    for (int i = 0; i < NPW; ++i) { const int c = wave + 8 * i; vsrc[i] = dma_src_off<DQK, LDROW>(c < DMA_NCH ? c : wave, lane, kcol, vcol, rcol); }
    const int krow0 = (int)(uintptr_t)ldsb + r32 * KP_ + hi * 16, vb00 = (int)(uintptr_t)ldsb + DMA_KB + v_rd_base(lane);
#define DMA_TILE(j, stg) do { if (ABL != 2) { const unsigned so_ = (unsigned)ts.row(j) * (unsigned)(LDROW * 2); _Pragma("unroll") for (int i = 0; i < NPW - 1; ++i) \
        __builtin_amdgcn_raw_ptr_buffer_load_lds(rs, (LAS void*)(ldsb + (stg) + 1024 * (wave + 8 * i)), 16, (int)vsrc[i], (int)so_, 0, 0); \
        if (wave + 8 * (NPW - 1) < DMA_NCH) __builtin_amdgcn_raw_ptr_buffer_load_lds(rs, (LAS void*)(ldsb + (stg) + 1024 * (wave + 8 * (NPW - 1))), 16, (int)vsrc[NPW - 1], (int)so_, 0, 0); } } while (0)
#define DMA_WAIT_BAR() do { asm volatile("s_waitcnt vmcnt(0)" ::: "memory"); __builtin_amdgcn_s_barrier(); asm volatile("" ::: "memory"); } while (0)
#define RESC(a) do { if (__any((a) < 1.f)) { const float a_ = (a); _Pragma("unroll") for (int d = 0; d < 4; ++d) _Pragma("unroll") for (int r = 0; r < 16; ++r) o[d][r] *= a_; \
    { const float nm_ = -m_reg; _Pragma("unroll") for (int r = 0; r < 16; ++r) negm[r] = nm_; } } } while (0)
#define KRD(d0, KB_, B0, B1) do { const int ad_ = (KB_) + (d0) * 32; B0 = *(const LAS bf16x8*)(ad_); B1 = *(const LAS bf16x8*)(ad_ + 32 * KP_); } while (0)
#define QKT(P0, P1, KB_) do { \
    bf16x8 kf0[3], kf1[3]; KRD(0, KB_, kf0[0], kf1[0]); KRD(1, KB_, kf0[1], kf1[1]); \
    _Pragma("unroll") for (int d0 = 0; d0 < ND; ++d0) { \
        if (d0 + 2 < ND) KRD(d0 + 2, KB_, kf0[(d0 + 2) % 3], kf1[(d0 + 2) % 3]); \
        if (d0 == 0) { P0 = __builtin_amdgcn_mfma_f32_32x32x16_bf16(kf0[0], qr[0], negm, 0, 0, 0); P1 = __builtin_amdgcn_mfma_f32_32x32x16_bf16(kf1[0], qr[0], negm, 0, 0, 0); }     \
        else { P0 = __builtin_amdgcn_mfma_f32_32x32x16_bf16(kf0[d0 % 3], qr[d0], P0, 0, 0, 0); P1 = __builtin_amdgcn_mfma_f32_32x32x16_bf16(kf1[d0 % 3], qr[d0], P1, 0, 0, 0); } } \
    __builtin_amdgcn_sched_group_barrier(0x100, 4, 0); sg_rmv<ND - 2>(); sg_mv<2>(); } while (0)
#define AMASK(P0, P1, j) do { if (MASK && ts.masked(j)) { const int kt0 = ts.tok(j); _Pragma("unroll") for (int r = 0; r < 16; ++r) { \
    const int k0_ = kt0 + crow(r, hi), k1_ = k0_ + 32; const int d0_ = qtok - k0_, d1_ = qtok - k1_; \
    if (d0_ > 128 || d0_ < -128 || k0_ < 0 || k0_ >= SEQ) P0[r] = -1e30f; if (d1_ > 128 || d1_ < -128 || k1_ < 0 || k1_ >= SEQ) P1[r] = -1e30f; } } } while (0)
    f32x16 pA0, pA1, pB0, pB1; float alA, alB; bf16x8 pa0, pa1, pa2, pa3;
    int s_prev = 0, s_cur = DMA_STAGE, s_next = 2 * DMA_STAGE;
    DMA_TILE(0, 0); DMA_TILE(1, DMA_STAGE); DMA_WAIT_BAR();
    QKT(pA0, pA1, krow0); AMASK(pA0, pA1, 0); partialSM<ABL>(pA0, pA1, m_reg, alA);
    RESC(alA);
    for (int j = 1; j + 1 < NT; j += 2) {
        DMA_TILE(j + 1, s_next);
        SBAR(); QKT(pB0, pB1, krow0 + s_cur); AMASK(pB0, pB1, j);
        finishSM<ABL>(pA0, pA1, alA, l_reg, pa0, pa1, pa2, pa3); SBAR();
        pv_d0(o, vb00 + s_prev, pa0, pa1, pa2, pa3); partialSM<ABL>(pB0, pB1, m_reg, alB);
        RESC(alB); DMA_WAIT_BAR();
        { const int t_ = s_prev; s_prev = s_cur; s_cur = s_next; s_next = t_; }
        if (j + 2 < NT) DMA_TILE(j + 2, s_next);
        SBAR(); QKT(pA0, pA1, krow0 + s_cur); AMASK(pA0, pA1, j + 1);
        finishSM<ABL>(pB0, pB1, alB, l_reg, pa0, pa1, pa2, pa3); SBAR();
        pv_d0(o, vb00 + s_prev, pa0, pa1, pa2, pa3); partialSM<ABL>(pA0, pA1, m_reg, alA);
        RESC(alA); DMA_WAIT_BAR();
        { const int t_ = s_prev; s_prev = s_cur; s_cur = s_next; s_next = t_; }
    }
    if (!ODD) {
        SBAR(); QKT(pB0, pB1, krow0 + s_cur); AMASK(pB0, pB1, NT - 1);
        finishSM<ABL>(pA0, pA1, alA, l_reg, pa0, pa1, pa2, pa3); SBAR();
        pv_d0(o, vb00 + s_prev, pa0, pa1, pa2, pa3); partialSM<ABL>(pB0, pB1, m_reg, alB);
        RESC(alB);
        finishSM<ABL>(pB0, pB1, alB, l_reg, pa0, pa1, pa2, pa3); SBAR();
        pv_d0(o, vb00 + s_cur, pa0, pa1, pa2, pa3);
    } else {
        finishSM<ABL>(pA0, pA1, alA, l_reg, pa0, pa1, pa2, pa3); SBAR();
        pv_d0(o, vb00 + s_prev, pa0, pa1, pa2, pa3);
    }
    { const float rl = __builtin_amdgcn_rcpf(l_reg);
      int lz = lane; asm volatile("" : "+v"(lz));
      const int qz = lz & 31, hz = lz >> 5;
      const bf16_t* grow = Gb + (size_t)qz * ldg + 4 * hz; bf16_t* orow = Ob + (size_t)qz * ldo + 8 * hz;
#pragma unroll
      for (int d0 = 0; d0 < 4; ++d0)
#pragma unroll
          for (int gp = 0; gp < 2; ++gp) {
              const int k = 4 * d0 + 2 * gp;
              const u32x2 ga = *(const u32x2*)(grow + 8 * k), gb = *(const u32x2*)(grow + 8 * k + 8);
              const f32x16& od = o[d0];
              const float a0 = od[8 * gp + 0] * rl * siluf_(bflo(ga.x)), a1 = od[8 * gp + 1] * rl * siluf_(bfhi(ga.x)), a2 = od[8 * gp + 2] * rl * siluf_(bflo(ga.y)), a3 = od[8 * gp + 3] * rl * siluf_(bfhi(ga.y));
              const float b0 = od[8 * gp + 4] * rl * siluf_(bflo(gb.x)), b1 = od[8 * gp + 5] * rl * siluf_(bfhi(gb.x)), b2 = od[8 * gp + 6] * rl * siluf_(bflo(gb.y)), b3 = od[8 * gp + 7] * rl * siluf_(bfhi(gb.y));
              const unsigned ax = cvt_pk_bf16(a0, a1), ay = cvt_pk_bf16(a2, a3), bx = cvt_pk_bf16(b0, b1), by = cvt_pk_bf16(b2, b3);
              auto rx = __builtin_amdgcn_permlane32_swap(ax, bx, false, false); auto ry = __builtin_amdgcn_permlane32_swap(ay, by, false, false);
              u32x4 w; w.x = rx[0]; w.y = ry[0]; w.z = rx[1]; w.w = ry[1];
              *(u32x4*)(orow + 8 * k) = w; } }
    __builtin_amdgcn_s_barrier();
#undef DMA_TILE
#undef DMA_WAIT_BAR
#undef RESC
#undef KRD
#undef QKT
#undef AMASK
}

constexpr float LOG2E = 1.4426950408889634f;
constexpr float SCALE_SWA = 0.08838834764831845f, SCALE_MLA = 0.07216878364870322f;
__device__ __forceinline__ void swa_unit(const Frame& F, int l, int unit) {
    const bf16_t* P = WSP(bf16_t, WS_P); bf16_t* Y = WSP(bf16_t, WS_Y);
    const bf16_t* Pq = P; asm volatile("" : "+s"(Pq), "+s"(Y));
    int lz = F.lane; asm volatile("" : "+v"(lz));
    const int r32 = lz & 31;
    const bool is_ctx = unit >= 512; const int u2 = is_ctx ? unit - 512 : unit, g2 = u2 & 1, qc = u2 >> 1;
    const int hq = 4 * g2 + (F.wave >> 1), rloc = 32 * (F.wave & 1);
    const int row0 = (is_ctx ? 0 : CTX) + qc * 64 + rloc;
    const bf16_t* Qrow = Pq + (size_t)(row0 + r32) * PW + S_SWA_Q + hq * 128;
    const bf16_t* Gb = Pq + (size_t)row0 * PW + S_SWA_G + hq * 128; bf16_t* Ob = Y + (size_t)row0 * DM + 1024 + hq * 128;
    const float m_init = F.sink[l * 8 + hq] * LOG2E;
    if (!is_ctx) { TsSwa ts; ts.tb = qc * 64 - 128;
        attn_dma<128, true, PW, TsSwa, 0, true>(Qrow, P, S_SWA_K + g2 * 128, S_SWA_V + g2 * 128, 0, ts, 9, m_init, 1.f, qc * 64 + rloc + r32, Gb, PW, Ob, DM, F.lds + LDS_RING, F.tid, F.wave); }
    else { TsDense ts;
        attn_dma<128, false, PW, TsDense, 0>(Qrow, P, S_SWA_K + g2 * 128, S_SWA_V + g2 * 128, 0, ts, 4, m_init, 1.f, 0, Gb, PW, Ob, DM, F.lds + LDS_RING, F.tid, F.wave); }
}
template <int ABL = 0>
__device__ __forceinline__ void mla_unit(const Frame& F, int unit) {
    const bf16_t* P = WSP(bf16_t, WS_P); bf16_t* Y = WSP(bf16_t, WS_Y); const bf16_t* QM = WSP(bf16_t, WS_QM); const bf16_t* KV = WSP(bf16_t, WS_KV);
    asm volatile("" : "+s"(P), "+s"(Y), "+s"(QM));
    int lz = F.lane; asm volatile("" : "+v"(lz));
    const int r32 = lz & 31;
    const bool is_ctx = unit >= 512; const int h = unit & 7, qb = is_ctx ? 0 : (unit >> 3);
    const int row0 = (is_ctx ? 0 : CTX + qb * 256) + 32 * F.wave;
    const bf16_t* Qrow = QM + (size_t)(row0 + r32) * 1536 + h * 192;
    const bf16_t* Gb = P + (size_t)row0 * PW + S_MLA_G + h * 128; bf16_t* Ob = (ABL ? WSP(bf16_t, WS_H) : Y) + (size_t)row0 * DM + 2048 + h * 128;
    attn_dma<192, false, LDKV, TsDense, ABL>(Qrow, KV, h * 256, h * 256 + 128, 2048, TsDense(), is_ctx ? 4 : T / 64, 0.f, 0.f, 0, Gb, PW, Ob, DM, F.lds + LDS_RING, F.tid, F.wave);
}

#ifndef PHMASK
#define PHMASK 0xFFFF
#endif
#define EN(b) ((PHMASK >> (b)) & 1)
#define IN(k) ph_in(lds, (k))
#define SEAM(k) do { if (IN(k) && IN((k) + 1)) grid_barrier(lds); } while (0)

template <int l>
__device__ __forceinline__ void layer_phases(LAS unsigned char* lds, const int wave0) {
        const int pb = 1 + 7 * l;
        const bool need_ctx = (l == 0);
        if (EN(1) && IN(pb + 0)) REP(1) {
            const Frame F = load_frame(lds, wave0);
            if (l == 0) norm_phase(F, 0, 0, T, 0, F.G);
            else {
                if (F.bid < 16) {
                    pg8::Gemm g{WSP(bf16_t, WS_Y), WSP(bf16_t, WS_WOUT) + (size_t)(l - 1) * DM * DM, CTX, DM, DM, DM, DM};
                    pg8::StaticOrder S; S.init(CTX, DM, 16, F.bid);
                    EpiOut E{WSP(bf16_t, WS_Z), WSP(float, WS_ST2), 0};
                    pg8::gemm_phase<EpiOut>(F.lds + LDS_RING, g, S, E, F.tid);
                }
                { const Frame F2 = load_frame(lds, wave0); norm_phase(F2, l, CTX, T, 16, F2.G - 16); }
            }
        }
        if (l > 0) SEAM(pb + 0);
        if (l > 0 && EN(1) && IN(pb + 1)) { const Frame F = load_frame(lds, wave0); norm_phase(F, l, 0, CTX, 0, F.G); }
        SEAM(pb + 1);
        if (EN(2) && IN(pb + 2)) REP(2) {
            const Frame F = load_frame(lds, wave0);
            pg8::Gemm g{WSP(bf16_t, WS_H), WSP(bf16_t, WS_WIN) + (size_t)l * NPAD * DM, T, NPAD, DM, DM, DM};
            pg8::StaticOrder S; S.init(T, NPAD, F.G, F.bid);
            EpiIn E{WSP(bf16_t, WS_P), WSP(bf16_t, WS_KV), WSP(float, WS_G), WSP(float, WS_ST1), WSP(float, WS_TAB16), WSP(float, WS_TAB32), F.gate_b + l * 32};
            pg8::gemm_phase<EpiIn>(F.lds + LDS_RING, g, S, E, F.tid);
        }
        SEAM(pb + 2);
        if (IN(pb + 3)) {
            if (EN(3)) REP(3) { const Frame F = load_frame(lds, wave0); pg8::Gemm g{WSP(bf16_t, WS_P) + S_CQ, WSP(bf16_t, WS_WUQ) + (size_t)l * 1536 * 768, T, 1536, 768, PW, 768};
              pg8::StaticOrder S; S.init(T, 1536, F.G, F.bid);
              EpiUq E{WSP(bf16_t, WS_QM), WSP(float, WS_ST1), WSP(float, WS_TAB16)};
              pg8::gemm_phase<EpiUq>(F.lds + LDS_RING, g, S, E, F.tid); }
            if (EN(4)) REP(4) { const Frame F = load_frame(lds, wave0); pg8::Gemm g{WSP(bf16_t, WS_P) + S_CKV, WSP(bf16_t, WS_WUKV) + (size_t)l * 2048 * 256, T, 2048, 256, PW, 256};
              pg8::StaticOrder S; S.init(T, 2048, F.G, (F.bid + F.G - 136) % F.G);
              EpiUkv E{WSP(bf16_t, WS_KV), WSP(float, WS_ST1)};
              pg8::gemm_phase<EpiUkv>(F.lds + LDS_RING, g, S, E, F.tid); }
            const int nswa = 512 + (need_ctx ? 8 : 0);
            if (EN(5)) REP(5) { const Frame F = load_frame(lds, wave0); for (int u = (F.bid + F.G - 144) % F.G; u < nswa; u += F.G) swa_unit(F, l, u); }
            if (EN(6)) REP(6) { const Frame F = load_frame(lds, wave0); for (int it = (F.bid + F.G - 152) % F.G; it < NCH * 8; it += F.G) ml_cloc_item(F, it); }
            if (EN(7)) REP(7) { const Frame F = load_frame(lds, wave0); for (int it = (F.bid + F.G - 168) % F.G; it < NCH * 16; it += F.G) lru_item(F, l, it); }
        }
        SEAM(pb + 3);
        if (IN(pb + 4)) {
            if (EN(8)) REP(8) { const Frame F = load_frame(lds, wave0);
                LAS float* sg = (LAS float*)(F.lds + LDS_RING); LAS float* sml = sg + 192;
                const int chain = F.bid >> 4;
                if (F.tid < NCH) { const int n = chunk_at(chain >> 3, F.tid); const float* gm = WSP(float, WS_GM) + ((size_t)n * 16 + chain) * 2; sg[F.tid] = gm[0]; sml[F.tid] = gm[1]; }
                __syncthreads();
                if (F.tid < 128) ml_scan(F, chain, (F.bid & 15) * 128 + F.tid, sg, sml);
                else if (F.tid < 160 && (F.bid & 15) == 0) ml_nscan(F, chain, F.tid - 128, sg, sml);
                else if (F.tid >= 256 && F.bid < 8) lru_carry(F, F.bid * 256 + (F.tid - 256));
                __syncthreads(); }
            const int nmla = 512 + (need_ctx ? 8 : 0);
            if (EN(9)) { const Frame F = load_frame(lds, wave0); for (int u = F.bid; u < nmla; u += F.G) mla_unit<0>(F, u); }
            if (EN(9) && ((REPMASK >> 9) & 1)) { const Frame F = load_frame(lds, wave0); for (int u = F.bid; u < nmla; u += F.G) mla_unit<ABL_KIND>(F, u); }
        }
        SEAM(pb + 4);
        if (IN(pb + 5)) {
            const int n0 = need_ctx ? 0 : 2;
            if (EN(10)) REP(10) { const Frame F = load_frame(lds, wave0); lru_out(F, n0 * 128, need_ctx ? 16 : 0); }
            if (EN(11)) REP(11) { const Frame F = load_frame(lds, wave0); ml_out_loop(F, l, n0 * 8 + F.bid); }
        }
        SEAM(pb + 5);
        if (EN(12) && IN(pb + 6)) REP(12) {
            const Frame F = load_frame(lds, wave0);
            pg8::Gemm g{WSP(bf16_t, WS_Y) + (size_t)CTX * DM, WSP(bf16_t, WS_WOUT) + (size_t)l * DM * DM, SEQ, DM, DM, DM, DM};
            pg8::StaticOrder S; S.init(SEQ, DM, F.G, F.bid);
            EpiOut E{WSP(bf16_t, WS_Z), WSP(float, WS_ST2), CTX};
            pg8::gemm_phase<EpiOut>(F.lds + LDS_RING, g, S, E, F.tid);
        }
        SEAM(pb + 6);
}

constexpr int N_PHASES = 16;
__global__ void __launch_bounds__(NTHR, 2) hybrid_fwd(Args args) {
    extern __shared__ __attribute__((aligned(16))) unsigned char lds_raw[];
    LAS unsigned char* const lds = (LAS unsigned char*)lds_raw;
    const int wave0 = __builtin_amdgcn_readfirstlane((int)threadIdx.x >> 6);
    if (threadIdx.x < 16) ((LAS unsigned*)(lds + LDS_MISC))[threadIdx.x] = 0u;
    if (threadIdx.x < 26) { const unsigned long long p = threadIdx.x < 24 ? (unsigned long long)args.in[threadIdx.x] : (threadIdx.x == 24 ? (unsigned long long)args.out : (unsigned long long)args.ws);
        ((LAS unsigned*)(lds + LDS_PTRS))[2 * threadIdx.x] = (unsigned)p; ((LAS unsigned*)(lds + LDS_PTRS))[2 * threadIdx.x + 1] = (unsigned)(p >> 32); }
    if (threadIdx.x == 0) { ((LAS int*)(lds + LDS_MISC))[8] = args.ph_lo; ((LAS int*)(lds + LDS_MISC))[9] = args.ph_hi; }
    __syncthreads();
    const int lo = args.ph_lo, hi = args.ph_hi;
    if (hi - lo > 1) (void)xcd_barrier_post((unsigned*)(args.ws + WS_CTL), (volatile LAS unsigned*)(lds + LDS_MISC));

    if (EN(0) && IN(0)) REP(0) { const Frame F = load_frame(lds, wave0); p0_prologue(F); }
    SEAM(0);
    layer_phases<0>(lds, wave0);
    layer_phases<1>(lds, wave0);
    if (EN(13) && IN(15)) { const Frame F = load_frame(lds, wave0); norm_phase(F, 2, CTX, T, 0, F.G); }
#undef IN
#undef SEAM
}

#ifndef N_LAUNCHES
#define N_LAUNCHES 1
#endif
extern "C" void kernel_launch(void* const* d_in, const int* in_sizes, int n_in, void* d_out, int out_size, void* d_ws, size_t ws_size, hipStream_t stream) {
    static int grid = 0;
    if (grid == 0) {
        if (n_in != 24 || in_sizes[0] != SEQ * DM || out_size != SEQ * DM || ws_size < WS_END) {
            fprintf(stderr, "kernel_launch: unexpected shapes (n_in %d, in0 %d, out %d, ws %zu, need %zu); nothing launched\n", n_in, n_in > 0 ? in_sizes[0] : -1, out_size, ws_size, (size_t)WS_END); grid = -1; return; }
        int dev = 0, cus = 0;
        if (hipGetDevice(&dev) != hipSuccess || hipDeviceGetAttribute(&cus, hipDeviceAttributeMultiprocessorCount, dev) != hipSuccess) { grid = -1; return; }
        if (hipFuncSetAttribute((const void*)hybrid_fwd, hipFuncAttributeMaxDynamicSharedMemorySize, LDS_BYTES) != hipSuccess) { fprintf(stderr, "kernel_launch: hipFuncSetAttribute failed\n"); grid = -1; return; }
        int per_cu = 0;
        if (hipOccupancyMaxActiveBlocksPerMultiprocessor(&per_cu, (const void*)hybrid_fwd, NTHR, LDS_BYTES) != hipSuccess || per_cu < 1) { fprintf(stderr, "kernel_launch: occupancy query says %d\n", per_cu); }
        (void)hipGetLastError();
        grid = cus;
    }
    if (grid < 0) return;
    (void)hipMemsetAsync((char*)d_ws + WS_CTL, 0, CTL_BYTES + (size_t)2 * 2 * 12288 * 4, stream);
    Args a{};
    for (int i = 0; i < 24; ++i) a.in[i] = (const float*)d_in[i];
    a.out = (float*)d_out; a.ws = (unsigned char*)d_ws;
#ifndef MAX_PHASE
#define MAX_PHASE N_PHASES
#endif
    for (int li = 0; li < N_LAUNCHES && li < MAX_PHASE; ++li) {
        a.ph_lo = (N_LAUNCHES == 1) ? 0 : li; a.ph_hi = (N_LAUNCHES == 1) ? MAX_PHASE : li + 1;
        hipLaunchKernelGGL(hybrid_fwd, dim3(grid), dim3(NTHR), LDS_BYTES, stream, a);
    }
}
```

```cpp
#include <hip/hip_runtime.h>
#include <cstdio>
#include <cstdint>
#include <cmath>

#define LAS __attribute__((address_space(3)))
typedef unsigned short bf16_t;
typedef short bf16x8 __attribute__((ext_vector_type(8)));
typedef short s16x4 __attribute__((ext_vector_type(4)));
typedef float f32x2 __attribute__((ext_vector_type(2)));
typedef float f32x4 __attribute__((ext_vector_type(4)));
typedef float f32x16 __attribute__((ext_vector_type(16)));
typedef unsigned u32x2 __attribute__((ext_vector_type(2)));
typedef unsigned u32x4 __attribute__((ext_vector_type(4)));
typedef unsigned int u32x4v __attribute__((__vector_size__(16)));

constexpr int DM = 4096, SEQ = 16384, CTX = 256, T = SEQ + CTX  , DEPTH = 2;
constexpr int NIN = 11872;
constexpr int PW = 11776;
constexpr int NPAD = 12032;
constexpr int NCH = T / 128;
constexpr int S_LRU_U = 0, S_LRU_G = 1024, S_SWA_Q = 2048, S_SWA_K = 3072, S_SWA_V = 3328, S_SWA_G = 3584, S_CQ = 4608, S_CKV = 5376,
              S_MLA_G = 5632, S_ML_Q = 6656, S_ML_K = 7680, S_ML_V = 8704, S_ML_O = 9728, S_ML_G = 10752, S_MISC = 11776;
constexpr int O_LRU_U = 0, O_LRU_G = 1024, O_SWA_Q = 2048, O_SWA_K = 3072, O_SWA_V = 3328, O_SWA_G = 3584, O_CQ = 4608, O_CKV = 5376, O_KR = 5632,
              O_MLA_G = 5696, O_ML_Q = 6720, O_ML_K = 7744, O_ML_V = 8768, O_ML_O = 9792, O_ML_GT = 10816, O_ML_G = 10848;
constexpr float EPS = 1e-6f;

constexpr size_t al256(size_t x) { return (x + 255) / 256 * 256; }
constexpr size_t WS_CTL = 0;
constexpr size_t CTL_BYTES = 65536;
constexpr size_t WS_MOD = WS_CTL + CTL_BYTES;
constexpr size_t WS_TAB16 = WS_MOD + al256((size_t)2 * 2 * 12288 * 4);
constexpr size_t WS_TAB32 = WS_TAB16 + 256 * 16 * 2 * 4;
constexpr size_t WS_WIN = WS_TAB32 + 256 * 32 * 2 * 4;
constexpr size_t WS_WOUT = WS_WIN + (size_t)2 * NPAD * DM * 2;
constexpr size_t WS_WUQ = WS_WOUT + (size_t)2 * DM * DM * 2;
constexpr size_t WS_WUKV = WS_WUQ + (size_t)2 * 1536 * 768 * 2;
constexpr size_t WS_LRUW = WS_WUKV + (size_t)2 * 2048 * 256 * 2;
constexpr size_t WS_H = WS_LRUW + (size_t)2 * 2 * 2 * 8 * 128 * 128 * 2;
constexpr size_t WS_P = WS_H + (size_t)T * DM * 2;
constexpr size_t WS_KR = WS_P + (size_t)T * PW * 2;
constexpr size_t WS_G = WS_KR + (size_t)T * 64 * 2;
constexpr size_t WS_ST1 = WS_G + (size_t)T * 32 * 4;
constexpr size_t WS_QM = WS_ST1 + (size_t)T * 16 * 4;
constexpr int LDKV = 2112;
constexpr size_t WS_KV = WS_QM + (size_t)T * 1536 * 2;
constexpr size_t WS_Y = WS_KV + (size_t)T * LDKV * 2;
constexpr size_t WS_Z = WS_Y + (size_t)T * DM * 2;
constexpr size_t WS_ST2 = WS_Z + (size_t)T * DM * 2;
constexpr size_t WS_XC = WS_ST2 + (size_t)T * 64 * 4;
constexpr size_t WS_LSUM = WS_XC + (size_t)CTX * DM * 4;
constexpr size_t WS_LCAR = WS_LSUM + (size_t)NCH * 2 * 2 * 1024 * 4;
constexpr size_t WS_CLOC = WS_LCAR + (size_t)NCH * 2 * 1024 * 4;
constexpr size_t WS_NLOC = WS_CLOC + (size_t)NCH * 16 * 16384 * 4;
constexpr size_t WS_GM = WS_NLOC + (size_t)NCH * 16 * 128 * 4;
constexpr size_t WS_CIN = WS_GM + al256((size_t)NCH * 16 * 2 * 4);
constexpr size_t WS_NIN = WS_CIN + (size_t)NCH * 16 * 16384 * 2;
constexpr size_t WS_MIN = WS_NIN + (size_t)NCH * 16 * 128 * 4;
constexpr size_t WS_END = WS_MIN + al256((size_t)NCH * 16 * 4);

__device__ __forceinline__ unsigned cvt_pk_bf16(float lo, float hi) { unsigned r; asm volatile("v_cvt_pk_bf16_f32 %0, %1, %2" : "=v"(r) : "v"(lo), "v"(hi)); return r; }
__device__ __forceinline__ bf16_t f2bf(float x) { return (bf16_t)(cvt_pk_bf16(x, x) & 0xffffu); }
__device__ __forceinline__ float bf2f(bf16_t u) { return __uint_as_float(((unsigned)u) << 16); }
__device__ __forceinline__ float bflo(unsigned w) { return __uint_as_float(w << 16); }
__device__ __forceinline__ float bfhi(unsigned w) { return __uint_as_float(w & 0xffff0000u); }
constexpr float LOG2E = 1.4426950408889634f;
__device__ __forceinline__ float sigmoidf_(float x) { return __builtin_amdgcn_rcpf(1.f + __expf(-x)); }
__device__ __forceinline__ float siluf_(float x) { return x * __builtin_amdgcn_rcpf(1.f + __expf(-x)); }
__device__ __forceinline__ float log_sigmoidf_(float x) { return fminf(x, 0.f) - log1pf(__expf(-fabsf(x))); }
__device__ __forceinline__ float softplusf_(float x) { return fmaxf(x, 0.f) + log1pf(__expf(-fabsf(x))); }

#define XB_TMO      128
#define XB_XCNT(j)  (256  + 64 * (j))
#define XB_XSUB(j)  (1280 + 64 * (j))
#define XB_XGEN(j)  (2304 + 64 * (j))
#define XB_TOP      3328
#define XB_TOPGEN   3392
#define XCD_BAR_WORDS 3456
#define XB_SPIN_CAP (1u << 24)
__device__ __forceinline__ unsigned xb_ld(unsigned* p)              { return __hip_atomic_load(p, __ATOMIC_RELAXED, __HIP_MEMORY_SCOPE_AGENT); }
__device__ __forceinline__ unsigned xb_add(unsigned* p, unsigned v) { return __hip_atomic_fetch_add(p, v, __ATOMIC_RELAXED, __HIP_MEMORY_SCOPE_AGENT); }
__device__ __forceinline__ unsigned xb_xcc_id() { return (unsigned)__builtin_amdgcn_s_getreg((3 << 11) | 20) & 0xFu; }
#define XB_SPIN(cond, bar) do { unsigned _sp = 0; while (cond) { __builtin_amdgcn_s_sleep(1); \
    if ((++_sp & 255u) == 0u) { if (xb_ld(&(bar)[XB_TMO])) break; if (_sp > XB_SPIN_CAP) { atomicAdd(&(bar)[XB_TMO], 1u); break; } } } } while (0)
struct XcdBarrier { unsigned* bar; unsigned x; volatile LAS unsigned* st; };
__device__ __forceinline__ XcdBarrier xcd_barrier_post(unsigned* bar, volatile LAS unsigned* st) {
    XcdBarrier b; b.bar = bar; b.x = xb_xcc_id(); b.st = st;
    if (threadIdx.x == 0) (void)xb_add(&bar[XB_XCNT(b.x)], 1u);
    return b;
}
__device__ __forceinline__ void xcd_barrier_complete(unsigned* bar, unsigned x, unsigned& nloc, unsigned& nx) {
    const unsigned G = gridDim.x * gridDim.y * gridDim.z;
    unsigned sum, cnt, mine, sp = 0u;
    for (;;) {
        sum = 0u; cnt = 0u; mine = 0u;
#pragma unroll
        for (unsigned j = 0; j < 16; ++j) { const unsigned c = xb_ld(&bar[XB_XCNT(j)]); sum += c; cnt += (c > 0u) ? 1u : 0u; mine = (j == x) ? c : mine; }
        if (sum == G) break;
        __builtin_amdgcn_s_sleep(1);
        if ((++sp & 255u) == 0u) { if (xb_ld(&bar[XB_TMO])) break; if (sp > XB_SPIN_CAP) { atomicAdd(&bar[XB_TMO], 1u); break; } }
    }
    nloc = mine > 0u ? mine : 1u; nx = cnt > 0u ? cnt : 1u;
}
__device__ __forceinline__ void xcd_barrier(const XcdBarrier& b) {
    asm volatile("s_waitcnt vmcnt(0)" ::: "memory");
    __syncthreads();
    if (threadIdx.x == 0) {
        unsigned* bar = b.bar;
        __builtin_amdgcn_s_waitcnt(0);
        unsigned nloc = b.st[0], nx = b.st[1];
        if (nloc == 0u) { xcd_barrier_complete(bar, b.x, nloc, nx); b.st[0] = nloc; b.st[1] = nx; }
        const unsigned old = xb_add(&bar[XB_XSUB(b.x)], 1u);
        const unsigned gen = old / nloc;
        if (old + 1u == (gen + 1u) * nloc) {
            __builtin_amdgcn_fence(__ATOMIC_RELEASE, "agent");
            asm volatile("s_waitcnt vmcnt(0)" ::: "memory");
            const unsigned og = xb_add(&bar[XB_TOP], 1u);
            const unsigned tg = og / nx;
            if (og + 1u == (tg + 1u) * nx) xb_add(&bar[XB_TOPGEN], 1u);
            else XB_SPIN(xb_ld(&bar[XB_TOPGEN]) == tg, bar);
            __builtin_amdgcn_fence(__ATOMIC_ACQUIRE, "agent");
            xb_add(&bar[XB_XGEN(b.x)], 1u);
            asm volatile("s_waitcnt vmcnt(0)" ::: "memory");
        } else {
            XB_SPIN(xb_ld(&bar[XB_XGEN(b.x)]) == gen, bar);
            __builtin_amdgcn_fence(__ATOMIC_ACQUIRE, "agent");
            asm volatile("s_waitcnt vmcnt(0)" ::: "memory");
        }
    }
    __syncthreads();
}

namespace pg8 {
constexpr int BM = 256, BK = 64, HALF = 128, HTB = HALF * BK * 2, STAGE_BYTES = 8 * HTB, NXCD = 8, WGM = 8;
__host__ __device__ __forceinline__ int lds_byte(int r, int c) { const int st = (r >> 4) * 2 + (c >> 5), rr = r & 15, cc = c & 31, ob = rr * 64 + cc * 2; return st * 1024 + (ob ^ (((ob >> 9) & 1) << 5)); }
__host__ __device__ __forceinline__ void stage_rc(int b, int& R, int& C) { const int st = b / 1024, sb = b % 1024, swz = sb ^ (((sb >> 9) & 1) << 5); R = (st >> 1) * 16 + swz / 64; C = (st & 1) * 32 + (swz % 64) / 2; }
__host__ __device__ __forceinline__ int perm32(int rho) { const int n = rho >> 4, i = rho & 15; return 8 * (i >> 2) + 4 * n + (i & 3); }
struct Unit { int pm, pn; };
struct Gemm { const bf16_t* A; const bf16_t* Bt; int M, N, K, lda, ldb; };
struct StaticOrder {
    int nM, nN, nwg, G, c;
    __host__ __device__ void init(int M, int N, int G_, int c_) { nM = M / BM; nN = N / BM; nwg = nM * nN; G = G_; c = c_; }
    __host__ __device__ bool next(int i, Unit& u) const {
        const long L = (long)i * G + c; if (L >= nwg) return false;
        int wgid = (int)L; { const int q = nwg / NXCD, r = nwg % NXCD, xcd = wgid % NXCD, off = wgid / NXCD; wgid = (xcd < r ? xcd * (q + 1) : r * (q + 1) + (xcd - r) * q) + off; }
        const int nig = WGM * nN, gid = wgid / nig, fm = gid * WGM, gsz = (nM - fm) < WGM ? (nM - fm) : WGM;
        u.pm = fm + ((wgid % nig) % gsz); u.pn = (wgid % nig) / gsz; return true;
    }
};
template <class Epi>
__device__ __forceinline__ void gemm_phase(LAS unsigned char* lds, const Gemm g, const StaticOrder& S, const Epi& E, const int tid) {
    const int wid = __builtin_amdgcn_readfirstlane(tid >> 6), lane = tid & 63, wr = wid >> 2, wc = wid & 3, fr = lane & 15, fq = lane >> 4;
    const int K = g.K, nt = K / BK;
    unsigned voffA[2], voffB[2], voffB1[2];
#pragma unroll
    for (int i = 0; i < 2; ++i) { int R, C; stage_rc(tid * 16 + i * 8192, R, C); const int Rb = 64 * (R >> 5) + perm32(R & 31);
        voffA[i] = (unsigned)(R * g.lda + C) * 2u; voffB[i] = (unsigned)(Rb * g.ldb + C) * 2u; voffB1[i] = (unsigned)((Rb + 32) * g.ldb + C) * 2u; }
    struct GOff { __amdgpu_buffer_rsrc_t rs; unsigned so; __device__ __forceinline__ GOff operator+(unsigned d) const { return GOff{rs, so + d}; } };
    const unsigned kstep = (unsigned)(BK * 2);
    const unsigned hstepA = (unsigned)HALF * (unsigned)g.lda * 2u, hstepB = (unsigned)HALF * (unsigned)g.ldb * 2u;
    const unsigned tstepA = 2u * hstepA, tstepB = 2u * hstepB;
    const __amdgpu_buffer_rsrc_t rsA = __builtin_amdgcn_make_buffer_rsrc((void*)g.A, (short)0, (int)0xFFFFFFF0u, 0x00020000), rsB = __builtin_amdgcn_make_buffer_rsrc((void*)g.Bt, (short)0, (int)0xFFFFFFF0u, 0x00020000);
    const unsigned ldsw = (unsigned)wid * 1024u;
    const int aoff = lds_byte(wr * 64 + fr, fq * 8), boff = lds_byte(wc * 32 + fr, fq * 8);
#define PG8_SA(b, h) (((b) * 2 + (h)) * HTB)
#define PG8_SB(b, h) ((4 + (b) * 2 + (h)) * HTB)
#define PG8_STAGE(bufoff, gbase, voff) do { _Pragma("unroll") for (int _i = 0; _i < 2; ++_i) \
        __builtin_amdgcn_raw_ptr_buffer_load_lds((gbase).rs, (LAS void*)(lds + (bufoff) + ldsw + _i * 8192), 16, (int)(voff)[_i], (int)(gbase).so, 0, 0); } while (0)
#define PG8_LDA(dst, b, h) do { _Pragma("unroll") for (int m = 0; m < 4; ++m) _Pragma("unroll") for (int k = 0; k < 2; ++k) dst[m][k] = *(const LAS bf16x8*)(lds + PG8_SA(b, h) + aoff + m * 2048 + k * 1024); } while (0)
#define PG8_LDB(dst, b, h) do { _Pragma("unroll") for (int n = 0; n < 2; ++n) _Pragma("unroll") for (int k = 0; k < 2; ++k) dst[n][k] = *(const LAS bf16x8*)(lds + PG8_SB(b, h) + boff + n * 2048 + k * 1024); } while (0)
#define PG8_MMA(ai, bj, At, Bt) do { __builtin_amdgcn_s_setprio(1); _Pragma("unroll") for (int m = 0; m < 4; ++m) _Pragma("unroll") for (int n = 0; n < 2; ++n) _Pragma("unroll") for (int k = 0; k < 2; ++k) \
        acc[ai][bj][m][n] = __builtin_amdgcn_mfma_f32_16x16x32_bf16(Bt[n][k], At[m][k], acc[ai][bj][m][n], 0, 0, 0); __builtin_amdgcn_s_setprio(0); } while (0)
#define PG8_WAIT_V(n) asm volatile("s_waitcnt vmcnt(" #n ")" ::: "memory")
#define PG8_WAIT_L(n) asm volatile("s_waitcnt lgkmcnt(" #n ")" ::: "memory")
#define PG8_BAR __builtin_amdgcn_s_barrier()
#define PG8_SCHED __builtin_amdgcn_sched_barrier(0)
    Unit cur, nxt; int ui = 0;
    if (!S.next(0, cur)) return;
    f32x4 acc[2][2][4][2];
#pragma unroll
    for (int a = 0; a < 2; ++a)
#pragma unroll
        for (int b = 0; b < 2; ++b)
#pragma unroll
            for (int m = 0; m < 4; ++m)
#pragma unroll
                for (int n = 0; n < 2; ++n) acc[a][b][m][n] = (f32x4){0.f, 0.f, 0.f, 0.f};
    bf16x8 At[4][2], B0[2][2], B1[2][2];
    GOff cA{rsA, (unsigned)cur.pm * tstepA}, cB{rsB, (unsigned)cur.pn * tstepB};
    PG8_STAGE(PG8_SB(0, 0), cB, voffB); PG8_STAGE(PG8_SA(0, 0), cA, voffA); PG8_STAGE(PG8_SB(0, 1), cB, voffB1); PG8_STAGE(PG8_SA(0, 1), cA + hstepA, voffA);
    if (wr == 1) PG8_BAR;
    PG8_WAIT_V(4); PG8_BAR;
    PG8_STAGE(PG8_SB(1, 0), cB + kstep, voffB); PG8_STAGE(PG8_SA(1, 0), cA + kstep, voffA); PG8_STAGE(PG8_SB(1, 1), cB + kstep, voffB1);
    PG8_WAIT_V(6); PG8_BAR;
    for (;;) {
        const bool has_next = S.next(ui + 1, nxt);
        const GOff nA{rsA, has_next ? (unsigned)nxt.pm * tstepA : cA.so}, nB{rsB, has_next ? (unsigned)nxt.pn * tstepB : cB.so};
#pragma unroll 1
        for (int t = 0; t < nt; t += 2) {
            const bool last = (t == nt - 2);
            const GOff a1 = cA + (unsigned)(t + 1) * kstep;
            const GOff a2 = last ? nA : cA + (unsigned)(t + 2) * kstep, b2 = last ? nB : cB + (unsigned)(t + 2) * kstep;
            const GOff a3 = a2 + kstep, b3 = b2 + kstep;
            PG8_LDB(B0, 0, 0); PG8_SCHED; PG8_LDA(At, 0, 0); PG8_STAGE(PG8_SA(1, 1), a1 + hstepA, voffA);
            PG8_WAIT_L(8); PG8_BAR; PG8_WAIT_L(0); PG8_MMA(0, 0, At, B0); PG8_BAR; PG8_SCHED;
            PG8_LDB(B1, 0, 1); PG8_STAGE(PG8_SB(0, 0), b2, voffB);
            PG8_BAR; PG8_WAIT_L(0); PG8_MMA(0, 1, At, B1); PG8_BAR;
            PG8_LDA(At, 0, 1); PG8_STAGE(PG8_SA(0, 0), a2, voffA);
            PG8_BAR; PG8_WAIT_L(0); PG8_MMA(1, 0, At, B0); PG8_BAR; PG8_SCHED;
            PG8_STAGE(PG8_SB(0, 1), b2, voffB1);
            PG8_WAIT_V(6); PG8_BAR; PG8_MMA(1, 1, At, B1); PG8_BAR;
            PG8_LDB(B0, 1, 0); PG8_SCHED; PG8_LDA(At, 1, 0); PG8_STAGE(PG8_SA(0, 1), a2 + hstepA, voffA);
            PG8_WAIT_L(8); PG8_BAR; PG8_WAIT_L(0); PG8_MMA(0, 0, At, B0); PG8_BAR; PG8_SCHED;
            PG8_LDB(B1, 1, 1); PG8_STAGE(PG8_SB(1, 0), b3, voffB);
            PG8_BAR; PG8_WAIT_L(0); PG8_MMA(0, 1, At, B1); PG8_BAR;
            PG8_LDA(At, 1, 1); PG8_STAGE(PG8_SA(1, 0), a3, voffA);
            PG8_BAR; PG8_WAIT_L(0); PG8_MMA(1, 0, At, B0); PG8_BAR; PG8_SCHED;
            PG8_STAGE(PG8_SB(1, 1), b3, voffB1);
            PG8_WAIT_V(6); PG8_BAR; PG8_MMA(1, 1, At, B1); PG8_BAR;
        }
        E(acc, cur, wr, wc, fr, fq);
        if (!has_next) break;
#pragma unroll
        for (int a = 0; a < 2; ++a)
#pragma unroll
            for (int b = 0; b < 2; ++b)
#pragma unroll
                for (int m = 0; m < 4; ++m)
#pragma unroll
                    for (int n = 0; n < 2; ++n) acc[a][b][m][n] = (f32x4){0.f, 0.f, 0.f, 0.f};
        cur = nxt; cA = nA; cB = nB; ++ui;
    }
    PG8_WAIT_V(0);
    if (wr == 0) PG8_BAR;
    PG8_BAR;
#undef PG8_SA
#undef PG8_SB
#undef PG8_STAGE
#undef PG8_LDA
#undef PG8_LDB
#undef PG8_MMA
#undef PG8_WAIT_V
#undef PG8_WAIT_L
#undef PG8_BAR
#undef PG8_SCHED
}
}

constexpr int NTHR = 512, NWAVE = 8;
constexpr int LDS_MISC = 0;
constexpr int LDS_RING = 512;
constexpr int LDS_BYTES = 155648;
constexpr int RING_BYTES = LDS_BYTES - LDS_RING;

#ifndef REPMASK
#define REPMASK 0
#endif
#define REP(b) _Pragma("unroll 1") for (int rep_ = 0; rep_ < 1 + ((REPMASK >> (b)) & 1); ++rep_)
struct Args {
    const float* in[24]; float* out; unsigned char* ws;
    int ph_lo, ph_hi;
};
struct Frame {
    LAS unsigned char* lds; unsigned char* ws; int tid, lane, wave, G, bid;
    const float *x, *c, *ctx, *c_ctx, *w_mod, *b_mod, *g_pre, *g_post, *w_in, *w_out, *conv_w, *conv_b, *lam, *wa, *ba, *wx, *bx, *sink, *q_norm, *w_uq, *kv_norm, *w_ukv, *gate_b, *head_norm;
    float* out;
};
constexpr int LDS_PTRS = 64;
__device__ __forceinline__ const float* lds_ptr(LAS unsigned char* lds, int k) {
    const LAS unsigned* p = (const LAS unsigned*)(lds + LDS_PTRS) + 2 * k;
    const unsigned lo = __builtin_amdgcn_readfirstlane(p[0]), hi = __builtin_amdgcn_readfirstlane(p[1]);
    typedef __attribute__((address_space(1))) const float gcf_t;
    return (const float*)(gcf_t*)(((unsigned long long)hi << 32) | lo);
}
__device__ __forceinline__ bool ph_in(LAS unsigned char* lds, int k) {
    const int lo = __builtin_amdgcn_readfirstlane(((const LAS int*)(lds + LDS_MISC))[8]), hi = __builtin_amdgcn_readfirstlane(((const LAS int*)(lds + LDS_MISC))[9]);
    return lo <= k && k < hi;
}
__device__ __forceinline__ void grid_barrier(LAS unsigned char* lds) {
    XcdBarrier b; b.bar = (unsigned*)((unsigned char*)lds_ptr(lds, 25) + WS_CTL); b.x = xb_xcc_id(); b.st = (volatile LAS unsigned*)(lds + LDS_MISC);
    xcd_barrier(b);
}
__device__ __forceinline__ Frame load_frame(LAS unsigned char* lds, const int wave0) {
    Frame F; F.lds = lds;
    unsigned z0 = 0u; asm volatile("" : "+v"(z0));
    int t = wave0 * 64 + (int)__builtin_amdgcn_mbcnt_hi(~0u, __builtin_amdgcn_mbcnt_lo(~0u, z0)); asm volatile("" : "+v"(t));
    F.tid = t; F.lane = t & 63; F.wave = wave0; F.G = gridDim.x; F.bid = blockIdx.x;
    F.x = lds_ptr(lds, 0); F.c = lds_ptr(lds, 1); F.ctx = lds_ptr(lds, 2); F.c_ctx = lds_ptr(lds, 3); F.w_mod = lds_ptr(lds, 4); F.b_mod = lds_ptr(lds, 5); F.g_pre = lds_ptr(lds, 6); F.g_post = lds_ptr(lds, 7);
    F.w_in = lds_ptr(lds, 8); F.w_out = lds_ptr(lds, 9); F.conv_w = lds_ptr(lds, 10); F.conv_b = lds_ptr(lds, 11); F.lam = lds_ptr(lds, 12); F.wa = lds_ptr(lds, 13); F.ba = lds_ptr(lds, 14); F.wx = lds_ptr(lds, 15);
    F.bx = lds_ptr(lds, 16); F.sink = lds_ptr(lds, 17); F.q_norm = lds_ptr(lds, 18); F.w_uq = lds_ptr(lds, 19); F.kv_norm = lds_ptr(lds, 20); F.w_ukv = lds_ptr(lds, 21); F.gate_b = lds_ptr(lds, 22); F.head_norm = lds_ptr(lds, 23);
    F.out = (float*)lds_ptr(lds, 24); F.ws = (unsigned char*)lds_ptr(lds, 25);
    return F;
}
#define WSP(T_, off) ((T_*)(F.ws + (off)))

__device__ __forceinline__ void rope4(f32x4& x1, f32x4& x2, const float* tp) {
    const f32x4 a = *(const f32x4*)tp, b = *(const f32x4*)(tp + 4);
    const float c0 = a[0], s0 = a[1], c1 = a[2], s1 = a[3], c2 = b[0], s2 = b[1], c3 = b[2], s3 = b[3];
    f32x4 o1, o2;
    o1[0] = x1[0] * c0 - x2[0] * s0; o2[0] = x2[0] * c0 + x1[0] * s0;
    o1[1] = x1[1] * c1 - x2[1] * s1; o2[1] = x2[1] * c1 + x1[1] * s1;
    o1[2] = x1[2] * c2 - x2[2] * s2; o2[2] = x2[2] * c2 + x1[2] * s2;
    o1[3] = x1[3] * c3 - x2[3] * s3; o2[3] = x2[3] * c3 + x1[3] * s3;
    x1 = o1; x2 = o2;
}
__device__ __forceinline__ void rope4v(f32x4& x1, f32x4& x2, const f32x4& a, const f32x4& b) {
    const float c0 = a[0], s0 = a[1], c1 = a[2], s1 = a[3], c2 = b[0], s2 = b[1], c3 = b[2], s3 = b[3];
    f32x4 o1, o2;
    o1[0] = x1[0] * c0 - x2[0] * s0; o2[0] = x2[0] * c0 + x1[0] * s0;
    o1[1] = x1[1] * c1 - x2[1] * s1; o2[1] = x2[1] * c1 + x1[1] * s1;
    o1[2] = x1[2] * c2 - x2[2] * s2; o2[2] = x2[2] * c2 + x1[2] * s2;
    o1[3] = x1[3] * c3 - x2[3] * s3; o2[3] = x2[3] * c3 + x1[3] * s3;
    x1 = o1; x2 = o2;
}
__device__ __forceinline__ u32x4 pack8(const f32x4& v0, const f32x4& v1) {
    u32x4 w; w.x = cvt_pk_bf16(v0[0], v0[1]); w.y = cvt_pk_bf16(v0[2], v0[3]); w.z = cvt_pk_bf16(v1[0], v1[1]); w.w = cvt_pk_bf16(v1[2], v1[3]); return w;
}
__device__ __forceinline__ float dot4(const f32x4& v) { return v[0] * v[0] + v[1] * v[1] + v[2] * v[2] + v[3] * v[3]; }

struct EpiIn {
    static constexpr bool PERM = true;
    bf16_t* P; bf16_t* KR; float* G; float* ST1; const float* tab16; const float* tab32; const float* gate_b; const LAS float* lt32;
    __device__ __forceinline__ void operator()(const f32x4 (&acc)[2][2][4][2], const pg8::Unit& u, int wr, int wc, int fr, int fq) const {
        const int pn = u.pn, rowb = u.pm * 256 + wr * 64 + fr;
        if (pn < 46) {
            const bool rope = (pn >= 8 && pn <= 12) && (u.pm >= 1);
            const bool stat = (pn >= 18 && pn <= 21);
            if (rope) {
#pragma unroll
                for (int ai = 0; ai < 2; ++ai) {
                    f32x4 ra[2], rb[2];
                    if (!(wc & 1)) {
#pragma unroll
                        for (int bj = 0; bj < 2; ++bj) { const float* tp = tab32 + ((4 * (u.pm - 1) + wr + 2 * ai) * 32 + 16 * bj + 4 * fq) * 2; ra[bj] = *(const f32x4*)tp; rb[bj] = *(const f32x4*)(tp + 4); }
                    }
#pragma unroll
                    for (int m = 0; m < 4; ++m) { const int row = rowb + ai * 128 + m * 16;
#pragma unroll
                        for (int bj = 0; bj < 2; ++bj) {
                            f32x4 v0 = acc[ai][bj][m][0], v1 = acc[ai][bj][m][1];
                            if (wc & 1) { const LAS float* tp = lt32 + ((fr + 16 * m) * 32 + 16 * bj + 4 * fq) * 2; const f32x4 ca_ = *(const LAS f32x4*)tp, cb_ = *(const LAS f32x4*)(tp + 4); rope4v(v0, v1, ca_, cb_); }
                            else rope4v(v0, v1, ra[bj], rb[bj]);
                            *(u32x4*)(P + (size_t)row * PW + pn * 256 + wc * 64 + bj * 32 + 8 * fq) = pack8(v0, v1);
                        }
                    }
                }
            } else {
#pragma unroll
            for (int ai = 0; ai < 2; ++ai)
#pragma unroll
                for (int m = 0; m < 4; ++m) {
                    const int row = rowb + ai * 128 + m * 16;
                    float ss = 0.f;
#pragma unroll
                    for (int bj = 0; bj < 2; ++bj) {
                        const f32x4 v0 = acc[ai][bj][m][0], v1 = acc[ai][bj][m][1];
                        if (stat) ss += dot4(v0) + dot4(v1);
                        *(u32x4*)(P + (size_t)row * PW + pn * 256 + wc * 64 + bj * 32 + 8 * fq) = pack8(v0, v1);
                    }
                    if (stat) { ss += __shfl_xor(ss, 16); ss += __shfl_xor(ss, 32); if (fq == 0) ST1[(size_t)row * 16 + (pn - 18) * 4 + wc] = ss; }
                }
            }
        } else {
#pragma unroll
            for (int ai = 0; ai < 2; ++ai)
#pragma unroll
                for (int m = 0; m < 4; ++m) {
                    const int row = rowb + ai * 128 + m * 16, t = row - 256, trow = t >> 6, tcol = t & 63;
                    if (wc == 0) {
#pragma unroll
                        for (int bj = 0; bj < 2; ++bj) { f32x4 v0 = acc[ai][bj][m][0], v1 = acc[ai][bj][m][1];
                            if (u.pm >= 1) { const int pos = (bj == 0) ? trow : tcol; rope4(v0, v1, tab16 + (pos * 16 + 4 * fq) * 2); }
                            *(u32x4*)(KR + (size_t)row * LDKV + 2048 + 32 * bj + 8 * fq) = pack8(v0, v1); }
                    } else if (wc == 1) {
                        const f32x4 v0 = acc[ai][0][m][0], v1 = acc[ai][0][m][1];
                        const f32x4 b0 = *(const f32x4*)(gate_b + 8 * fq), b1 = *(const f32x4*)(gate_b + 8 * fq + 4);
                        *(f32x4*)(G + (size_t)row * 32 + 8 * fq) = v0 + b0; *(f32x4*)(G + (size_t)row * 32 + 8 * fq + 4) = v1 + b1;
                    }
                }
        }
    }
};
struct EpiUq {
    static constexpr bool PERM = true;
    bf16_t* QM; const float* ST1; const float* tab16; const LAS float* lt16;
    __device__ __forceinline__ void operator()(const f32x4 (&acc)[2][2][4][2], const pg8::Unit& u, int wr, int wc, int fr, int fq) const {
        const int pn = u.pn, rowb = u.pm * 256 + wr * 64 + fr;
        const bool ropew = ((8 * pn + 2 * wc) % 6 == 4) && (u.pm >= 1);
        f32x4 ra[2], rb[2];
#pragma unroll
        for (int ai = 0; ai < 2; ++ai) { const float* tp = tab16 + ((ropew ? 4 * (u.pm - 1) + wr + 2 * ai : 0) * 16 + 4 * fq) * 2; ra[ai] = *(const f32x4*)tp; rb[ai] = *(const f32x4*)(tp + 4); }
        float rstd[2][4];
#pragma unroll
        for (int ai = 0; ai < 2; ++ai)
#pragma unroll
            for (int m = 0; m < 4; ++m) { const int row = rowb + ai * 128 + m * 16;
                const f32x4 s0 = *(const f32x4*)(ST1 + (size_t)row * 16 + (fq < 3 ? fq : 0) * 4);
                float ssum = fq < 3 ? (s0[0] + s0[1]) + (s0[2] + s0[3]) : 0.f; ssum += __shfl_xor(ssum, 16); ssum += __shfl_xor(ssum, 32);
                rstd[ai][m] = rsqrtf(ssum * (1.f / 768.f) + EPS) * (0.07216878364870322f * 1.4426950408889634f); }
#pragma unroll
        for (int ai = 0; ai < 2; ++ai)
#pragma unroll
            for (int m = 0; m < 4; ++m) { const int row = rowb + ai * 128 + m * 16;
#pragma unroll
                for (int bj = 0; bj < 2; ++bj) {
                    f32x4 v0 = acc[ai][bj][m][0] * rstd[ai][m], v1 = acc[ai][bj][m][1] * rstd[ai][m];
                    if (ropew) { if (bj == 0) rope4v(v0, v1, ra[ai], rb[ai]);
                                 else { const LAS float* tp = lt16 + ((fr + 16 * m) * 16 + 4 * fq) * 2; const f32x4 ca_ = *(const LAS f32x4*)tp, cb_ = *(const LAS f32x4*)(tp + 4); rope4v(v0, v1, ca_, cb_); } }
                    *(u32x4*)(QM + (size_t)row * 1536 + pn * 256 + wc * 64 + bj * 32 + 8 * fq) = pack8(v0, v1);
                }
            }
    }
};
struct EpiUkv {
    static constexpr bool PERM = true;
    bf16_t* KV; const float* ST1;
    __device__ __forceinline__ void operator()(const f32x4 (&acc)[2][2][4][2], const pg8::Unit& u, int wr, int wc, int fr, int fq) const {
        const int pn = u.pn, rowb = u.pm * 256 + wr * 64 + fr;
        float rstdv[2][4];
#pragma unroll
        for (int ai = 0; ai < 2; ++ai)
#pragma unroll
            for (int m = 0; m < 4; ++m) { const f32x4 s0 = *(const f32x4*)(ST1 + (size_t)(rowb + ai * 128 + m * 16) * 16 + 12);
                rstdv[ai][m] = rsqrtf((s0[0] + s0[1] + s0[2] + s0[3]) * (1.f / 256.f) + EPS); }
#pragma unroll
        for (int ai = 0; ai < 2; ++ai)
#pragma unroll
            for (int m = 0; m < 4; ++m) {
                const int row = rowb + ai * 128 + m * 16;
                const float rstd = rstdv[ai][m];
#pragma unroll
                for (int bj = 0; bj < 2; ++bj) {
                    const f32x4 v0 = acc[ai][bj][m][0] * rstd, v1 = acc[ai][bj][m][1] * rstd;
                    *(u32x4*)(KV + (size_t)row * LDKV + pn * 256 + wc * 64 + bj * 32 + 8 * fq) = pack8(v0, v1);
                }
            }
    }
};
struct EpiOut {
    static constexpr bool PERM = true;
    bf16_t* Z; float* ST2; int row0;
    __device__ __forceinline__ void operator()(const f32x4 (&acc)[2][2][4][2], const pg8::Unit& u, int wr, int wc, int fr, int fq) const {
        const int pn = u.pn, rowb = row0 + u.pm * 256 + wr * 64 + fr;
#pragma unroll
        for (int ai = 0; ai < 2; ++ai)
#pragma unroll
            for (int m = 0; m < 4; ++m) {
                const int row = rowb + ai * 128 + m * 16;
                float ss = 0.f;
#pragma unroll
                for (int bj = 0; bj < 2; ++bj) {
                    const f32x4 v0 = acc[ai][bj][m][0], v1 = acc[ai][bj][m][1];
                    ss += dot4(v0) + dot4(v1);
                    *(u32x4*)(Z + (size_t)row * DM + pn * 256 + wc * 64 + bj * 32 + 8 * fq) = pack8(v0, v1);
                }
                ss += __shfl_xor(ss, 16); ss += __shfl_xor(ss, 32);
                if (fq == 0) ST2[(size_t)row * 64 + pn * 4 + wc] = ss;
            }
    }
};

__device__ __forceinline__ int swa_perm(int sh) { const int g = sh >> 5, fq = (sh >> 3) & 3, n = (sh >> 2) & 1, j = sh & 3; return 64 * (g >> 1) + 32 * n + 16 * (g & 1) + 4 * fq + j; }
__device__ __forceinline__ int rope64_perm(int s) { const int g = s >> 5, fq = (s >> 3) & 3, n = (s >> 2) & 1, j = s & 3; return 32 * g + 16 * n + 4 * fq + j; }
struct CmWin {
    __device__ __forceinline__ int operator()(int s, float& sc) const {
        if (s < S_SWA_Q) return s;
        if (s < S_SWA_K) { const int x = s - S_SWA_Q; sc = 0.08838834764831845f * 1.4426950408889634f; return O_SWA_Q + (x & ~127) + swa_perm(x & 127); }
        if (s < S_SWA_V) { const int x = s - S_SWA_K; return O_SWA_K + (x & ~127) + swa_perm(x & 127); }
        if (s < S_MLA_G) return s;
        if (s < S_ML_Q) return O_MLA_G + (s - S_MLA_G);
        if (s < S_ML_K) return O_ML_Q + (s - S_ML_Q);
        if (s < S_ML_V) { sc = 0.08838834764831845f; return O_ML_K + (s - S_ML_K); }
        if (s < S_ML_O) return O_ML_V + (s - S_ML_V);
        if (s < S_ML_G) return O_ML_O + (s - S_ML_O);
        if (s < S_MISC) return O_ML_G + (s - S_ML_G);
        const int x = s - S_MISC;
        if (x < 64) return O_KR + rope64_perm(x);
        if (x < 96) return O_ML_GT + (x - 64);
        return -1;
    }
};
struct CmId { __device__ __forceinline__ int operator()(int s, float&) const { return s; } };
struct CmUq { __device__ __forceinline__ int operator()(int s, float&) const { const int h = s / 192, x = s - h * 192; return x < 128 ? s : h * 192 + 128 + rope64_perm(x - 128); } };

template <int KT, class CM>
__device__ __forceinline__ void transpose_item(const Frame& F, const float* __restrict__ src, int ld_src, int K, bf16_t* __restrict__ dst, const float* __restrict__ rowscale, const CM& cm, int s0, int k0) {
    constexpr int PW_ = KT / 2 + 1, NJ = KT / 64;
    LAS unsigned* tile = (LAS unsigned*)(F.lds + LDS_RING);
    const int q = F.tid & 15, kp = F.tid >> 4;
    float sc = 1.f; const int col = cm(s0 + 4 * q, sc);
    f32x4 v0[NJ], v1[NJ];
#pragma unroll
    for (int j = 0; j < NJ; ++j) { v0[j] = (f32x4){0.f, 0.f, 0.f, 0.f}; v1[j] = v0[j]; }
    if (col >= 0) {
#pragma unroll
        for (int j = 0; j < NJ; ++j) { const int k = k0 + 2 * (kp + 32 * j);
            v0[j] = __builtin_nontemporal_load((const f32x4*)(src + (size_t)k * ld_src + col)); v1[j] = __builtin_nontemporal_load((const f32x4*)(src + (size_t)(k + 1) * ld_src + col)); }
#pragma unroll
        for (int j = 0; j < NJ; ++j) { const int k = k0 + 2 * (kp + 32 * j); float r0 = sc, r1 = sc; if (rowscale) { r0 *= rowscale[k]; r1 *= rowscale[k + 1]; } v0[j] *= r0; v1[j] *= r1; }
    }
#pragma unroll
    for (int j = 0; j < NJ; ++j)
#pragma unroll
        for (int e = 0; e < 4; ++e) tile[(4 * q + e) * PW_ + kp + 32 * j] = cvt_pk_bf16(v0[j][e], v1[j][e]);
    __syncthreads();
    const int sr = F.tid >> 3, c8 = F.tid & 7;
#pragma unroll
    for (int j = 0; j < NJ; ++j) { const int kc = (c8 + 8 * j) * 4;
        u32x4 w; w.x = tile[sr * PW_ + kc]; w.y = tile[sr * PW_ + kc + 1]; w.z = tile[sr * PW_ + kc + 2]; w.w = tile[sr * PW_ + kc + 3];
        *(u32x4*)(dst + (size_t)(s0 + sr) * K + k0 + 2 * kc) = w; }
    __syncthreads();
}

__device__ __forceinline__ void mod_item(const Frame& F, int item) {
    const int l = item / 384, r = item % 384, kh = r / 192, n0 = (r % 192) * 64;
    LAS float* sc = (LAS float*)(F.lds + LDS_RING); LAS float* red = sc + 4096;
    for (int i = F.tid; i < 2048; i += NTHR) { sc[i] = siluf_(F.c[kh * 2048 + i]); sc[2048 + i] = siluf_(F.c_ctx[kh * 2048 + i]); }
    __syncthreads();
    const int cq = F.lane & 15, kl = (F.lane >> 4) + 4 * F.wave;
    f32x4 a0 = {0.f, 0.f, 0.f, 0.f}, a1 = {0.f, 0.f, 0.f, 0.f};
    const float* wp = F.w_mod + ((size_t)l * DM + kh * 2048) * 12288 + n0 + 4 * cq;
#pragma unroll 16
    for (int i = 0; i < 64; ++i) { const int k = kl + 32 * i; const f32x4 w = __builtin_nontemporal_load((const f32x4*)(wp + (size_t)k * 12288)); a0 += w * sc[k]; a1 += w * sc[2048 + k]; }
#pragma unroll
    for (int j = 0; j < 4; ++j) { red[(kl * 64 + 4 * cq + j) * 2] = a0[j]; red[(kl * 64 + 4 * cq + j) * 2 + 1] = a1[j]; }
    __syncthreads();
    if (F.tid < 128) { const int col = F.tid & 63, v = F.tid >> 6; float s_ = 0.f;
        for (int k2 = 0; k2 < 32; ++k2) s_ += red[(k2 * 64 + col) * 2 + v];
        if (kh == 0) s_ += F.b_mod[l * 12288 + n0 + col];
        atomicAdd(WSP(float, WS_MOD) + (size_t)(l * 2 + v) * 12288 + n0 + col, s_); }
    __syncthreads();
}

__device__ __forceinline__ void rope_tables(const Frame& F) {
    if (F.tid < 48) {
        const bool is32 = F.tid >= 16; const int i = is32 ? F.tid - 16 : F.tid, half = is32 ? 32 : 16;
        const double r = is32 ? 0.7498942093324558 : 0.5623413251903491;
        double f = 1.0; for (int q = 0; q < i; ++q) f *= r;
        double cb = 1.0, sb = f, term_c = 1.0, term_s = f; const double f2 = f * f;
        for (int q = 1; q < 14; ++q) { term_c *= -f2 / (double)((2 * q - 1) * (2 * q)); term_s *= -f2 / (double)((2 * q) * (2 * q + 1)); cb += term_c; sb += term_s; }
        float* tab = is32 ? WSP(float, WS_TAB32) : WSP(float, WS_TAB16);
        double c = 1.0, s = 0.0;
        for (int pos = 0; pos < 256; ++pos) { tab[(pos * half + i) * 2] = (float)c; tab[(pos * half + i) * 2 + 1] = (float)s; const double c2 = c * cb - s * sb; s = s * cb + c * sb; c = c2; }
    }
}

constexpr int NB_WIN = 188 * 16, NB_WOUT = 64 * 16, NB_L = NB_WIN + NB_WOUT, NB_ALL = 2 * NB_L;
struct TDesc { const float* sp; bf16_t* dp; int ld; float sc; bool ok; };
__device__ __forceinline__ TDesc big_item(const Frame& F, int it, int q, int kp) {
    TDesc d; const int l = it / NB_L; int r = it - l * NB_L; d.sc = 1.f;
    if (r < NB_WIN) { const int s0 = (r >> 4) * 64, k0 = (r & 15) * 256; const int col = CmWin()(s0 + 4 * q, d.sc); d.ok = col >= 0; d.ld = NIN;
        d.sp = F.w_in + (size_t)l * DM * NIN + (size_t)(k0 + 2 * kp) * NIN + (col >= 0 ? col : 0); d.dp = WSP(bf16_t, WS_WIN) + (size_t)l * NPAD * DM + (size_t)s0 * DM + k0; }
    else { r -= NB_WIN; const int s0 = (r >> 4) * 64, k0 = (r & 15) * 256; d.ok = true; d.ld = DM;
        d.sp = F.w_out + (size_t)l * DM * DM + (size_t)(k0 + 2 * kp) * DM + s0 + 4 * q; d.dp = WSP(bf16_t, WS_WOUT) + (size_t)l * DM * DM + (size_t)s0 * DM + k0; }
    return d;
}
#define TLOAD(D, V0, V1) do { _Pragma("unroll") for (int j = 0; j < 4; ++j) { if ((D).ok) { V0[j] = __builtin_nontemporal_load((const f32x4*)((D).sp + (size_t)(64 * j) * (D).ld)); \
        V1[j] = __builtin_nontemporal_load((const f32x4*)((D).sp + (size_t)(64 * j + 1) * (D).ld)); } else { V0[j] = (f32x4){0.f, 0.f, 0.f, 0.f}; V1[j] = V0[j]; } } } while (0)
#define TSTEP(D, V0, V1, ITN) do { \
        _Pragma("unroll") for (int j = 0; j < 4; ++j) _Pragma("unroll") for (int e = 0; e < 4; ++e) tile[(4 * q + e) * 129 + kp + 32 * j] = cvt_pk_bf16(V0[j][e] * (D).sc, V1[j][e] * (D).sc); \
        __syncthreads(); \
        bf16_t* dp_ = (D).dp; const int itn_ = (ITN); \
        if (itn_ < NB_ALL) { (D) = big_item(F, itn_, q, kp); TLOAD(D, V0, V1); }       \
        _Pragma("unroll") for (int j = 0; j < 4; ++j) { const int kc = (c8 + 8 * j) * 4; \
            u32x4 w; w.x = tile[sr * 129 + kc]; w.y = tile[sr * 129 + kc + 1]; w.z = tile[sr * 129 + kc + 2]; w.w = tile[sr * 129 + kc + 3]; \
            *(u32x4*)(dp_ + (size_t)sr * DM + 2 * kc) = w; } \
        __syncthreads(); } while (0)
__device__ __forceinline__ void big_transposes(const Frame& F) {
    LAS unsigned* tile = (LAS unsigned*)(F.lds + LDS_RING);
    const int q = F.tid & 15, kp = F.tid >> 4, sr = F.tid >> 3, c8 = F.tid & 7;
    int it = F.bid; if (it >= NB_ALL) return;
    TDesc da = big_item(F, it, q, kp), db = da, dc = da; f32x4 a0[4], a1[4], b0[4], b1[4], c0[4], c1[4];
    TLOAD(da, a0, a1);
    if (it + F.G < NB_ALL) { db = big_item(F, it + F.G, q, kp); TLOAD(db, b0, b1); }
    if (it + 2 * F.G < NB_ALL) { dc = big_item(F, it + 2 * F.G, q, kp); TLOAD(dc, c0, c1); }
    for (; it < NB_ALL; it += 3 * F.G) {
        TSTEP(da, a0, a1, it + 3 * F.G);
        if (it + F.G < NB_ALL) TSTEP(db, b0, b1, it + 4 * F.G);
        if (it + 2 * F.G < NB_ALL) TSTEP(dc, c0, c1, it + 5 * F.G);
    }
}
#undef TLOAD
#undef TSTEP

__device__ __forceinline__ void p0_prologue(const Frame& F) {
    if (F.bid == 0) rope_tables(F);
    for (int it = F.bid; it < 768; it += F.G) mod_item(F, it);
    REP(14) big_transposes(F);
    constexpr int N_UQ = 24 * 3, N_UKV = 32, N_LRU = 32 * 4, N_L = N_UQ + N_UKV + N_LRU;
    for (int it = F.bid; it < 2 * N_L; it += F.G) {
        const int l = it / N_L; int r = it - l * N_L;
        if (r < N_UQ) { transpose_item<256>(F, F.w_uq + (size_t)l * 768 * 1536, 1536, 768, WSP(bf16_t, WS_WUQ) + (size_t)l * 1536 * 768, F.q_norm + l * 768, CmUq(), (r / 3) * 64, (r % 3) * 256); continue; }
        r -= N_UQ;
        if (r < N_UKV) { transpose_item<256>(F, F.w_ukv + (size_t)l * 256 * 2048, 2048, 256, WSP(bf16_t, WS_WUKV) + (size_t)l * 2048 * 256, F.kv_norm + l * 256, CmId(), r * 64, 0); continue; }
        r -= N_UKV;
        { const int mat = r >> 2, q = r & 3, gate = mat >> 4, db = mat & 15;
          const float* src = (gate ? F.wx : F.wa) + ((size_t)l * 16 + db) * 16384;
          bf16_t* dst = WSP(bf16_t, WS_LRUW) + (((size_t)l * 2 + (db >> 3)) * 2 + gate) * 8 * 16384 + (size_t)(db & 7) * 16384;
          transpose_item<64>(F, src, 128, 128, dst, nullptr, CmId(), (q >> 1) * 64, (q & 1) * 64); }
    }
}

__device__ __forceinline__ float wave_sum(float v) {
#pragma unroll
    for (int o = 32; o >= 1; o >>= 1) v += __shfl_xor(v, o);
    return v;
}
typedef unsigned int u32x2v __attribute__((__vector_size__(8)));
__device__ __forceinline__ __amdgpu_buffer_rsrc_t mk_rsrc(const void* p, size_t bytes) { return __builtin_amdgcn_make_buffer_rsrc((void*)p, (short)0, (int)bytes, 0x00020000); }
__device__ __forceinline__ f32x4 bld_f4(__amdgpu_buffer_rsrc_t r, unsigned vo, unsigned so) { const u32x4v v = __builtin_amdgcn_raw_buffer_load_b128(r, (int)vo, (int)so, 0); return __builtin_bit_cast(f32x4, v); }
__device__ __forceinline__ u32x2 bld_u2(__amdgpu_buffer_rsrc_t r, unsigned vo, unsigned so) { const u32x2v v = __builtin_amdgcn_raw_buffer_load_b64(r, (int)vo, (int)so, 0); return __builtin_bit_cast(u32x2, v); }
__device__ __forceinline__ void bst_f4(__amdgpu_buffer_rsrc_t r, unsigned vo, unsigned so, f32x4 x) { __builtin_amdgcn_raw_buffer_store_b128(__builtin_bit_cast(u32x4v, x), r, (int)vo, (int)so, 0); }
__device__ __forceinline__ void bst_u2(__amdgpu_buffer_rsrc_t r, unsigned vo, unsigned so, u32x2 x) { __builtin_amdgcn_raw_buffer_store_b64(__builtin_bit_cast(u32x2v, x), r, (int)vo, (int)so, 0); }
__device__ __forceinline__ void norm_phase(const Frame& F, int l, int row_lo, int row_hi, int blk0, int nblk) {
    if (F.bid < blk0 || F.bid >= blk0 + nblk || row_lo + (F.bid - blk0) * NWAVE >= row_hi) return;
    const float* MOD = WSP(float, WS_MOD);
    const __amdgpu_buffer_rsrc_t rZ = mk_rsrc(WSP(bf16_t, WS_Z), (size_t)T * DM * 2), rH = mk_rsrc(WSP(bf16_t, WS_H), (size_t)T * DM * 2);
    const __amdgpu_buffer_rsrc_t rXC = mk_rsrc(WSP(float, WS_XC), (size_t)CTX * DM * 4), rOut = mk_rsrc(F.out, (size_t)SEQ * DM * 4);
    const __amdgpu_buffer_rsrc_t rX = mk_rsrc(F.x, (size_t)SEQ * DM * 4), rCtx = mk_rsrc(F.ctx, (size_t)CTX * DM * 4);
    const unsigned vo = (unsigned)F.lane * 16u, vo2 = (unsigned)F.lane * 8u;
    LAS float* tab = (LAS float*)(F.lds + LDS_RING);
    { const int v_lo = (l == 0) ? 0 : (row_lo < CTX ? 1 : 0), v_hi = (l == 0) ? 1 : v_lo;
      for (int v = v_lo; v <= v_hi; ++v)
#pragma unroll
          for (int k = 0; k < 2; ++k) { const int c = (F.tid + NTHR * k) * 4;
              if (l < 2) { const f32x4 gp = *(const f32x4*)(F.g_pre + l * DM + c), sc = *(const f32x4*)(MOD + (size_t)(l * 2 + v) * 12288 + DM + c), sh = *(const f32x4*)(MOD + (size_t)(l * 2 + v) * 12288 + c);
                  *(LAS f32x4*)(tab + (v * 3 + 0) * DM + c) = gp * (sc + 1.f); *(LAS f32x4*)(tab + (v * 3 + 1) * DM + c) = sh; }
              if (l >= 1) { const f32x4 gt = *(const f32x4*)(MOD + (size_t)((l - 1) * 2 + v) * 12288 + 2 * DM + c), gq = *(const f32x4*)(F.g_post + (l - 1) * DM + c);
                  *(LAS f32x4*)(tab + (v * 3 + 2) * DM + c) = gt * gq; } } }
    __syncthreads();
    for (int row = row_lo + (F.bid - blk0) * NWAVE + F.wave; row < row_hi; row += nblk * NWAVE) {
        const bool is_ctx = row < CTX;
        const unsigned rr = (unsigned)(is_ctx ? row : row - CTX) * (unsigned)(DM * 4);
        const LAS float* tv = tab + (is_ctx ? 3 : 0) * DM + F.lane * 4;
        f32x4 xv[16];
        if (l <= 1) {
#pragma unroll
            for (int i = 0; i < 16; ++i) xv[i] = is_ctx ? bld_f4(rCtx, vo, rr + i * 1024u) : bld_f4(rX, vo, rr + i * 1024u);
        } else {
#pragma unroll
            for (int i = 0; i < 16; ++i) { if (is_ctx) xv[i] = bld_f4(rXC, vo, rr + i * 1024u);
                else { const u32x2 t = bld_u2(rOut, vo2, rr + i * 512u); xv[i] = (f32x4){bflo(t.x), bfhi(t.x), bflo(t.y), bfhi(t.y)}; } }
        }
        if (l >= 1) {
            u32x2 zzv[16]; const unsigned zo = (unsigned)row * (unsigned)(DM * 2);
            const float st2v = WSP(float, WS_ST2)[(size_t)row * 64 + F.lane];
#pragma unroll
            for (int i = 0; i < 16; ++i) zzv[i] = bld_u2(rZ, vo2, zo + i * 512u);
            const float rstd_z = rsqrtf(wave_sum(st2v) * (1.f / DM) + EPS);
#pragma unroll
            for (int i = 0; i < 16; ++i) {
                const u32x2 zz = zzv[i]; const f32x4 g4 = *(const LAS f32x4*)(tv + 2 * DM + i * 256);
                xv[i][0] += g4[0] * (bflo(zz.x) * rstd_z); xv[i][1] += g4[1] * (bfhi(zz.x) * rstd_z);
                xv[i][2] += g4[2] * (bflo(zz.y) * rstd_z); xv[i][3] += g4[3] * (bfhi(zz.y) * rstd_z);
                if (is_ctx) bst_f4(rXC, vo, rr + i * 1024u, xv[i]);
                else if (l == 1) { u32x2 w; w.x = cvt_pk_bf16(xv[i][0], xv[i][1]); w.y = cvt_pk_bf16(xv[i][2], xv[i][3]); bst_u2(rOut, vo2, rr + i * 512u, w); }
                else bst_f4(rOut, vo, rr + i * 1024u, xv[i]); }
        }
        if (l < 2) {
            float ss = 0.f;
#pragma unroll
            for (int i = 0; i < 16; ++i) ss += dot4(xv[i]);
            const float rstd = rsqrtf(wave_sum(ss) * (1.f / DM) + EPS);
            const unsigned ho = (unsigned)row * (unsigned)(DM * 2);
#pragma unroll
            for (int i = 0; i < 16; ++i) {
                const f32x4 a4 = *(const LAS f32x4*)(tv + i * 256), b4 = *(const LAS f32x4*)(tv + DM + i * 256);
                const float h0 = xv[i][0] * rstd * a4[0] + b4[0], h1 = xv[i][1] * rstd * a4[1] + b4[1];
                const float h2 = xv[i][2] * rstd * a4[2] + b4[2], h3 = xv[i][3] * rstd * a4[3] + b4[3];
                u32x2 w; w.x = cvt_pk_bf16(h0, h1); w.y = cvt_pk_bf16(h2, h3); bst_u2(rH, vo2, ho + i * 512u, w); }
        }
    }
    __syncthreads();
}

#define SBAR() __builtin_amdgcn_sched_barrier(0)
__device__ __forceinline__ int crow(int r, int hi) { return (r & 3) + 8 * (r >> 2) + 4 * hi; }
__device__ __forceinline__ int v_st(int k, int c) { const int kk = (k & ~0xC) | ((k & 4) << 1) | ((k & 8) >> 1); return ((kk >> 3) * 4 + (c >> 5)) * 512 + ((kk & 7) * 32 + (c & 31)) * 2; }
__device__ __forceinline__ int v_rd_base(int lane) { return ((lane & 3) << 3) | (((lane >> 2) & 3) << 6) | (((lane >> 4) & 1) << 5) | (((lane >> 5) & 1) << 8); }
constexpr int v_rd_off(int d0, int ks, int half) { return d0 * 512 + ks * 4096 + half * 2048; }
template <int OFF> __device__ __forceinline__ s16x4 tr_read(int vb) {
    s16x4 r; asm volatile("ds_read_b64_tr_b16 %0, %1 offset:%2" : "=&v"(r) : "v"(vb), "i"(OFF) : "memory"); return r;
}
template <int S> __device__ __forceinline__ void pv_rd(int vb, s16x4& a, s16x4& b, s16x4& c, s16x4& d) {
    a = tr_read<v_rd_off(S >> 1, 2 * (S & 1), 0)>(vb); b = tr_read<v_rd_off(S >> 1, 2 * (S & 1), 1)>(vb);
    c = tr_read<v_rd_off(S >> 1, 2 * (S & 1) + 1, 0)>(vb); d = tr_read<v_rd_off(S >> 1, 2 * (S & 1) + 1, 1)>(vb);
}
#define PVPK(L, H) (bf16x8){L[0], L[1], L[2], L[3], H[0], H[1], H[2], H[3]}
#define PV_STEP(S, OD, PA, PB, CA, CB, CC, CD, NA, NB, NC, ND_) do { if (S < 7) pv_rd<(S < 7 ? S + 1 : 7)>(vb, NA, NB, NC, ND_); \
    if (S < 7) asm volatile("s_waitcnt lgkmcnt(4)" : "+v"(CA), "+v"(CB), "+v"(CC), "+v"(CD) :: "memory"); else asm volatile("s_waitcnt lgkmcnt(0)" : "+v"(CA), "+v"(CB), "+v"(CC), "+v"(CD) :: "memory"); \
    OD = __builtin_amdgcn_mfma_f32_32x32x16_bf16(PVPK(CA, CB), PA, OD, 0, 0, 0); OD = __builtin_amdgcn_mfma_f32_32x32x16_bf16(PVPK(CC, CD), PB, OD, 0, 0, 0); } while (0)
__device__ __forceinline__ void pv_d0(f32x16* o, int vb, bf16x8 pa0, bf16x8 pa1, bf16x8 pa2, bf16x8 pa3) {
    s16x4 a0, b0, c0, d0, a1, b1, c1, d1;
    pv_rd<0>(vb, a0, b0, c0, d0);
    PV_STEP(0, o[0], pa0, pa1, a0, b0, c0, d0, a1, b1, c1, d1);
    PV_STEP(1, o[0], pa2, pa3, a1, b1, c1, d1, a0, b0, c0, d0);
    PV_STEP(2, o[1], pa0, pa1, a0, b0, c0, d0, a1, b1, c1, d1);
    PV_STEP(3, o[1], pa2, pa3, a1, b1, c1, d1, a0, b0, c0, d0);
    PV_STEP(4, o[2], pa0, pa1, a0, b0, c0, d0, a1, b1, c1, d1);
    PV_STEP(5, o[2], pa2, pa3, a1, b1, c1, d1, a0, b0, c0, d0);
    PV_STEP(6, o[3], pa0, pa1, a0, b0, c0, d0, a1, b1, c1, d1);
    PV_STEP(7, o[3], pa2, pa3, a1, b1, c1, d1, a0, b0, c0, d0);
}
#undef PV_STEP
#undef PVPK
constexpr float THR2 = 11.5415603f;
template <int ABL = 0>
__device__ __forceinline__ void partialSM(f32x16& p0, f32x16& p1, float& m_reg, float& alpha) {
    if (ABL == 1) { alpha = 1.f; return; }
    float pmax = p0[0];
#pragma unroll
    for (int r = 1; r < 16; ++r) pmax = fmaxf(pmax, p0[r]);
#pragma unroll
    for (int r = 0; r < 16; ++r) pmax = fmaxf(pmax, p1[r]);
    { auto rr = __builtin_amdgcn_permlane32_swap(__float_as_uint(pmax), __float_as_uint(pmax), false, false);
      pmax = fmaxf(__uint_as_float(rr[0]), __uint_as_float(rr[1])); }
    if (__builtin_expect(__all(pmax <= THR2), 1)) { alpha = 1.f; }
    else { const float sh = fmaxf(pmax, 0.f); alpha = __builtin_amdgcn_exp2f(-sh); m_reg += sh;
#pragma unroll
        for (int r = 0; r < 16; ++r) { p0[r] -= sh; p1[r] -= sh; } }
#pragma unroll
    for (int r = 0; r < 16; ++r) p0[r] = __builtin_amdgcn_exp2f(p0[r]);
}
template <int ABL = 0>
__device__ __forceinline__ void finishSM(f32x16& p0, f32x16& p1, float alpha, float& l_reg, bf16x8& pa0, bf16x8& pa1, bf16x8& pa2, bf16x8& pa3) {
    if (ABL != 1) {
#pragma unroll
    for (int r = 0; r < 16; ++r) p1[r] = __builtin_amdgcn_exp2f(p1[r]); }
    float ps = 0;
    if (ABL != 1) {
#pragma unroll
    for (int r = 0; r < 16; ++r) ps += p0[r];
#pragma unroll
    for (int r = 0; r < 16; ++r) ps += p1[r]; }
    { auto rr = __builtin_amdgcn_permlane32_swap(__float_as_uint(ps), __float_as_uint(ps), false, false);
      ps = __uint_as_float(rr[0]) + __uint_as_float(rr[1]); }
    l_reg = l_reg * alpha + ps;
#define PK4(P, BASE, OUT) do { unsigned a0 = cvt_pk_bf16(P[BASE + 0], P[BASE + 1]), a1 = cvt_pk_bf16(P[BASE + 2], P[BASE + 3]);   \
    unsigned b0 = cvt_pk_bf16(P[BASE + 4], P[BASE + 5]), b1 = cvt_pk_bf16(P[BASE + 6], P[BASE + 7]);                              \
    auto r0 = __builtin_amdgcn_permlane32_swap(a0, b0, false, false); auto r1 = __builtin_amdgcn_permlane32_swap(a1, b1, false, false); \
    u32x4 w = {r0[0], r1[0], r0[1], r1[1]}; OUT = *reinterpret_cast<bf16x8*>(&w); } while (0)
    PK4(p0, 0, pa0); PK4(p0, 8, pa1); PK4(p1, 0, pa2); PK4(p1, 8, pa3);
#undef PK4
}

template <int N> __device__ __forceinline__ void sg_rmv() { if constexpr (N > 0) { __builtin_amdgcn_sched_group_barrier(0x008, 2, 0); __builtin_amdgcn_sched_group_barrier(0x100, 2, 0); sg_rmv<N - 1>(); } }
template <int N> __device__ __forceinline__ void sg_mv() { if constexpr (N > 0) { __builtin_amdgcn_sched_group_barrier(0x008, 2, 0); sg_mv<N - 1>(); } }
struct TsDense { __device__ __forceinline__ int row(int j) const { return 64 * j; } __device__ __forceinline__ int tok(int) const { return 0; } __device__ __forceinline__ bool masked(int) const { return false; } };
struct TsSwa {
    int tb;
    __device__ __forceinline__ int tok(int j) const { return tb + 64 * j; }
    __device__ __forceinline__ bool masked(int j) const { return j < 5 && (j == 0 || j == 4 || tb + 64 * j < 0 || tb + 64 * j + 64 > SEQ); }
    __device__ __forceinline__ int row(int j) const { if (j >= 5) return 64 * (j - 5); int t = tb + 64 * j; t = t < 0 ? 0 : (t > SEQ - 64 ? SEQ - 64 : t); return CTX + t; }
};

__device__ __forceinline__ bf16x8 buf_ld16(__amdgpu_buffer_rsrc_t rs, unsigned voff, unsigned soff) { const u32x4v v = __builtin_amdgcn_raw_buffer_load_b128(rs, (int)voff, (int)soff, 0); return __builtin_bit_cast(bf16x8, v); }
#ifndef ABL_KIND
#define ABL_KIND 0
#endif

constexpr int TLD = 136;
__device__ __forceinline__ bf16x8 frag_kc(const LAS bf16_t* base, int ld, int idx0, int k0, int lane) {
    return *(const LAS bf16x8*)(base + (idx0 + (lane & 15)) * ld + k0 + 8 * (lane >> 4));
}
struct TrFrag { s16x4 lo, hi; };
__device__ __forceinline__ void frag_tr_issue(TrFrag& f, const LAS bf16_t* base, int ld, int idx0, int k0, int lane) {
    const int g = lane >> 4, i = lane & 15, q = i >> 2, p = i & 3;
    const int a = (int)(uintptr_t)(base + (k0 + 8 * g + q) * ld + idx0 + 4 * p);
    asm volatile("ds_read_b64_tr_b16 %0, %1" : "=&v"(f.lo) : "v"(a) : "memory");
    asm volatile("ds_read_b64_tr_b16 %0, %1" : "=&v"(f.hi) : "v"(a + 4 * ld * 2) : "memory");
}
__device__ __forceinline__ void frag_tr_issue_p(TrFrag& f, const LAS bf16_t* base, int ld, int idx32, int nn, int k0, int lane) {
    const int g = lane >> 4, i = lane & 15, q = i >> 2, p = i & 3;
    const int a = (int)(uintptr_t)(base + (k0 + 8 * g + q) * ld + idx32 + 8 * p + 4 * nn);
    asm volatile("ds_read_b64_tr_b16 %0, %1" : "=&v"(f.lo) : "v"(a) : "memory");
    asm volatile("ds_read_b64_tr_b16 %0, %1" : "=&v"(f.hi) : "v"(a + 4 * ld * 2) : "memory");
}
#define TRGET(f) ((bf16x8){(f).lo[0], (f).lo[1], (f).lo[2], (f).lo[3], (f).hi[0], (f).hi[1], (f).hi[2], (f).hi[3]})
#define LDS_WAIT(n) asm volatile("s_waitcnt lgkmcnt(" #n ")" ::: "memory")
__device__ __forceinline__ void load_tile128(LAS bf16_t* dst, const bf16_t* __restrict__ src, size_t ld, int tid) {
#pragma unroll
    for (int i = 0; i < 4; ++i) { const int idx = tid + NTHR * i, r = idx >> 4, oc = idx & 15;
        *(LAS bf16x8*)(dst + r * TLD + oc * 8) = *(const bf16x8*)(src + (size_t)r * ld + oc * 8); }
}
__device__ __forceinline__ float wave_scan_add(float v, int lane) {
#pragma unroll
    for (int o = 1; o < 64; o <<= 1) { const float t = __shfl_up(v, o); if (lane >= o) v += t; }
    return v;
}
__device__ __forceinline__ float wave_scan_max(float v, int lane) {
#pragma unroll
    for (int o = 1; o < 64; o <<= 1) { const float t = __shfl_up(v, o); if (lane >= o) v = fmaxf(v, t); }
    return v;
}
__device__ __forceinline__ float wave_max(float v) {
#pragma unroll
    for (int o = 32; o >= 1; o >>= 1) v = fmaxf(v, __shfl_xor(v, o));
    return v;
}
__device__ __forceinline__ int chunk_at(int dir, int s) { return dir == 0 ? s : (s == 0 ? 1 : (s == 1 ? 0 : 131 - s)); }

constexpr int XLD = 68;
constexpr size_t WS_LH = WS_Z, WS_LA = WS_Z + (size_t)2 * T * 1024 * 2;
__device__ __forceinline__ float fast_sigmoid(float x) { return __builtin_amdgcn_rcpf(1.f + __expf(-x)); }
__device__ __forceinline__ float one_minus_sq(float la, float a) {
    const float x = 2.f * la;
    const float p = -x * (1.f + x * 0.5f * (1.f + x * (1.f / 3.f) * (1.f + x * 0.25f * (1.f + x * 0.2f))));
    return x < -0.25f ? 1.f - a * a : p;
}
#define LRU_F8(CTL) \
    "s_nop 4\n" \
    "v_fmac_f32_dpp %0, %0, %8 " CTL " row_mask:0xf bank_mask:0xf\n" "v_fmac_f32_dpp %1, %1, %9 " CTL " row_mask:0xf bank_mask:0xf\n" \
    "v_fmac_f32_dpp %2, %2, %10 " CTL " row_mask:0xf bank_mask:0xf\n" "v_fmac_f32_dpp %3, %3, %11 " CTL " row_mask:0xf bank_mask:0xf\n" \
    "v_fmac_f32_dpp %4, %4, %12 " CTL " row_mask:0xf bank_mask:0xf\n" "v_fmac_f32_dpp %5, %5, %13 " CTL " row_mask:0xf bank_mask:0xf\n" \
    "v_fmac_f32_dpp %6, %6, %14 " CTL " row_mask:0xf bank_mask:0xf\n" "v_fmac_f32_dpp %7, %7, %15 " CTL " row_mask:0xf bank_mask:0xf\n" \
    "v_mul_f32_dpp %8, %8, %8 " CTL " row_mask:0xf bank_mask:0xf\n" "v_mul_f32_dpp %9, %9, %9 " CTL " row_mask:0xf bank_mask:0xf\n" \
    "v_mul_f32_dpp %10, %10, %10 " CTL " row_mask:0xf bank_mask:0xf\n" "v_mul_f32_dpp %11, %11, %11 " CTL " row_mask:0xf bank_mask:0xf\n" \
    "v_mul_f32_dpp %12, %12, %12 " CTL " row_mask:0xf bank_mask:0xf\n" "v_mul_f32_dpp %13, %13, %13 " CTL " row_mask:0xf bank_mask:0xf\n" \
    "v_mul_f32_dpp %14, %14, %14 " CTL " row_mask:0xf bank_mask:0xf\n" "v_mul_f32_dpp %15, %15, %15 " CTL " row_mask:0xf bank_mask:0xf\n"
#define LRU_STEP8(CTL, A, B) asm volatile(LRU_F8(CTL) : "+v"(B[0]), "+v"(B[1]), "+v"(B[2]), "+v"(B[3]), "+v"(B[4]), "+v"(B[5]), "+v"(B[6]), "+v"(B[7]), \
                                                         "+v"(A[0]), "+v"(A[1]), "+v"(A[2]), "+v"(A[3]), "+v"(A[4]), "+v"(A[5]), "+v"(A[6]), "+v"(A[7]))
template <int DIR> __device__ __forceinline__ void lru_row_scan8(float (&A)[8], float (&B)[8]) {
    if (DIR == 0) { LRU_STEP8("row_shr:1", A, B); LRU_STEP8("row_shr:2", A, B); LRU_STEP8("row_shr:4", A, B); LRU_STEP8("row_shr:8", A, B); }
    else          { LRU_STEP8("row_shl:1", A, B); LRU_STEP8("row_shl:2", A, B); LRU_STEP8("row_shl:4", A, B); LRU_STEP8("row_shl:8", A, B); }
}
#define LRU_C8(CTL) \
    "s_nop 4\n" \
    "v_fmac_f32_dpp %0, %16, %8 " CTL " row_mask:0xf bank_mask:0xf\n" "v_fmac_f32_dpp %1, %17, %9 " CTL " row_mask:0xf bank_mask:0xf\n" \
    "v_fmac_f32_dpp %2, %18, %10 " CTL " row_mask:0xf bank_mask:0xf\n" "v_fmac_f32_dpp %3, %19, %11 " CTL " row_mask:0xf bank_mask:0xf\n" \
    "v_fmac_f32_dpp %4, %20, %12 " CTL " row_mask:0xf bank_mask:0xf\n" "v_fmac_f32_dpp %5, %21, %13 " CTL " row_mask:0xf bank_mask:0xf\n" \
    "v_fmac_f32_dpp %6, %22, %14 " CTL " row_mask:0xf bank_mask:0xf\n" "v_fmac_f32_dpp %7, %23, %15 " CTL " row_mask:0xf bank_mask:0xf\n" \
    "v_mul_f32_dpp %8, %24, %8 " CTL " row_mask:0xf bank_mask:0xf\n" "v_mul_f32_dpp %9, %25, %9 " CTL " row_mask:0xf bank_mask:0xf\n" \
    "v_mul_f32_dpp %10, %26, %10 " CTL " row_mask:0xf bank_mask:0xf\n" "v_mul_f32_dpp %11, %27, %11 " CTL " row_mask:0xf bank_mask:0xf\n" \
    "v_mul_f32_dpp %12, %28, %12 " CTL " row_mask:0xf bank_mask:0xf\n" "v_mul_f32_dpp %13, %29, %13 " CTL " row_mask:0xf bank_mask:0xf\n" \
    "v_mul_f32_dpp %14, %30, %14 " CTL " row_mask:0xf bank_mask:0xf\n" "v_mul_f32_dpp %15, %31, %15 " CTL " row_mask:0xf bank_mask:0xf\n"
#define LRU_CARRY8(CTL, As, Bs, Af, Bf) asm volatile(LRU_C8(CTL) : "+v"(Bs[0]), "+v"(Bs[1]), "+v"(Bs[2]), "+v"(Bs[3]), "+v"(Bs[4]), "+v"(Bs[5]), "+v"(Bs[6]), "+v"(Bs[7]), \
        "+v"(As[0]), "+v"(As[1]), "+v"(As[2]), "+v"(As[3]), "+v"(As[4]), "+v"(As[5]), "+v"(As[6]), "+v"(As[7]) \
        : "v"(Bf[0]), "v"(Bf[1]), "v"(Bf[2]), "v"(Bf[3]), "v"(Bf[4]), "v"(Bf[5]), "v"(Bf[6]), "v"(Bf[7]), "v"(Af[0]), "v"(Af[1]), "v"(Af[2]), "v"(Af[3]), "v"(Af[4]), "v"(Af[5]), "v"(Af[6]), "v"(Af[7]))
template <int DIR>
__device__ __forceinline__ void lru_dir(const Frame& F, int n, int blk, int hf, const LAS bf16_t* Ub, const LAS bf16_t* Wl, LAS float* seg, const LAS float* par, int wr, int wc, int li, int lq, int lane) {
    constexpr int dir = DIR;
    LAS float* segA = seg + dir * 512; LAS float* segH = segA + 256;
    const LAS bf16_t* Wa = Wl + (dir * 2 + 0) * 64 * TLD; const LAS bf16_t* Wx = Wl + (dir * 2 + 1) * 64 * TLD;
    f32x4 ar[2][2], ai[2][2];
#pragma unroll
    for (int m = 0; m < 2; ++m)
#pragma unroll
        for (int nn = 0; nn < 2; ++nn) { ar[m][nn] = (f32x4){0.f, 0.f, 0.f, 0.f}; ai[m][nn] = (f32x4){0.f, 0.f, 0.f, 0.f}; }
#pragma unroll
    for (int ks = 0; ks < 4; ++ks) {
        bf16x8 fu[2], fa[1][2], fx[1][2];
#pragma unroll
        for (int nn = 0; nn < 2; ++nn) { fa[0][nn] = frag_kc(Wa, TLD, 32 * wc + 16 * nn, 32 * ks, lane); fx[0][nn] = frag_kc(Wx, TLD, 32 * wc + 16 * nn, 32 * ks, lane); }
#pragma unroll
        for (int m = 0; m < 2; ++m) fu[m] = frag_kc(Ub, TLD, 32 * wr + 16 * m, 32 * ks, lane);
#pragma unroll
        for (int m = 0; m < 2; ++m)
#pragma unroll
            for (int nn = 0; nn < 2; ++nn) { ar[m][nn] = __builtin_amdgcn_mfma_f32_16x16x32_bf16(fa[0][nn], fu[m], ar[m][nn], 0, 0, 0);
                                             ai[m][nn] = __builtin_amdgcn_mfma_f32_16x16x32_bf16(fx[0][nn], fu[m], ai[m][nn], 0, 0, 0); }
    }
    float A[2][8], B[2][8];
#pragma unroll
    for (int m = 0; m < 2; ++m)
#pragma unroll
        for (int nn = 0; nn < 2; ++nn) { const int tt = 32 * wr + 16 * m + li, chb = 32 * wc + 16 * nn + 4 * lq;
            const u32x2 uu = *(const LAS u32x2*)(Ub + tt * TLD + hf * 64 + chb); const float u4[4] = {bflo(uu.x), bfhi(uu.x), bflo(uu.y), bfhi(uu.y)};
            const f32x4 pa = *(const LAS f32x4*)(par + 128 + dir * 64 + chb), px = *(const LAS f32x4*)(par + 256 + dir * 64 + chb), ps = *(const LAS f32x4*)(par + dir * 64 + chb);
#pragma unroll
            for (int e = 0; e < 4; e += 2) {
                const f32x2 xa = {ar[m][nn][e], ar[m][nn][e + 1]}, xi = {ai[m][nn][e], ai[m][nn][e + 1]};
                const f32x2 ta = xa * (-LOG2E) + (f32x2){pa[e], pa[e + 1]}, ti = xi * (-LOG2E) + (f32x2){px[e], px[e + 1]};
                const f32x2 da = (f32x2){__builtin_amdgcn_exp2f(ta[0]), __builtin_amdgcn_exp2f(ta[1])} + 1.f, di = (f32x2){__builtin_amdgcn_exp2f(ti[0]), __builtin_amdgcn_exp2f(ti[1])} + 1.f;
                const f32x2 r = {__builtin_amdgcn_rcpf(da[0]), __builtin_amdgcn_rcpf(da[1])}, ig = {__builtin_amdgcn_rcpf(di[0]), __builtin_amdgcn_rcpf(di[1])};
                const f32x2 l2 = r * (f32x2){ps[e], ps[e + 1]};
                const f32x2 a_ = {__builtin_amdgcn_exp2f(l2[0]), __builtin_amdgcn_exp2f(l2[1])};
                const f32x2 x = l2 * 1.3862943611198906f;
                f32x2 t = x * (1.f / 24.f) + (1.f / 6.f); t = x * t + 0.5f; t = x * t + 1.f;
                const f32x2 p = -x * t, d = 1.f - a_ * a_;
                const float o0 = x[0] < -0.0625f ? d[0] : p[0], o1 = x[1] < -0.0625f ? d[1] : p[1];
                const f32x2 sq = {__builtin_amdgcn_sqrtf(fmaxf(o0, 0.f)), __builtin_amdgcn_sqrtf(fmaxf(o1, 0.f))};
                const f32x2 b_ = sq * (ig * (f32x2){u4[e], u4[e + 1]});
                A[m][4 * nn + e] = a_[0]; A[m][4 * nn + e + 1] = a_[1]; B[m][4 * nn + e] = b_[0]; B[m][4 * nn + e + 1] = b_[1]; } }
    lru_row_scan8<DIR>(A[0], B[0]); lru_row_scan8<DIR>(A[1], B[1]);
    constexpr int mf = DIR ? 1 : 0, ms = 1 - mf, last = DIR ? 0 : 15;
    if (DIR == 0) LRU_CARRY8("row_newbcast:15", A[ms], B[ms], A[mf], B[mf]); else LRU_CARRY8("row_newbcast:0", A[ms], B[ms], A[mf], B[mf]);
    if (li == last) {
#pragma unroll
        for (int nn = 0; nn < 2; ++nn) { const int chb = 32 * wc + 16 * nn + 4 * lq;
            *(LAS f32x4*)(segA + wr * 64 + chb) = (f32x4){A[ms][4 * nn], A[ms][4 * nn + 1], A[ms][4 * nn + 2], A[ms][4 * nn + 3]};
            *(LAS f32x4*)(segH + wr * 64 + chb) = (f32x4){B[ms][4 * nn], B[ms][4 * nn + 1], B[ms][4 * nn + 2], B[ms][4 * nn + 3]}; } }
    __syncthreads();
    const int pos = DIR ? 3 - wr : wr;
    f32x4 c[2], Pp[2];
#pragma unroll
    for (int nn = 0; nn < 2; ++nn) { c[nn] = (f32x4){0.f, 0.f, 0.f, 0.f}; Pp[nn] = (f32x4){1.f, 1.f, 1.f, 1.f}; }
    for (int s2 = 0; s2 < pos; ++s2) { const int w2 = DIR ? 3 - s2 : s2;
#pragma unroll
        for (int nn = 0; nn < 2; ++nn) { const int chb = 32 * wc + 16 * nn + 4 * lq; const f32x4 a = *(const LAS f32x4*)(segA + w2 * 64 + chb), h = *(const LAS f32x4*)(segH + w2 * 64 + chb);
            c[nn] = a * c[nn] + h; Pp[nn] = Pp[nn] * a; } }
    const size_t r0 = (size_t)n * 128;
    if (pos == 3 && li == last) {
        float* LS = WSP(float, WS_LSUM) + (((size_t)n * 2 + dir) * 2) * 1024 + blk * 128 + hf * 64;
#pragma unroll
        for (int nn = 0; nn < 2; ++nn) { const int chb = 32 * wc + 16 * nn + 4 * lq; f32x4 ta, th;
#pragma unroll
            for (int e = 0; e < 4; ++e) { ta[e] = Pp[nn][e] * A[ms][4 * nn + e]; th[e] = A[ms][4 * nn + e] * c[nn][e] + B[ms][4 * nn + e]; }
            *(f32x4*)(LS + chb) = ta; *(f32x4*)(LS + 1024 + chb) = th; } }
#pragma unroll
    for (int m = 0; m < 2; ++m)
#pragma unroll
        for (int nn = 0; nn < 2; ++nn) { const int tt = 32 * wr + 16 * m + li, chb = 32 * wc + 16 * nn + 4 * lq;
            const size_t go = ((size_t)dir * T + r0 + tt) * 1024 + blk * 128 + hf * 64 + chb;
            u32x2 hw, aw;
            const float* Am = A[m] + 4 * nn; const float* Bm = B[m] + 4 * nn;
            hw.x = cvt_pk_bf16(Bm[0] + Am[0] * c[nn][0], Bm[1] + Am[1] * c[nn][1]); hw.y = cvt_pk_bf16(Bm[2] + Am[2] * c[nn][2], Bm[3] + Am[3] * c[nn][3]);
            aw.x = cvt_pk_bf16(Am[0] * Pp[nn][0], Am[1] * Pp[nn][1]); aw.y = cvt_pk_bf16(Am[2] * Pp[nn][2], Am[3] * Pp[nn][3]);
            *(u32x2*)(WSP(bf16_t, WS_LH) + go) = hw; *(u32x2*)(WSP(bf16_t, WS_LA) + go) = aw; }
}
struct LruIn { u32x4 v[7]; };
__device__ __forceinline__ void lru_in_issue(LruIn& X, const Frame& F, int item, int tid, bool live) {
    const int n = item >> 4, blk = (item >> 1) & 7, oc = tid & 15, tq = tid >> 4, c0 = blk * 128 + oc * 8;
    const int r0 = n * 128, seg_lo = (n < 2) ? 0 : CTX, seg_hi = (n < 2) ? CTX : T;
    const bf16_t* P = WSP(bf16_t, WS_P);
#pragma unroll
    for (int q = 0; q < 7; ++q) { const int r = r0 + tq * 4 - 2 + q;
        u32x4 v = {0u, 0u, 0u, 0u}; if (live && r >= seg_lo && r < seg_hi) v = *(const u32x4*)(P + (size_t)r * PW + S_LRU_U + c0); X.v[q] = v; }
}
__device__ __forceinline__ void lru_conv(const LruIn& X, LAS bf16_t* Ub, const LAS float* cw, int tid) {
    const int oc = tid & 15, tq = tid >> 4;
    float w[4][8], bb[8];
#pragma unroll
    for (int j = 0; j < 4; ++j) { const f32x4 a = *(const LAS f32x4*)(cw + j * 128 + oc * 8), b = *(const LAS f32x4*)(cw + j * 128 + oc * 8 + 4);
        w[j][0] = a[0]; w[j][1] = a[1]; w[j][2] = a[2]; w[j][3] = a[3]; w[j][4] = b[0]; w[j][5] = b[1]; w[j][6] = b[2]; w[j][7] = b[3]; }
    { const f32x4 a = *(const LAS f32x4*)(cw + 512 + oc * 8), b = *(const LAS f32x4*)(cw + 512 + oc * 8 + 4);
        bb[0] = a[0]; bb[1] = a[1]; bb[2] = a[2]; bb[3] = a[3]; bb[4] = b[0]; bb[5] = b[1]; bb[6] = b[2]; bb[7] = b[3]; }
    float xin[7][8];
#pragma unroll
    for (int q = 0; q < 7; ++q) { const u32x4 v = X.v[q];
        xin[q][0] = bflo(v.x); xin[q][1] = bfhi(v.x); xin[q][2] = bflo(v.y); xin[q][3] = bfhi(v.y); xin[q][4] = bflo(v.z); xin[q][5] = bfhi(v.z); xin[q][6] = bflo(v.w); xin[q][7] = bfhi(v.w); }
#pragma unroll
    for (int t4 = 0; t4 < 4; ++t4) { float o[8];
#pragma unroll
        for (int e = 0; e < 8; ++e) o[e] = bb[e] + w[0][e] * xin[t4][e] + w[1][e] * xin[t4 + 1][e] + w[2][e] * xin[t4 + 2][e] + w[3][e] * xin[t4 + 3][e];
        u32x4 pk; pk.x = cvt_pk_bf16(o[0], o[1]); pk.y = cvt_pk_bf16(o[2], o[3]); pk.z = cvt_pk_bf16(o[4], o[5]); pk.w = cvt_pk_bf16(o[6], o[7]);
        *(LAS u32x4*)(Ub + (tq * 4 + t4) * TLD + oc * 8) = pk; }
}
__device__ __forceinline__ void lru_loop(const Frame& F, int l, int it0) {
    if (it0 >= NCH * 16) return;
    const int blk = (it0 >> 1) & 7, hf = it0 & 1;
    LAS bf16_t* Ub0 = (LAS bf16_t*)(F.lds + LDS_RING);
    LAS bf16_t* Wl = Ub0 + 2 * 128 * TLD;
    LAS float* segA = (LAS float*)(Wl + 4 * 64 * TLD);
    LAS float* par = segA + 1024;
    LAS float* cw = par + 384;
    { const int tid = F.tid;
      if (tid < 128) { const int d = tid >> 6, ch = tid & 63, gc = blk * 128 + hf * 64 + ch;
          par[d * 64 + ch] = -8.f * LOG2E * softplusf_(-F.lam[(l * 2 + d) * 1024 + gc]);
          par[128 + d * 64 + ch] = -LOG2E * F.ba[(l * 2 + d) * 1024 + gc]; par[256 + d * 64 + ch] = -LOG2E * F.bx[(l * 2 + d) * 1024 + gc]; }
      if (tid >= 128 && tid < 128 + 160) { const int i = tid - 128, j = i >> 5, c4 = (i & 31) * 4;
          *(LAS f32x4*)(cw + j * 128 + c4) = (j < 4) ? *(const f32x4*)(F.conv_w + ((size_t)l * 4 + j) * 1024 + blk * 128 + c4) : *(const f32x4*)(F.conv_b + l * 1024 + blk * 128 + c4); }
#pragma unroll
      for (int i = 0; i < 8; ++i) { const int idx = tid + NTHR * i, mat = idx >> 10, row = (idx >> 4) & 63, oc = idx & 15;
          const bf16_t* W = WSP(bf16_t, WS_LRUW) + ((((size_t)l * 2 + (mat >> 1)) * 2 + (mat & 1)) * 8 + blk) * 16384;
          *(LAS bf16x8*)(Wl + (mat * 64 + row) * TLD + oc * 8) = *(const bf16x8*)(W + (hf * 64 + row) * 128 + oc * 8); } }
    __syncthreads();
    { LruIn X0; lru_in_issue(X0, F, it0, F.tid, true); lru_conv(X0, Ub0, cw, F.tid); }
    __syncthreads();
    int cur = 0;
#pragma unroll 1
    for (int item = it0; item < NCH * 16; item += F.G) {
        int tz_ = F.tid; asm volatile("" : "+v"(tz_));
        const int tid = tz_, lane = tz_ & 63, wave = F.wave, n = item >> 4;
        const bool has_next = item + F.G < NCH * 16;
        LruIn X; lru_in_issue(X, F, has_next ? item + F.G : item, tid, has_next);
        const int wr = wave >> 1, wc = wave & 1, li = lane & 15, lq = lane >> 4;
        const LAS bf16_t* Ub = Ub0 + cur * 128 * TLD;
        lru_dir<0>(F, n, blk, hf, Ub, Wl, segA, par, wr, wc, li, lq, lane);
        lru_dir<1>(F, n, blk, hf, Ub, Wl, segA, par, wr, wc, li, lq, lane);
        if (has_next) lru_conv(X, Ub0 + (cur ^ 1) * 128 * TLD, cw, tid);
        __syncthreads();
        cur ^= 1;
    }
}
struct LruOutIn { u32x4 hf_, af_, hb_, ab_, gt_; f32x4 cf0, cf1, cb0, cb1; int row, c0; };
__device__ __forceinline__ void lru_out_load(LruOutIn& I, const Frame& F, long i, int row_lo) {
    const bf16_t* P = WSP(bf16_t, WS_P); const bf16_t* LH = WSP(bf16_t, WS_LH); const bf16_t* LA = WSP(bf16_t, WS_LA); const float* LC = WSP(float, WS_LCAR);
    const int row = row_lo + (int)(i >> 7), c0 = (int)(i & 127) * 8, n = row >> 7; I.row = row; I.c0 = c0;
    I.hf_ = *(const u32x4*)(LH + (size_t)row * 1024 + c0); I.af_ = *(const u32x4*)(LA + (size_t)row * 1024 + c0);
    I.hb_ = *(const u32x4*)(LH + ((size_t)T + row) * 1024 + c0); I.ab_ = *(const u32x4*)(LA + ((size_t)T + row) * 1024 + c0);
    I.gt_ = *(const u32x4*)(P + (size_t)row * PW + S_LRU_G + c0);
    I.cf0 = *(const f32x4*)(LC + ((size_t)n * 2 + 0) * 1024 + c0); I.cf1 = *(const f32x4*)(LC + ((size_t)n * 2 + 0) * 1024 + c0 + 4);
    I.cb0 = *(const f32x4*)(LC + ((size_t)n * 2 + 1) * 1024 + c0); I.cb1 = *(const f32x4*)(LC + ((size_t)n * 2 + 1) * 1024 + c0 + 4);
}
__device__ __forceinline__ void lru_out_store(const LruOutIn& I, const Frame& F) {
    bf16_t* Y = WSP(bf16_t, WS_Y);
    const unsigned hw[4] = {I.hf_.x, I.hf_.y, I.hf_.z, I.hf_.w}, aw[4] = {I.af_.x, I.af_.y, I.af_.z, I.af_.w}, hbw[4] = {I.hb_.x, I.hb_.y, I.hb_.z, I.hb_.w}, abw[4] = {I.ab_.x, I.ab_.y, I.ab_.z, I.ab_.w}, gw[4] = {I.gt_.x, I.gt_.y, I.gt_.z, I.gt_.w};
    const float cf[8] = {I.cf0[0], I.cf0[1], I.cf0[2], I.cf0[3], I.cf1[0], I.cf1[1], I.cf1[2], I.cf1[3]}, cb[8] = {I.cb0[0], I.cb0[1], I.cb0[2], I.cb0[3], I.cb1[0], I.cb1[1], I.cb1[2], I.cb1[3]};
    unsigned ow[4];
#pragma unroll
    for (int e = 0; e < 4; ++e) {
        const float y0 = (bflo(hw[e]) + bflo(aw[e]) * cf[2 * e] + bflo(hbw[e]) + bflo(abw[e]) * cb[2 * e]) * siluf_(bflo(gw[e]));
        const float y1 = (bfhi(hw[e]) + bfhi(aw[e]) * cf[2 * e + 1] + bfhi(hbw[e]) + bfhi(abw[e]) * cb[2 * e + 1]) * siluf_(bfhi(gw[e]));
        ow[e] = cvt_pk_bf16(y0, y1); }
    u32x4 o; o.x = ow[0]; o.y = ow[1]; o.z = ow[2]; o.w = ow[3];
    *(u32x4*)(Y + (size_t)I.row * DM + I.c0) = o;
}
__device__ __forceinline__ void lru_out(const Frame& F, int row_lo, int blk0) {
    const long total = (long)(T - row_lo) * 128;
    if (F.bid < blk0) return;
    const long stride = (long)(F.G - blk0) * NTHR;
    long i = (long)(F.bid - blk0) * NTHR + F.tid;
#pragma unroll 1
    for (; i + stride < total; i += 2 * stride) { LruOutIn a, b; lru_out_load(a, F, i, row_lo); lru_out_load(b, F, i + stride, row_lo); lru_out_store(a, F); lru_out_store(b, F); }
    if (i < total) { LruOutIn a; lru_out_load(a, F, i, row_lo); lru_out_store(a, F); }
}
__device__ __forceinline__ void lru_carry(const Frame& F, int chain) {
    const int dir = chain >> 10, c = chain & 1023; const float* LS = WSP(float, WS_LSUM); float* LC = WSP(float, WS_LCAR);
    float h = 0.f;
#pragma unroll 1
    for (int s0 = 0; s0 < NCH; s0 += 26) {
        float A[26], hh[26];
#pragma unroll
        for (int j = 0; j < 26; ++j) { const int n = chunk_at(dir, s0 + j); const size_t b = (((size_t)n * 2 + dir) * 2) * 1024 + c; A[j] = LS[b]; hh[j] = LS[b + 1024]; }
#pragma unroll
        for (int j = 0; j < 26; ++j) { const int n = chunk_at(dir, s0 + j); LC[((size_t)n * 2 + dir) * 1024 + c] = h; h = A[j] * h + hh[j]; }
    }
}

struct MlStats { float cum0, cum1, u0, u1; };
__device__ __forceinline__ MlStats ml_cum(const LAS float* lf, const LAS float* ig, int dir, int lane) {
    MlStats s;
    if (dir == 0) { const float e0 = lf[2 * lane], e1 = lf[2 * lane + 1]; const float inc = wave_scan_add(e0 + e1, lane), pre = inc - (e0 + e1);
        s.cum0 = pre + e0; s.cum1 = inc; }
    else { const float e0 = lf[127 - 2 * lane], e1 = lf[126 - 2 * lane]; const float inc = wave_scan_add(e0 + e1, lane), pre = inc - (e0 + e1);
        s.cum0 = pre + e0; s.cum1 = inc; }
    const int t0 = dir == 0 ? 2 * lane : 127 - 2 * lane, t1 = dir == 0 ? 2 * lane + 1 : 126 - 2 * lane;
    s.u0 = ig[t0] - s.cum0; s.u1 = ig[t1] - s.cum1;
    return s;
}

struct ClPre { bf16x8 k[4], v[4]; float g[4]; };
__device__ __forceinline__ void cl_pre_issue(ClPre& R, const Frame& F, int item, int tid, bool live) {
    const int hd = item & 7, n = item >> 3;
    const __amdgpu_buffer_rsrc_t rp = mk_rsrc(WSP(bf16_t, WS_P) + (size_t)n * 128 * PW + hd * 128, live ? (size_t)128 * PW * 2 : 0);
    const unsigned vp = (unsigned)((tid >> 4) * PW + (tid & 15) * 8) * 2u;
#pragma unroll
    for (int i = 0; i < 4; ++i) { R.k[i] = buf_ld16(rp, vp, (unsigned)(i * 32 * PW + S_ML_K) * 2u); R.v[i] = buf_ld16(rp, vp, (unsigned)(i * 32 * PW + S_ML_V) * 2u); }
    if (tid < 128) { const float* g = WSP(float, WS_G) + ((size_t)n * 128 + tid) * 32; R.g[0] = g[8 + hd]; R.g[1] = g[hd]; R.g[2] = g[24 + hd]; R.g[3] = g[16 + hd]; }
}
__device__ __forceinline__ void cl_pre_commit(const ClPre& R, LAS bf16_t* Kt, LAS float* vec, int tid) {
    LAS bf16_t* Vt = Kt + 128 * TLD;
#pragma unroll
    for (int i = 0; i < 4; ++i) { const int idx = tid + NTHR * i, o = (idx >> 4) * TLD + (idx & 15) * 8; *(LAS bf16x8*)(Kt + o) = R.k[i]; *(LAS bf16x8*)(Vt + o) = R.v[i]; }
    if (tid < 128) { vec[tid] = log_sigmoidf_(R.g[0]); vec[128 + tid] = R.g[1]; vec[256 + tid] = log_sigmoidf_(R.g[2]); vec[384 + tid] = R.g[3]; }
}
__device__ __forceinline__ void ml_cloc_loop(const Frame& F, int it0) {
  if (it0 >= NCH * 8) return;
  LAS bf16_t* Kt = (LAS bf16_t*)(F.lds + LDS_RING); LAS bf16_t* Vt = Kt + 128 * TLD; LAS bf16_t* WK0 = Vt + 128 * TLD; LAS bf16_t* WK1 = WK0 + 128 * TLD;
  LAS float* vec = (LAS float*)(WK1 + 128 * TLD);
  { ClPre R0; cl_pre_issue(R0, F, it0, F.tid, true); cl_pre_commit(R0, Kt, vec, F.tid); }
  __syncthreads();
#pragma unroll 1
  for (int item = it0; item < NCH * 8; item += F.G) {
    int tz_ = F.tid; asm volatile("" : "+v"(tz_));
    const int hd = item & 7, n = item >> 3; const int tid = tz_, lane = tz_ & 63, wave = F.wave;
    const bool has_next = item + F.G < NCH * 8;
    ClPre R; cl_pre_issue(R, F, has_next ? item + F.G : item, tid, has_next);
    if (wave < 2) { const int dir = wave; const MlStats s = ml_cum(vec + dir * 256, vec + dir * 256 + 128, dir, lane);
        const float umax = wave_max(fmaxf(s.u0, s.u1));
        const int t0 = dir == 0 ? 2 * lane : 127 - 2 * lane, t1 = dir == 0 ? 2 * lane + 1 : 126 - 2 * lane;
        vec[512 + dir * 128 + t0] = __expf(s.u0 - umax); vec[512 + dir * 128 + t1] = __expf(s.u1 - umax);
        const float gtot = __shfl(s.cum1, 63);
        if (lane == 0) { float* gm = WSP(float, WS_GM) + ((size_t)n * 16 + dir * 8 + hd) * 2; gm[0] = gtot; gm[1] = gtot + umax; } }
    __syncthreads();
#pragma unroll
    for (int i = 0; i < 4; ++i) { const int idx = tid + NTHR * i, r = idx >> 4, oc = idx & 15; const u32x4 kv = *(const LAS u32x4*)(Kt + r * TLD + oc * 8);
        const float k0 = bflo(kv.x), k1 = bfhi(kv.x), k2 = bflo(kv.y), k3 = bfhi(kv.y), k4 = bflo(kv.z), k5 = bfhi(kv.z), k6 = bflo(kv.w), k7 = bfhi(kv.w);
#pragma unroll
        for (int dir = 0; dir < 2; ++dir) { const float w = vec[512 + dir * 128 + r]; u32x4 o; o.x = cvt_pk_bf16(w * k0, w * k1); o.y = cvt_pk_bf16(w * k2, w * k3); o.z = cvt_pk_bf16(w * k4, w * k5); o.w = cvt_pk_bf16(w * k6, w * k7);
            *(LAS u32x4*)((dir ? WK1 : WK0) + r * TLD + oc * 8) = o; } }
    { const int dir = tid >> 8, d = tid & 127, half = (tid >> 7) & 1; float s_ = 0.f;
#pragma unroll 8
        for (int q = 0; q < 64; ++q) s_ += vec[512 + dir * 128 + half * 64 + q] * bf2f(Kt[(half * 64 + q) * TLD + d]);
        vec[768 + tid] = s_; }
    __syncthreads();
    if (tid < 256) { const int dir = tid >> 7, d = tid & 127; WSP(float, WS_NLOC)[((size_t)n * 16 + dir * 8 + hd) * 128 + d] = vec[768 + dir * 256 + d] + vec[768 + dir * 256 + 128 + d]; }
    const int wr = wave >> 2, wc = wave & 3, li = lane & 15, lq = lane >> 4;
#pragma unroll 1
    for (int dir = 0; dir < 2; ++dir) {
        const LAS bf16_t* WK = dir ? WK1 : WK0;
        f32x4 acc[4][2];
#pragma unroll
        for (int m = 0; m < 4; ++m)
#pragma unroll
            for (int nn = 0; nn < 2; ++nn) acc[m][nn] = (f32x4){0.f, 0.f, 0.f, 0.f};
        TrFrag tk[2][4], tv[2][2];
#define CL_ISSUE(ks, st) do { _Pragma("unroll") for (int m = 0; m < 4; ++m) frag_tr_issue(tk[st][m], WK, TLD, 64 * wr + 16 * m, 32 * (ks), lane); \
            _Pragma("unroll") for (int nn = 0; nn < 2; ++nn) frag_tr_issue_p(tv[st][nn], Vt, TLD, 32 * wc, nn, 32 * (ks), lane); } while (0)
#define CL_MMA(st) do { SBAR(); _Pragma("unroll") for (int m = 0; m < 4; ++m) _Pragma("unroll") for (int nn = 0; nn < 2; ++nn) \
            acc[m][nn] = __builtin_amdgcn_mfma_f32_16x16x32_bf16(TRGET(tv[st][nn]), TRGET(tk[st][m]), acc[m][nn], 0, 0, 0); SBAR(); } while (0)
        CL_ISSUE(0, 0);
        CL_ISSUE(1, 1); LDS_WAIT(12); CL_MMA(0);
        CL_ISSUE(2, 0); LDS_WAIT(12); CL_MMA(1);
        CL_ISSUE(3, 1); LDS_WAIT(12); CL_MMA(0);
        LDS_WAIT(0); CL_MMA(1);
#undef CL_ISSUE
#undef CL_MMA
        bf16_t* CL = WSP(bf16_t, WS_CLOC) + ((size_t)n * 16 + dir * 8 + hd) * 16384;
#pragma unroll
        for (int m = 0; m < 4; ++m) *(u32x4*)(CL + (64 * wr + 16 * m + li) * 128 + 32 * wc + 8 * lq) = pack8(acc[m][0], acc[m][1]);
    }
    __syncthreads();
    if (has_next) cl_pre_commit(R, Kt, vec, tid);
    __syncthreads();
  }
}

constexpr int SCB = 13;
__device__ __forceinline__ void ml_scan(const Frame& F, int chain, int q, const LAS float* sg, const LAS float* sml) {
    const int dir = chain >> 3;
    const bf16_t* CL = WSP(bf16_t, WS_CLOC) + (size_t)chain * 16384 + q * 8; bf16_t* CI = WSP(bf16_t, WS_CIN) + (size_t)chain * 16384 + q * 8; float* MI = WSP(float, WS_MIN) + chain;
    f32x4 C0 = {0.f, 0.f, 0.f, 0.f}, C1 = {0.f, 0.f, 0.f, 0.f}; float m = 0.f;
    u32x4 ca[SCB], cb[SCB];
#define SC_LOAD(buf, s0) do { _Pragma("unroll") for (int j = 0; j < SCB; ++j) { const int n = chunk_at(dir, (s0) + j); buf[j] = *(const u32x4*)(CL + (size_t)n * (16 * 16384)); } } while (0)
#define SC_STEP(buf, s0) do { _Pragma("unroll") for (int j = 0; j < SCB; ++j) { const int s = (s0) + j, n = chunk_at(dir, s); const float g = sg[s], ml = sml[s]; \
        *(u32x4*)(CI + (size_t)n * (16 * 16384)) = pack8(C0, C1); if (q == 0) MI[n * 16] = m; \
        const float mnew = fmaxf(g + m, ml), a = __expf(g + m - mnew), e = __expf(ml - mnew); const u32x4 cl = buf[j]; \
        const f32x4 l0 = {bflo(cl.x), bfhi(cl.x), bflo(cl.y), bfhi(cl.y)}, l1 = {bflo(cl.z), bfhi(cl.z), bflo(cl.w), bfhi(cl.w)}; \
        C0 = C0 * a + l0 * e; C1 = C1 * a + l1 * e; m = mnew; } } while (0)
    SC_LOAD(ca, 0);
#pragma unroll 1
    for (int s0 = 0; s0 < NCH - 2 * SCB; s0 += 2 * SCB) { SC_LOAD(cb, s0 + SCB); SC_STEP(ca, s0); SC_LOAD(ca, s0 + 2 * SCB); SC_STEP(cb, s0 + SCB); }
    SC_LOAD(cb, NCH - SCB); SC_STEP(ca, NCH - 2 * SCB); SC_STEP(cb, NCH - SCB);
#undef SC_LOAD
#undef SC_STEP
}
__device__ __forceinline__ void ml_nscan(const Frame& F, int chain, int q4, const LAS float* sg, const LAS float* sml) {
    const int dir = chain >> 3;
    const float* NL = WSP(float, WS_NLOC) + (size_t)chain * 128 + q4 * 4; float* NI = WSP(float, WS_NIN) + (size_t)chain * 128 + q4 * 4;
    f32x4 nv = {0.f, 0.f, 0.f, 0.f}; float m = 0.f;
#pragma unroll 1
    for (int s0 = 0; s0 < NCH; s0 += SCB) {
        f32x4 nl[SCB];
#pragma unroll
        for (int j = 0; j < SCB; ++j) { const int n = chunk_at(dir, s0 + j); nl[j] = *(const f32x4*)(NL + (size_t)n * 2048); }
#pragma unroll
        for (int j = 0; j < SCB; ++j) { const int s = s0 + j, n = chunk_at(dir, s); const float g = sg[s], ml = sml[s];
            *(f32x4*)(NI + (size_t)n * 2048) = nv;
            const float mnew = fmaxf(g + m, ml), a = __expf(g + m - mnew), e = __expf(ml - mnew);
            nv = nv * a + nl[j] * e; m = mnew; }
    }
}

struct MlPre { bf16x8 q[4], k[4], v[4], c[4]; float g[4], nin, min_; };
__device__ __forceinline__ void ml_pre_issue(MlPre& R, const Frame& F, int item, int tid, int wave, bool live = true) {
    const int hd = item & 7, n = item >> 3;
    const bf16_t* P = WSP(bf16_t, WS_P);
    const __amdgpu_buffer_rsrc_t rp = mk_rsrc(P + (size_t)n * 128 * PW + hd * 128, live ? (size_t)128 * PW * 2 : 0), rc = mk_rsrc(WSP(bf16_t, WS_CIN) + ((size_t)n * 16 + hd) * 16384, live ? 32768 : 0);
    const unsigned vp = (unsigned)((tid >> 4) * PW + (tid & 15) * 8) * 2u;
#pragma unroll
    for (int i = 0; i < 4; ++i) { R.q[i] = buf_ld16(rp, vp, (unsigned)(i * 32 * PW + S_ML_Q) * 2u); R.k[i] = buf_ld16(rp, vp, (unsigned)(i * 32 * PW + S_ML_K) * 2u);
        R.v[i] = buf_ld16(rp, vp, (unsigned)(i * 32 * PW + S_ML_V) * 2u); R.c[i] = buf_ld16(rc, (unsigned)tid * 16u, (unsigned)i * 8192u); }
    if (tid < 128) { const float* g = WSP(float, WS_G) + ((size_t)n * 128 + tid) * 32; R.g[0] = g[8 + hd]; R.g[1] = g[hd]; R.g[2] = g[24 + hd]; R.g[3] = g[16 + hd]; }
    if (tid < 256) R.nin = WSP(float, WS_NIN)[((size_t)n * 16 + (tid >> 7) * 8 + hd) * 128 + (tid & 127)];
    if (wave < 2) R.min_ = WSP(float, WS_MIN)[(size_t)n * 16 + wave * 8 + hd];
}
__device__ __forceinline__ void ml_pre_commit(const MlPre& R, LAS bf16_t* Qt, LAS float* vec, int tid) {
    LAS bf16_t* KP = Qt + 128 * TLD; LAS bf16_t* Vt = KP + 128 * TLD; LAS bf16_t* Ct = Vt + 128 * TLD;
#pragma unroll
    for (int i = 0; i < 4; ++i) { const int idx = tid + NTHR * i, o = (idx >> 4) * TLD + (idx & 15) * 8;
        *(LAS bf16x8*)(Qt + o) = R.q[i]; *(LAS bf16x8*)(KP + o) = R.k[i]; *(LAS bf16x8*)(Vt + o) = R.v[i]; *(LAS bf16x8*)(Ct + o) = R.c[i]; }
    if (tid < 128) { vec[tid] = log_sigmoidf_(R.g[0]); vec[128 + tid] = R.g[1]; vec[256 + tid] = log_sigmoidf_(R.g[2]); vec[384 + tid] = R.g[3]; }
    if (tid < 256) vec[2688 + tid] = R.nin;
}
__device__ __forceinline__ void ml_out_loop(const Frame& F, int l, int it0) {
  if (it0 >= NCH * 8) return;
  LAS bf16_t* Qt = (LAS bf16_t*)(F.lds + LDS_RING); LAS bf16_t* KP = Qt + 128 * TLD; LAS bf16_t* Vt = KP + 128 * TLD; LAS bf16_t* Ct = Vt + 128 * TLD;
  LAS float* vec = (LAS float*)(Ct + 128 * TLD);
  float m_cur;
  { MlPre R0; ml_pre_issue(R0, F, it0, F.tid, F.wave); ml_pre_commit(R0, Qt, vec, F.tid); m_cur = R0.min_; }
  __syncthreads();
#pragma unroll 1
  for (int item = it0; item < NCH * 8; item += F.G) {
    int tz_ = F.tid; asm volatile("" : "+v"(tz_));
    const int hd = item & 7, n = item >> 3; const int tid = tz_, lane = tz_ & 63, wave = F.wave;
    const bf16_t* P = WSP(bf16_t, WS_P);
    const size_t r0 = (size_t)n * 128;
    bf16x8 c1r[4];
    if (wave < 2) { const int dir = wave; const MlStats s = ml_cum(vec + dir * 256, vec + dir * 256 + 128, dir, lane);
        const float m_in = m_cur;
        const float inc = wave_scan_max(fmaxf(s.u0, s.u1), lane); float pre = __shfl_up(inc, 1); if (lane == 0) pre = -3.0e38f;
        const float M0 = fmaxf(pre, s.u0), M1 = inc;
        const float mu0 = fmaxf(m_in, M0), mu1 = fmaxf(m_in, M1);
        const int t0 = dir == 0 ? 2 * lane : 127 - 2 * lane, t1 = dir == 0 ? 2 * lane + 1 : 126 - 2 * lane;
        LAS float* v = vec + 512 + dir * 512;
        v[t0] = s.u0; v[t1] = s.u1; v[128 + t0] = mu0; v[128 + t1] = mu1; v[256 + t0] = __expf(m_in - mu0); v[256 + t1] = __expf(m_in - mu1);
        v[384 + t0] = __expf(-(s.cum0 + mu0)); v[384 + t1] = __expf(-(s.cum1 + mu1)); }
    const int wr = wave >> 2, wc = wave & 3, li = lane & 15, lq = lane >> 4;
    f32x4 sacc[4][2];
#pragma unroll
    for (int m = 0; m < 4; ++m)
#pragma unroll
        for (int nn = 0; nn < 2; ++nn) sacc[m][nn] = (f32x4){0.f, 0.f, 0.f, 0.f};
#pragma unroll
    for (int ks = 0; ks < 4; ++ks) {
        bf16x8 fq_[4], fk_[2];
#pragma unroll
        for (int m = 0; m < 4; ++m) fq_[m] = frag_kc(Qt, TLD, 64 * wr + 16 * m, 32 * ks, lane);
#pragma unroll
        for (int nn = 0; nn < 2; ++nn) fk_[nn] = frag_kc(KP, TLD, 32 * wc + 16 * nn, 32 * ks, lane);
#pragma unroll
        for (int m = 0; m < 4; ++m)
#pragma unroll
            for (int nn = 0; nn < 2; ++nn) sacc[m][nn] = __builtin_amdgcn_mfma_f32_16x16x32_bf16(fk_[nn], fq_[m], sacc[m][nn], 0, 0, 0);
    }
    __syncthreads();
    f32x4 hs[4][2];
#pragma unroll
    for (int m = 0; m < 4; ++m)
#pragma unroll
        for (int nn = 0; nn < 2; ++nn) hs[m][nn] = (f32x4){0.f, 0.f, 0.f, 0.f};
#pragma unroll 1
    for (int dir = 0; dir < 2; ++dir) {
        const LAS float* v = vec + 512 + dir * 512; const size_t cc = (size_t)n * 16 + dir * 8 + hd;
        if (dir == 1) { const __amdgpu_buffer_rsrc_t rc = __builtin_amdgcn_make_buffer_rsrc((void*)(WSP(bf16_t, WS_CIN) + cc * 16384), (short)0, 32768, 0x00020000);
#pragma unroll
            for (int i = 0; i < 4; ++i) c1r[i] = buf_ld16(rc, (unsigned)tid * 16u, (unsigned)i * 8192u); }
#pragma unroll
        for (int m = 0; m < 4; ++m) { const int j = 64 * wr + 16 * m + li; const float muj = v[128 + j]; float ps = 0.f;
#pragma unroll
            for (int nn = 0; nn < 2; ++nn) { const int s0 = 32 * wc + 16 * nn + 4 * lq; float pv[4];
#pragma unroll
                for (int e = 0; e < 4; ++e) { const int s = s0 + e; const bool ok = dir == 0 ? (s <= j) : (s >= j);
                    pv[e] = ok ? __expf(v[s] - muj) * sacc[m][nn][e] : 0.f; ps += pv[e]; }
                u32x2 w; w.x = cvt_pk_bf16(pv[0], pv[1]); w.y = cvt_pk_bf16(pv[2], pv[3]); *(LAS u32x2*)(KP + j * TLD + s0) = w; }
            ps += __shfl_xor(ps, 16); ps += __shfl_xor(ps, 32);
            if (lq == 0) vec[1664 + j * 4 + wc] = ps; }
        if (dir == 1) {
#pragma unroll
            for (int i = 0; i < 4; ++i) { const int idx = tid + NTHR * i, r = idx >> 4, oc = idx & 15; *(LAS bf16x8*)(Ct + r * TLD + oc * 8) = c1r[i]; } }
        { const int j = tid >> 2, qd = tid & 3; float s_ = 0.f;
          const LAS f32x4* np = (const LAS f32x4*)(vec + 2688 + dir * 128 + qd * 32);
#pragma unroll
          for (int d4 = 0; d4 < 8; ++d4) { const f32x4 nv = np[d4]; const u32x2 qq = *(const LAS u32x2*)(Qt + j * TLD + qd * 32 + d4 * 4);
              s_ += bflo(qq.x) * nv[0] + bfhi(qq.x) * nv[1] + bflo(qq.y) * nv[2] + bfhi(qq.y) * nv[3]; }
          s_ += __shfl_xor(s_, 1); s_ += __shfl_xor(s_, 2);
          if (qd == 0) vec[1536 + j] = s_; }
        __syncthreads();
        f32x4 acc[4][2];
#pragma unroll
        for (int m = 0; m < 4; ++m)
#pragma unroll
            for (int nn = 0; nn < 2; ++nn) acc[m][nn] = (f32x4){0.f, 0.f, 0.f, 0.f};
        { TrFrag tc[2][2]; bf16x8 fq_[4];
#define OC_ISSUE(ks, st) do { _Pragma("unroll") for (int nn = 0; nn < 2; ++nn) frag_tr_issue_p(tc[st][nn], Ct, TLD, 32 * wc, nn, 32 * (ks), lane); } while (0)
#define OC_STEP(ks, st, NW_) do { _Pragma("unroll") for (int m = 0; m < 4; ++m) fq_[m] = frag_kc(Qt, TLD, 64 * wr + 16 * m, 32 * (ks), lane); \
            if ((ks) < 3) OC_ISSUE((ks) + 1, 1 - (st)); if ((ks) < 3) LDS_WAIT(4); else LDS_WAIT(0); SBAR(); \
            _Pragma("unroll") for (int m = 0; m < 4; ++m) _Pragma("unroll") for (int nn = 0; nn < 2; ++nn) \
                acc[m][nn] = __builtin_amdgcn_mfma_f32_16x16x32_bf16(TRGET(tc[st][nn]), fq_[m], acc[m][nn], 0, 0, 0); SBAR(); } while (0)
          OC_ISSUE(0, 0); OC_STEP(0, 0, 0); OC_STEP(1, 1, 0); OC_STEP(2, 0, 0); OC_STEP(3, 1, 0);
#undef OC_ISSUE
#undef OC_STEP
        }
#pragma unroll
        for (int m = 0; m < 4; ++m) { const float ej = v[256 + 64 * wr + 16 * m + li];
#pragma unroll
            for (int nn = 0; nn < 2; ++nn) acc[m][nn] *= ej; }
        { TrFrag tv[2][2]; bf16x8 fp_[4];
#define OV_ISSUE(ks, st) do { _Pragma("unroll") for (int nn = 0; nn < 2; ++nn) frag_tr_issue_p(tv[st][nn], Vt, TLD, 32 * wc, nn, 32 * (ks), lane); } while (0)
#define OV_STEP(ks, st) do { _Pragma("unroll") for (int m = 0; m < 4; ++m) fp_[m] = frag_kc(KP, TLD, 64 * wr + 16 * m, 32 * (ks), lane); \
            if ((ks) < 3) OV_ISSUE((ks) + 1, 1 - (st)); if ((ks) < 3) LDS_WAIT(4); else LDS_WAIT(0); SBAR(); \
            _Pragma("unroll") for (int m = 0; m < 4; ++m) _Pragma("unroll") for (int nn = 0; nn < 2; ++nn) \
                acc[m][nn] = __builtin_amdgcn_mfma_f32_16x16x32_bf16(TRGET(tv[st][nn]), fp_[m], acc[m][nn], 0, 0, 0); SBAR(); } while (0)
          OV_ISSUE(0, 0); OV_STEP(0, 0); OV_STEP(1, 1); OV_STEP(2, 0); OV_STEP(3, 1);
#undef OV_ISSUE
#undef OV_STEP
        }
#pragma unroll
        for (int m = 0; m < 4; ++m) { const int j = 64 * wr + 16 * m + li;
            const float den = v[256 + j] * vec[1536 + j] + (vec[1664 + j * 4] + vec[1664 + j * 4 + 1] + vec[1664 + j * 4 + 2] + vec[1664 + j * 4 + 3]);
            const float inv = __builtin_amdgcn_rcpf(fmaxf(fabsf(den), v[384 + j]));
#pragma unroll
            for (int nn = 0; nn < 2; ++nn) hs[m][nn] += acc[m][nn] * inv; }
        __syncthreads();
    }
    const bool has_next = item + F.G < NCH * 8;
    MlPre R;
    ml_pre_issue(R, F, has_next ? item + F.G : item, tid, wave, has_next);
#pragma unroll
    for (int m = 0; m < 4; ++m) { float ss = dot4(hs[m][0]) + dot4(hs[m][1]); ss += __shfl_xor(ss, 16); ss += __shfl_xor(ss, 32);
        if (lq == 0) vec[2176 + (64 * wr + 16 * m + li) * 4 + wc] = ss; }
    __syncthreads();
    bf16_t* Y = WSP(bf16_t, WS_Y);
#pragma unroll
    for (int m = 0; m < 4; ++m) { const int j = 64 * wr + 16 * m + li; const size_t row = r0 + j;
        const float rstd = rsqrtf((vec[2176 + j * 4] + vec[2176 + j * 4 + 1] + vec[2176 + j * 4 + 2] + vec[2176 + j * 4 + 3]) * (1.f / 128.f) + EPS);
        { const int e0 = 32 * wc + 8 * lq;
            const f32x4 hn0 = *(const f32x4*)(F.head_norm + l * 1024 + hd * 128 + e0), hn1 = *(const f32x4*)(F.head_norm + l * 1024 + hd * 128 + e0 + 4);
            const u32x4 ov = *(const u32x4*)(P + row * PW + S_ML_O + hd * 128 + e0), gv = *(const u32x4*)(P + row * PW + S_ML_G + hd * 128 + e0);
            const float ow[8] = {bflo(ov.x), bfhi(ov.x), bflo(ov.y), bfhi(ov.y), bflo(ov.z), bfhi(ov.z), bflo(ov.w), bfhi(ov.w)};
            const float gw[8] = {bflo(gv.x), bfhi(gv.x), bflo(gv.y), bfhi(gv.y), bflo(gv.z), bfhi(gv.z), bflo(gv.w), bfhi(gv.w)};
            f32x4 y0, y1;
#pragma unroll
            for (int e = 0; e < 4; ++e) {
                y0[e] = (hs[m][0][e] * rstd * hn0[e]) * (gw[e] * __builtin_amdgcn_rcpf((1.f + __expf(-ow[e])) * (1.f + __expf(-gw[e]))));
                y1[e] = (hs[m][1][e] * rstd * hn1[e]) * (gw[4 + e] * __builtin_amdgcn_rcpf((1.f + __expf(-ow[4 + e])) * (1.f + __expf(-gw[4 + e])))); }
            *(u32x4*)(Y + row * DM + 3072 + hd * 128 + e0) = pack8(y0, y1); }
        __builtin_amdgcn_sched_barrier(0); }
    if (has_next) { ml_pre_commit(R, Qt, vec, tid); m_cur = R.min_; }
    __syncthreads();
  }
}

template <int DQK, int LDROW>
__device__ __forceinline__ unsigned dma_src_off(int c, int lane, int kcol, int vcol, int rcol) {
    constexpr int KP_ = DQK * 2 + 16, KB_ = 64 * KP_;
    const int B = 1024 * c + 16 * lane;
    if (B < KB_) { const int row = B / KP_, cb = B - row * KP_;
        const int col = cb < 256 ? kcol * 2 + cb : ((DQK == 192 && cb < 384) ? rcol * 2 + (cb - 256) : kcol * 2);
        return (unsigned)(row * (LDROW * 2) + col); }
    const int Bv = B - KB_, sid = Bv >> 9, w16 = (Bv & 511) >> 4, kk = (sid >> 2) * 8 + (w16 >> 2);
    const int key = (kk & ~0xC) | ((kk & 4) << 1) | ((kk & 8) >> 1), col = (sid & 3) * 32 + (w16 & 3) * 8;
    return (unsigned)(key * (LDROW * 2) + (vcol + col) * 2);
}
template <int DQK, bool MASK, int LDROW, class TS, int ABL, bool ODD = false>
__device__ __forceinline__ void attn_dma(const bf16_t* __restrict__ Qrow, const bf16_t* __restrict__ base, int kcol, int vcol, int rcol, const TS ts, int NT, float m_init, float l_init, int qtok,
                                         const bf16_t* __restrict__ Gb, int ldg, bf16_t* __restrict__ Ob, int ldo, LAS unsigned char* ldsb, const int tid_, const int wave) {
    constexpr int KP_ = DQK * 2 + 16, ND = DQK / 16, DMA_KB = 64 * KP_, DMA_STAGE = DMA_KB + 16384, DMA_NCH = DMA_STAGE / 1024, NPW = (DMA_NCH + 7) / 8;
    static_assert(DMA_KB % 1024 == 0, "K region must be whole 1 KiB chunks");
    int tl = tid_; asm volatile("" : "+v"(tl));
    const int tid = tl, lane = tid & 63, r32 = lane & 31, hi = lane >> 5;
    float m_reg = m_init, l_reg = l_init; f32x16 o[4] = {}; bf16x8 qr[ND];
    f32x16 negm;
#pragma unroll
    for (int r = 0; r < 16; ++r) negm[r] = -m_init;
    const bf16_t* Qw = Qrow + hi * 8;
#pragma unroll
    for (int d0 = 0; d0 < ND; ++d0) qr[d0] = *reinterpret_cast<const bf16x8*>(Qw + d0 * 16);
    const __amdgpu_buffer_rsrc_t rs = __builtin_amdgcn_make_buffer_rsrc((void*)base, (short)0, (int)((size_t)T * LDROW * 2), 0x00020000);
    unsigned vsrc[NPW];
#pragma unroll
    for (int i = 0; i < NPW; ++i) { const int c = wave + 8 * i; vsrc[i] = dma_src_off<DQK, LDROW>(c < DMA_NCH ? c : wave, lane, kcol, vcol, rcol); }
    const int krow0 = (int)(uintptr_t)ldsb + r32 * KP_ + hi * 16, vb00 = (int)(uintptr_t)ldsb + DMA_KB + v_rd_base(lane);
#define DMA_TILE(j, stg) do { if (ABL != 2) { const unsigned so_ = (unsigned)ts.row(j) * (unsigned)(LDROW * 2); _Pragma("unroll") for (int i = 0; i < NPW - 1; ++i) \
        __builtin_amdgcn_raw_ptr_buffer_load_lds(rs, (LAS void*)(ldsb + (stg) + 1024 * (wave + 8 * i)), 16, (int)vsrc[i], (int)so_, 0, 0); \
        if (wave + 8 * (NPW - 1) < DMA_NCH) __builtin_amdgcn_raw_ptr_buffer_load_lds(rs, (LAS void*)(ldsb + (stg) + 1024 * (wave + 8 * (NPW - 1))), 16, (int)vsrc[NPW - 1], (int)so_, 0, 0); } } while (0)
#define DMA_WAIT_BAR() do { asm volatile("s_waitcnt vmcnt(0)" ::: "memory"); __builtin_amdgcn_s_barrier(); asm volatile("" ::: "memory"); } while (0)
#define RESC(a) do { if (__any((a) < 1.f)) { const float a_ = (a); _Pragma("unroll") for (int d = 0; d < 4; ++d) _Pragma("unroll") for (int r = 0; r < 16; ++r) o[d][r] *= a_; \
    { const float nm_ = -m_reg; _Pragma("unroll") for (int r = 0; r < 16; ++r) negm[r] = nm_; } } } while (0)
#define KRD(d0, KB_, B0, B1) do { const int ad_ = (KB_) + (d0) * 32; B0 = *(const LAS bf16x8*)(ad_); B1 = *(const LAS bf16x8*)(ad_ + 32 * KP_); } while (0)
#define QKT(P0, P1, KB_) do { \
    bf16x8 kf0[3], kf1[3]; KRD(0, KB_, kf0[0], kf1[0]); KRD(1, KB_, kf0[1], kf1[1]); \
    _Pragma("unroll") for (int d0 = 0; d0 < ND; ++d0) { \
        if (d0 + 2 < ND) KRD(d0 + 2, KB_, kf0[(d0 + 2) % 3], kf1[(d0 + 2) % 3]); \
        if (d0 == 0) { P0 = __builtin_amdgcn_mfma_f32_32x32x16_bf16(kf0[0], qr[0], negm, 0, 0, 0); P1 = __builtin_amdgcn_mfma_f32_32x32x16_bf16(kf1[0], qr[0], negm, 0, 0, 0); }     \
        else { P0 = __builtin_amdgcn_mfma_f32_32x32x16_bf16(kf0[d0 % 3], qr[d0], P0, 0, 0, 0); P1 = __builtin_amdgcn_mfma_f32_32x32x16_bf16(kf1[d0 % 3], qr[d0], P1, 0, 0, 0); } } \
    __builtin_amdgcn_sched_group_barrier(0x100, 4, 0); sg_rmv<ND - 2>(); sg_mv<2>(); } while (0)
#define AMASK(P0, P1, j) do { if (MASK && ts.masked(j)) { const int kt0 = ts.tok(j); _Pragma("unroll") for (int r = 0; r < 16; ++r) { \
    const int k0_ = kt0 + crow(r, hi), k1_ = k0_ + 32; const int d0_ = qtok - k0_, d1_ = qtok - k1_; \
    if (d0_ > 128 || d0_ < -128 || k0_ < 0 || k0_ >= SEQ) P0[r] = -1e30f; if (d1_ > 128 || d1_ < -128 || k1_ < 0 || k1_ >= SEQ) P1[r] = -1e30f; } } } while (0)
    f32x16 pA0, pA1, pB0, pB1; float alA, alB; bf16x8 pa0, pa1, pa2, pa3;
    int s_prev = 0, s_cur = DMA_STAGE, s_next = 2 * DMA_STAGE;
    DMA_TILE(0, 0); DMA_TILE(1, DMA_STAGE); DMA_WAIT_BAR();
    QKT(pA0, pA1, krow0); AMASK(pA0, pA1, 0); partialSM<ABL>(pA0, pA1, m_reg, alA);
    RESC(alA);
    for (int j = 1; j + 1 < NT; j += 2) {
        DMA_TILE(j + 1, s_next);
        SBAR(); QKT(pB0, pB1, krow0 + s_cur); AMASK(pB0, pB1, j);
        finishSM<ABL>(pA0, pA1, alA, l_reg, pa0, pa1, pa2, pa3); SBAR();
        pv_d0(o, vb00 + s_prev, pa0, pa1, pa2, pa3); partialSM<ABL>(pB0, pB1, m_reg, alB);
        RESC(alB); DMA_WAIT_BAR();
        { const int t_ = s_prev; s_prev = s_cur; s_cur = s_next; s_next = t_; }
        if (j + 2 < NT) DMA_TILE(j + 2, s_next);
        SBAR(); QKT(pA0, pA1, krow0 + s_cur); AMASK(pA0, pA1, j + 1);
        finishSM<ABL>(pB0, pB1, alB, l_reg, pa0, pa1, pa2, pa3); SBAR();
        pv_d0(o, vb00 + s_prev, pa0, pa1, pa2, pa3); partialSM<ABL>(pA0, pA1, m_reg, alA);
        RESC(alA); DMA_WAIT_BAR();
        { const int t_ = s_prev; s_prev = s_cur; s_cur = s_next; s_next = t_; }
    }
    if (!ODD) {
        SBAR(); QKT(pB0, pB1, krow0 + s_cur); AMASK(pB0, pB1, NT - 1);
        finishSM<ABL>(pA0, pA1, alA, l_reg, pa0, pa1, pa2, pa3); SBAR();
        pv_d0(o, vb00 + s_prev, pa0, pa1, pa2, pa3); partialSM<ABL>(pB0, pB1, m_reg, alB);
        RESC(alB);
        finishSM<ABL>(pB0, pB1, alB, l_reg, pa0, pa1, pa2, pa3); SBAR();
        pv_d0(o, vb00 + s_cur, pa0, pa1, pa2, pa3);
    } else {
        finishSM<ABL>(pA0, pA1, alA, l_reg, pa0, pa1, pa2, pa3); SBAR();
        pv_d0(o, vb00 + s_prev, pa0, pa1, pa2, pa3);
    }
    { const float rl = __builtin_amdgcn_rcpf(l_reg);
      int lz = lane; asm volatile("" : "+v"(lz));
      const int qz = lz & 31, hz = lz >> 5;
      const bf16_t* grow = Gb + (size_t)qz * ldg + 4 * hz; bf16_t* orow = Ob + (size_t)qz * ldo + 8 * hz;
      u32x2 gav[8], gbv[8];
      if (DQK == 128) {
#pragma unroll
          for (int kk = 0; kk < 8; ++kk) { gav[kk] = *(const u32x2*)(grow + 16 * kk); gbv[kk] = *(const u32x2*)(grow + 16 * kk + 8); } }
#pragma unroll
      for (int d0 = 0; d0 < 4; ++d0)
#pragma unroll
          for (int gp = 0; gp < 2; ++gp) {
              const int k = 4 * d0 + 2 * gp;
              u32x2 ga, gb;
              if (DQK == 128) { ga = gav[2 * d0 + gp]; gb = gbv[2 * d0 + gp]; } else { ga = *(const u32x2*)(grow + 8 * k); gb = *(const u32x2*)(grow + 8 * k + 8); }
              const f32x16& od = o[d0];
              const float a0 = od[8 * gp + 0] * rl * siluf_(bflo(ga.x)), a1 = od[8 * gp + 1] * rl * siluf_(bfhi(ga.x)), a2 = od[8 * gp + 2] * rl * siluf_(bflo(ga.y)), a3 = od[8 * gp + 3] * rl * siluf_(bfhi(ga.y));
              const float b0 = od[8 * gp + 4] * rl * siluf_(bflo(gb.x)), b1 = od[8 * gp + 5] * rl * siluf_(bfhi(gb.x)), b2 = od[8 * gp + 6] * rl * siluf_(bflo(gb.y)), b3 = od[8 * gp + 7] * rl * siluf_(bfhi(gb.y));
              const unsigned ax = cvt_pk_bf16(a0, a1), ay = cvt_pk_bf16(a2, a3), bx = cvt_pk_bf16(b0, b1), by = cvt_pk_bf16(b2, b3);
              auto rx = __builtin_amdgcn_permlane32_swap(ax, bx, false, false); auto ry = __builtin_amdgcn_permlane32_swap(ay, by, false, false);
              u32x4 w; w.x = rx[0]; w.y = ry[0]; w.z = rx[1]; w.w = ry[1];
              *(u32x4*)(orow + 8 * k) = w; } }
    __builtin_amdgcn_s_barrier();
#undef DMA_TILE
#undef DMA_WAIT_BAR
#undef RESC
#undef KRD
#undef QKT
#undef AMASK
}

constexpr float SCALE_SWA = 0.08838834764831845f, SCALE_MLA = 0.07216878364870322f;
__device__ __forceinline__ void swa_unit(const Frame& F, int l, int unit) {
    const bf16_t* P = WSP(bf16_t, WS_P); bf16_t* Y = WSP(bf16_t, WS_Y);
    const bf16_t* Pq = P; asm volatile("" : "+s"(Pq), "+s"(Y));
    int lz = F.lane; asm volatile("" : "+v"(lz));
    const int r32 = lz & 31;
    const bool is_ctx = unit >= 512; const int u2 = is_ctx ? unit - 512 : unit, g2 = u2 & 1, qc = u2 >> 1;
    const int hq = 4 * g2 + (F.wave >> 1), rloc = 32 * (F.wave & 1);
    const int row0 = (is_ctx ? 0 : CTX) + qc * 64 + rloc;
    const bf16_t* Qrow = Pq + (size_t)(row0 + r32) * PW + S_SWA_Q + hq * 128;
    const bf16_t* Gb = Pq + (size_t)row0 * PW + S_SWA_G + hq * 128; bf16_t* Ob = Y + (size_t)row0 * DM + 1024 + hq * 128;
    const float m_init = F.sink[l * 8 + hq] * LOG2E;
    if (!is_ctx) { TsSwa ts; ts.tb = qc * 64 - 128;
        attn_dma<128, true, PW, TsSwa, 0, true>(Qrow, P, S_SWA_K + g2 * 128, S_SWA_V + g2 * 128, 0, ts, 9, m_init, 1.f, qc * 64 + rloc + r32, Gb, PW, Ob, DM, F.lds + LDS_RING, F.tid, F.wave); }
    else { TsDense ts;
        attn_dma<128, false, PW, TsDense, 0>(Qrow, P, S_SWA_K + g2 * 128, S_SWA_V + g2 * 128, 0, ts, 4, m_init, 1.f, 0, Gb, PW, Ob, DM, F.lds + LDS_RING, F.tid, F.wave); }
}
template <int ABL = 0>
__device__ __forceinline__ void mla_unit(const Frame& F, int unit) {
    const bf16_t* P = WSP(bf16_t, WS_P); bf16_t* Y = WSP(bf16_t, WS_Y); const bf16_t* QM = WSP(bf16_t, WS_QM); const bf16_t* KV = WSP(bf16_t, WS_KV);
    asm volatile("" : "+s"(P), "+s"(Y), "+s"(QM));
    int lz = F.lane; asm volatile("" : "+v"(lz));
    const int r32 = lz & 31;
    const bool is_ctx = unit >= 512; const int h = unit & 7, qb = is_ctx ? 0 : (unit >> 3);
    const int row0 = (is_ctx ? 0 : CTX + qb * 256) + 32 * F.wave;
    const bf16_t* Qrow = QM + (size_t)(row0 + r32) * 1536 + h * 192;
    const bf16_t* Gb = P + (size_t)row0 * PW + S_MLA_G + h * 128; bf16_t* Ob = (ABL ? WSP(bf16_t, WS_H) : Y) + (size_t)row0 * DM + 2048 + h * 128;
    attn_dma<192, false, LDKV, TsDense, ABL>(Qrow, KV, h * 256, h * 256 + 128, 2048, TsDense(), is_ctx ? 4 : T / 64, 0.f, 0.f, 0, Gb, PW, Ob, DM, F.lds + LDS_RING, F.tid, F.wave);
}

#ifndef PHMASK
#define PHMASK 0xFFFF
#endif
#define EN(b) ((PHMASK >> (b)) & 1)
#define IN(k) ph_in(lds, (k))
#define SEAM(k) do { if (IN(k) && IN((k) + 1)) grid_barrier(lds); } while (0)

template <int l>
__device__ __forceinline__ void layer_phases(LAS unsigned char* lds, const int wave0) {
        const int pb = 1 + 7 * l;
        const bool need_ctx = (l == 0);
        if (EN(1) && IN(pb + 0)) REP(1) {
            const Frame F = load_frame(lds, wave0);
            if (l == 0) norm_phase(F, 0, 0, T, 0, F.G);
            else {
                if (F.bid < 16) {
                    pg8::Gemm g{WSP(bf16_t, WS_Y), WSP(bf16_t, WS_WOUT) + (size_t)(l - 1) * DM * DM, CTX, DM, DM, DM, DM};
                    pg8::StaticOrder S; S.init(CTX, DM, 16, F.bid);
                    EpiOut E{WSP(bf16_t, WS_Z), WSP(float, WS_ST2), 0};
                    pg8::gemm_phase<EpiOut>(F.lds + LDS_RING, g, S, E, F.tid);
                }
                { const Frame F2 = load_frame(lds, wave0); norm_phase(F2, l, CTX, T, 16, F2.G - 16); }
            }
        }
        if (l > 0) SEAM(pb + 0);
        if (l > 0 && EN(1) && IN(pb + 1)) { const Frame F = load_frame(lds, wave0); norm_phase(F, l, 0, CTX, 0, F.G); }
        SEAM(pb + 1);
        if (EN(2) && IN(pb + 2)) REP(2) {
            const Frame F = load_frame(lds, wave0);
            pg8::Gemm g{WSP(bf16_t, WS_H), WSP(bf16_t, WS_WIN) + (size_t)l * NPAD * DM, T, NPAD, DM, DM, DM};
            pg8::StaticOrder S; S.init(T, NPAD, F.G, F.bid);
            LAS float* lt32 = (LAS float*)(F.lds + LDS_RING + pg8::STAGE_BYTES);
#pragma unroll
            for (int i = 0; i < 2; ++i) *(LAS f32x4*)(lt32 + 4 * (F.tid + NTHR * i)) = *(const f32x4*)(WSP(float, WS_TAB32) + 4 * (F.tid + NTHR * i));
            __syncthreads();
            EpiIn E{WSP(bf16_t, WS_P), WSP(bf16_t, WS_KV), WSP(float, WS_G), WSP(float, WS_ST1), WSP(float, WS_TAB16), WSP(float, WS_TAB32), F.gate_b + l * 32, lt32};
            pg8::gemm_phase<EpiIn>(F.lds + LDS_RING, g, S, E, F.tid);
        }
        SEAM(pb + 2);
        if (IN(pb + 3)) {
            if (EN(3)) REP(3) { const Frame F = load_frame(lds, wave0); pg8::Gemm g{WSP(bf16_t, WS_P) + S_CQ, WSP(bf16_t, WS_WUQ) + (size_t)l * 1536 * 768, T, 1536, 768, PW, 768};
              pg8::StaticOrder S; S.init(T, 1536, F.G, F.bid);
              LAS float* lt16 = (LAS float*)(F.lds + LDS_RING + pg8::STAGE_BYTES);
              *(LAS f32x4*)(lt16 + 4 * F.tid) = *(const f32x4*)(WSP(float, WS_TAB16) + 4 * F.tid);
              __syncthreads();
              EpiUq E{WSP(bf16_t, WS_QM), WSP(float, WS_ST1), WSP(float, WS_TAB16), lt16};
              pg8::gemm_phase<EpiUq>(F.lds + LDS_RING, g, S, E, F.tid); }
            if (EN(4)) REP(4) { const Frame F = load_frame(lds, wave0); pg8::Gemm g{WSP(bf16_t, WS_P) + S_CKV, WSP(bf16_t, WS_WUKV) + (size_t)l * 2048 * 256, T, 2048, 256, PW, 256};
              pg8::StaticOrder S; S.init(T, 2048, F.G, (F.bid + F.G - 136) % F.G);
              EpiUkv E{WSP(bf16_t, WS_KV), WSP(float, WS_ST1)};
              pg8::gemm_phase<EpiUkv>(F.lds + LDS_RING, g, S, E, F.tid); }
            const int nswa = 512 + (need_ctx ? 8 : 0);
            if (EN(5)) REP(5) { const Frame F = load_frame(lds, wave0); for (int u = (F.bid + F.G - 144) % F.G; u < nswa; u += F.G) swa_unit(F, l, u); }
            if (EN(6)) REP(6) { const Frame F = load_frame(lds, wave0); ml_cloc_loop(F, (F.bid + F.G - 152) % F.G); }
            if (EN(7)) REP(7) { const Frame F = load_frame(lds, wave0); lru_loop(F, l, (F.bid + F.G - 168) % F.G); }
        }
        SEAM(pb + 3);
        if (IN(pb + 4)) {
            if (EN(8)) REP(8) { const Frame F = load_frame(lds, wave0);
                LAS float* sg = (LAS float*)(F.lds + LDS_RING); LAS float* sml = sg + 192;
                const int chain = F.bid >> 4;
                if (F.tid < NCH) { const int n = chunk_at(chain >> 3, F.tid); const float* gm = WSP(float, WS_GM) + ((size_t)n * 16 + chain) * 2; sg[F.tid] = gm[0]; sml[F.tid] = gm[1]; }
                __syncthreads();
                if (F.tid < 128) ml_scan(F, chain, (F.bid & 15) * 128 + F.tid, sg, sml);
                else if (F.tid < 160 && (F.bid & 15) == 0) ml_nscan(F, chain, F.tid - 128, sg, sml);
                else if (F.tid >= 256 && F.bid < 8) lru_carry(F, F.bid * 256 + (F.tid - 256));
                __syncthreads(); }
            const int nmla = 512 + (need_ctx ? 8 : 0);
            if (EN(9)) { const Frame F = load_frame(lds, wave0); for (int u = F.bid; u < nmla; u += F.G) mla_unit<0>(F, u); }
            if (EN(9) && ((REPMASK >> 9) & 1)) { const Frame F = load_frame(lds, wave0); for (int u = F.bid; u < nmla; u += F.G) mla_unit<ABL_KIND>(F, u); }
        }
        SEAM(pb + 4);
        if (IN(pb + 5)) {
            const int n0 = need_ctx ? 0 : 2;
            if (EN(10)) REP(10) { const Frame F = load_frame(lds, wave0); lru_out(F, n0 * 128, need_ctx ? 16 : 0); }
            if (EN(11)) REP(11) { const Frame F = load_frame(lds, wave0); ml_out_loop(F, l, n0 * 8 + F.bid); }
        }
        SEAM(pb + 5);
        if (EN(12) && IN(pb + 6)) REP(12) {
            const Frame F = load_frame(lds, wave0);
            pg8::Gemm g{WSP(bf16_t, WS_Y) + (size_t)CTX * DM, WSP(bf16_t, WS_WOUT) + (size_t)l * DM * DM, SEQ, DM, DM, DM, DM};
            pg8::StaticOrder S; S.init(SEQ, DM, F.G, F.bid);
            EpiOut E{WSP(bf16_t, WS_Z), WSP(float, WS_ST2), CTX};
            pg8::gemm_phase<EpiOut>(F.lds + LDS_RING, g, S, E, F.tid);
        }
        SEAM(pb + 6);
}

constexpr int N_PHASES = 16;
__global__ void __launch_bounds__(NTHR, 2) hybrid_fwd(Args args) {
    extern __shared__ __attribute__((aligned(16))) unsigned char lds_raw[];
    LAS unsigned char* const lds = (LAS unsigned char*)lds_raw;
    const int wave0 = __builtin_amdgcn_readfirstlane((int)threadIdx.x >> 6);
    if (threadIdx.x < 16) ((LAS unsigned*)(lds + LDS_MISC))[threadIdx.x] = 0u;
    if (threadIdx.x < 26) { const unsigned long long p = threadIdx.x < 24 ? (unsigned long long)args.in[threadIdx.x] : (threadIdx.x == 24 ? (unsigned long long)args.out : (unsigned long long)args.ws);
        ((LAS unsigned*)(lds + LDS_PTRS))[2 * threadIdx.x] = (unsigned)p; ((LAS unsigned*)(lds + LDS_PTRS))[2 * threadIdx.x + 1] = (unsigned)(p >> 32); }
    if (threadIdx.x == 0) { ((LAS int*)(lds + LDS_MISC))[8] = args.ph_lo; ((LAS int*)(lds + LDS_MISC))[9] = args.ph_hi; }
    __syncthreads();
    const int lo = args.ph_lo, hi = args.ph_hi;
    if (hi - lo > 1) (void)xcd_barrier_post((unsigned*)(args.ws + WS_CTL), (volatile LAS unsigned*)(lds + LDS_MISC));

    if (EN(0) && IN(0)) REP(0) { const Frame F = load_frame(lds, wave0); p0_prologue(F); }
    SEAM(0);
    layer_phases<0>(lds, wave0);
    layer_phases<1>(lds, wave0);
    if (EN(13) && IN(15)) { const Frame F = load_frame(lds, wave0); norm_phase(F, 2, CTX, T, 0, F.G); }
#undef IN
#undef SEAM
}

#ifndef N_LAUNCHES
#define N_LAUNCHES 1
#endif
extern "C" void kernel_launch(void* const* d_in, const int* in_sizes, int n_in, void* d_out, int out_size, void* d_ws, size_t ws_size, hipStream_t stream) {
    static int grid = 0;
    if (grid == 0) {
        if (n_in != 24 || in_sizes[0] != SEQ * DM || out_size != SEQ * DM || ws_size < WS_END) {
            fprintf(stderr, "kernel_launch: unexpected shapes (n_in %d, in0 %d, out %d, ws %zu, need %zu); nothing launched\n", n_in, n_in > 0 ? in_sizes[0] : -1, out_size, ws_size, (size_t)WS_END); grid = -1; return; }
        int dev = 0, cus = 0;
        if (hipGetDevice(&dev) != hipSuccess || hipDeviceGetAttribute(&cus, hipDeviceAttributeMultiprocessorCount, dev) != hipSuccess) { grid = -1; return; }
        if (hipFuncSetAttribute((const void*)hybrid_fwd, hipFuncAttributeMaxDynamicSharedMemorySize, LDS_BYTES) != hipSuccess) { fprintf(stderr, "kernel_launch: hipFuncSetAttribute failed\n"); grid = -1; return; }
        int per_cu = 0;
        if (hipOccupancyMaxActiveBlocksPerMultiprocessor(&per_cu, (const void*)hybrid_fwd, NTHR, LDS_BYTES) != hipSuccess || per_cu < 1) { fprintf(stderr, "kernel_launch: occupancy query says %d\n", per_cu); }
        (void)hipGetLastError();
        grid = cus;
    }
    if (grid < 0) return;
    (void)hipMemsetAsync((char*)d_ws + WS_CTL, 0, CTL_BYTES + (size_t)2 * 2 * 12288 * 4, stream);
    Args a{};
    for (int i = 0; i < 24; ++i) a.in[i] = (const float*)d_in[i];
    a.out = (float*)d_out; a.ws = (unsigned char*)d_ws;
#ifndef MAX_PHASE
#define MAX_PHASE N_PHASES
#endif
    for (int li = 0; li < N_LAUNCHES && li < MAX_PHASE; ++li) {
        a.ph_lo = (N_LAUNCHES == 1) ? 0 : li; a.ph_hi = (N_LAUNCHES == 1) ? MAX_PHASE : li + 1;
        hipLaunchKernelGGL(hybrid_fwd, dim3(grid), dim3(NTHR), LDS_BYTES, stream, a);
    }
}
```

```cpp
#include <hip/hip_runtime.h>
#include <cstdio>
#include <cstdint>
#include <cmath>

#define LAS __attribute__((address_space(3)))
typedef unsigned short bf16_t;
typedef short bf16x8 __attribute__((ext_vector_type(8)));
typedef short s16x4 __attribute__((ext_vector_type(4)));
typedef float f32x2 __attribute__((ext_vector_type(2)));
typedef float f32x4 __attribute__((ext_vector_type(4)));
typedef float f32x16 __attribute__((ext_vector_type(16)));
typedef unsigned u32x2 __attribute__((ext_vector_type(2)));
typedef unsigned u32x4 __attribute__((ext_vector_type(4)));
typedef unsigned int u32x4v __attribute__((__vector_size__(16)));

constexpr int DM = 4096, SEQ = 16384, CTX = 256, T = SEQ + CTX  , DEPTH = 2;
constexpr int NIN = 11872;
constexpr int PW = 11776;
constexpr int NPAD = 12032;
constexpr int NCH = T / 128;
constexpr int S_LRU_U = 0, S_LRU_G = 1024, S_SWA_Q = 2048, S_SWA_K = 3072, S_SWA_V = 3328, S_SWA_G = 3584, S_CQ = 4608, S_CKV = 5376,
              S_MLA_G = 5632, S_ML_Q = 6656, S_ML_K = 7680, S_ML_V = 8704, S_ML_O = 9728, S_ML_G = 10752, S_MISC = 11776;
constexpr int O_LRU_U = 0, O_LRU_G = 1024, O_SWA_Q = 2048, O_SWA_K = 3072, O_SWA_V = 3328, O_SWA_G = 3584, O_CQ = 4608, O_CKV = 5376, O_KR = 5632,
              O_MLA_G = 5696, O_ML_Q = 6720, O_ML_K = 7744, O_ML_V = 8768, O_ML_O = 9792, O_ML_GT = 10816, O_ML_G = 10848;
constexpr float EPS = 1e-6f;

constexpr size_t al256(size_t x) { return (x + 255) / 256 * 256; }
constexpr size_t WS_CTL = 0;
constexpr size_t CTL_BYTES = 65536;
constexpr size_t WS_MOD = WS_CTL + CTL_BYTES;
constexpr size_t WS_TAB16 = WS_MOD + al256((size_t)2 * 2 * 12288 * 4);
constexpr size_t WS_TAB32 = WS_TAB16 + 256 * 16 * 2 * 4;
constexpr size_t WS_WIN = WS_TAB32 + 256 * 32 * 2 * 4;
constexpr size_t WS_WOUT = WS_WIN + (size_t)2 * NPAD * DM * 2;
constexpr size_t WS_WUQ = WS_WOUT + (size_t)2 * DM * DM * 2;
constexpr size_t WS_WUKV = WS_WUQ + (size_t)2 * 1536 * 768 * 2;
constexpr size_t WS_LRUW = WS_WUKV + (size_t)2 * 2048 * 256 * 2;
constexpr size_t WS_H = WS_LRUW + (size_t)2 * 2 * 2 * 8 * 128 * 128 * 2;
constexpr size_t WS_P = WS_H + (size_t)T * DM * 2;
constexpr size_t WS_KR = WS_P + (size_t)T * PW * 2;
constexpr size_t WS_G = WS_KR + (size_t)T * 64 * 2;
constexpr size_t WS_ST1 = WS_G + (size_t)T * 32 * 4;
constexpr size_t WS_QM = WS_ST1 + (size_t)T * 16 * 4;
constexpr int LDKV = 2112;
constexpr size_t WS_KV = WS_QM + (size_t)T * 1536 * 2;
constexpr size_t WS_Y = WS_KV + (size_t)T * LDKV * 2;
constexpr size_t WS_Z = WS_Y + (size_t)T * DM * 2;
constexpr size_t WS_ST2 = WS_Z + (size_t)T * DM * 2;
constexpr size_t WS_XC = WS_ST2 + (size_t)T * 64 * 4;
constexpr size_t WS_LSUM = WS_XC + (size_t)CTX * DM * 4;
constexpr size_t WS_LCAR = WS_LSUM + (size_t)NCH * 2 * 2 * 1024 * 4;
constexpr size_t WS_CLOC = WS_LCAR + (size_t)NCH * 2 * 1024 * 4;
constexpr size_t WS_NLOC = WS_CLOC + (size_t)NCH * 16 * 16384 * 4;
constexpr size_t WS_GM = WS_NLOC + (size_t)NCH * 16 * 128 * 4;
constexpr size_t WS_CIN = WS_GM + al256((size_t)NCH * 16 * 2 * 4);
constexpr size_t WS_NIN = WS_CIN + (size_t)NCH * 16 * 16384 * 2;
constexpr size_t WS_MIN = WS_NIN + (size_t)NCH * 16 * 128 * 4;
constexpr size_t WS_END = WS_MIN + al256((size_t)NCH * 16 * 4);

__device__ __forceinline__ unsigned cvt_pk_bf16(float lo, float hi) { unsigned r; asm volatile("v_cvt_pk_bf16_f32 %0, %1, %2" : "=v"(r) : "v"(lo), "v"(hi)); return r; }
__device__ __forceinline__ bf16_t f2bf(float x) { return (bf16_t)(cvt_pk_bf16(x, x) & 0xffffu); }
__device__ __forceinline__ float bf2f(bf16_t u) { return __uint_as_float(((unsigned)u) << 16); }
__device__ __forceinline__ float bflo(unsigned w) { return __uint_as_float(w << 16); }
__device__ __forceinline__ float bfhi(unsigned w) { return __uint_as_float(w & 0xffff0000u); }
constexpr float LOG2E = 1.4426950408889634f;
__device__ __forceinline__ float sigmoidf_(float x) { return __builtin_amdgcn_rcpf(1.f + __expf(-x)); }
__device__ __forceinline__ float siluf_(float x) { return x * __builtin_amdgcn_rcpf(1.f + __expf(-x)); }
__device__ __forceinline__ float log_sigmoidf_(float x) { return fminf(x, 0.f) - log1pf(__expf(-fabsf(x))); }
__device__ __forceinline__ float softplusf_(float x) { return fmaxf(x, 0.f) + log1pf(__expf(-fabsf(x))); }

#define XB_TMO      128
#define XB_XCNT(j)  (256  + 64 * (j))
#define XB_XSUB(j)  (1280 + 64 * (j))
#define XB_XGEN(j)  (2304 + 64 * (j))
#define XB_TOP      3328
#define XB_TOPGEN   3392
#define XCD_BAR_WORDS 3456
#define XB_SPIN_CAP (1u << 24)
__device__ __forceinline__ unsigned xb_ld(unsigned* p)              { return __hip_atomic_load(p, __ATOMIC_RELAXED, __HIP_MEMORY_SCOPE_AGENT); }
__device__ __forceinline__ unsigned xb_add(unsigned* p, unsigned v) { return __hip_atomic_fetch_add(p, v, __ATOMIC_RELAXED, __HIP_MEMORY_SCOPE_AGENT); }
__device__ __forceinline__ unsigned xb_xcc_id() { return (unsigned)__builtin_amdgcn_s_getreg((3 << 11) | 20) & 0xFu; }
#define XB_SPIN(cond, bar) do { unsigned _sp = 0; while (cond) { __builtin_amdgcn_s_sleep(1); \
    if ((++_sp & 255u) == 0u) { if (xb_ld(&(bar)[XB_TMO])) break; if (_sp > XB_SPIN_CAP) { atomicAdd(&(bar)[XB_TMO], 1u); break; } } } } while (0)
struct XcdBarrier { unsigned* bar; unsigned x; volatile LAS unsigned* st; };
__device__ __forceinline__ XcdBarrier xcd_barrier_post(unsigned* bar, volatile LAS unsigned* st) {
    XcdBarrier b; b.bar = bar; b.x = xb_xcc_id(); b.st = st;
    if (threadIdx.x == 0) (void)xb_add(&bar[XB_XCNT(b.x)], 1u);
    return b;
}
__device__ __forceinline__ void xcd_barrier_complete(unsigned* bar, unsigned x, unsigned& nloc, unsigned& nx) {
    const unsigned G = gridDim.x * gridDim.y * gridDim.z;
    unsigned sum, cnt, mine, sp = 0u;
    for (;;) {
        sum = 0u; cnt = 0u; mine = 0u;
#pragma unroll
        for (unsigned j = 0; j < 16; ++j) { const unsigned c = xb_ld(&bar[XB_XCNT(j)]); sum += c; cnt += (c > 0u) ? 1u : 0u; mine = (j == x) ? c : mine; }
        if (sum == G) break;
        __builtin_amdgcn_s_sleep(1);
        if ((++sp & 255u) == 0u) { if (xb_ld(&bar[XB_TMO])) break; if (sp > XB_SPIN_CAP) { atomicAdd(&bar[XB_TMO], 1u); break; } }
    }
    nloc = mine > 0u ? mine : 1u; nx = cnt > 0u ? cnt : 1u;
}
__device__ __forceinline__ void xcd_barrier(const XcdBarrier& b) {
    asm volatile("s_waitcnt vmcnt(0)" ::: "memory");
    __syncthreads();
    if (threadIdx.x == 0) {
        unsigned* bar = b.bar;
        __builtin_amdgcn_s_waitcnt(0);
        unsigned nloc = b.st[0], nx = b.st[1];
        if (nloc == 0u) { xcd_barrier_complete(bar, b.x, nloc, nx); b.st[0] = nloc; b.st[1] = nx; }
        const unsigned old = xb_add(&bar[XB_XSUB(b.x)], 1u);
        const unsigned gen = old / nloc;
        if (old + 1u == (gen + 1u) * nloc) {
            __builtin_amdgcn_fence(__ATOMIC_RELEASE, "agent");
            asm volatile("s_waitcnt vmcnt(0)" ::: "memory");
            const unsigned og = xb_add(&bar[XB_TOP], 1u);
            const unsigned tg = og / nx;
            if (og + 1u == (tg + 1u) * nx) xb_add(&bar[XB_TOPGEN], 1u);
            else XB_SPIN(xb_ld(&bar[XB_TOPGEN]) == tg, bar);
            __builtin_amdgcn_fence(__ATOMIC_ACQUIRE, "agent");
            xb_add(&bar[XB_XGEN(b.x)], 1u);
            asm volatile("s_waitcnt vmcnt(0)" ::: "memory");
        } else {
            XB_SPIN(xb_ld(&bar[XB_XGEN(b.x)]) == gen, bar);
            __builtin_amdgcn_fence(__ATOMIC_ACQUIRE, "agent");
            asm volatile("s_waitcnt vmcnt(0)" ::: "memory");
        }
    }
    __syncthreads();
}

namespace pg8 {
constexpr int BM = 256, BK = 64, HALF = 128, HTB = HALF * BK * 2, STAGE_BYTES = 8 * HTB, NXCD = 8, WGM = 8;
__host__ __device__ __forceinline__ int lds_byte(int r, int c) { const int st = (r >> 4) * 2 + (c >> 5), rr = r & 15, cc = c & 31, ob = rr * 64 + cc * 2; return st * 1024 + (ob ^ (((ob >> 9) & 1) << 5)); }
__host__ __device__ __forceinline__ void stage_rc(int b, int& R, int& C) { const int st = b / 1024, sb = b % 1024, swz = sb ^ (((sb >> 9) & 1) << 5); R = (st >> 1) * 16 + swz / 64; C = (st & 1) * 32 + (swz % 64) / 2; }
__host__ __device__ __forceinline__ int perm32(int rho) { const int n = rho >> 4, i = rho & 15; return 8 * (i >> 2) + 4 * n + (i & 3); }
struct Unit { int pm, pn; };
struct Gemm { const bf16_t* A; const bf16_t* Bt; int M, N, K, lda, ldb; };
struct StaticOrder {
    int nM, nN, nwg, G, c;
    __host__ __device__ void init(int M, int N, int G_, int c_) { nM = M / BM; nN = N / BM; nwg = nM * nN; G = G_; c = c_; }
    __host__ __device__ bool next(int i, Unit& u) const {
        const long L = (long)i * G + c; if (L >= nwg) return false;
        int wgid = (int)L; { const int q = nwg / NXCD, r = nwg % NXCD, xcd = wgid % NXCD, off = wgid / NXCD; wgid = (xcd < r ? xcd * (q + 1) : r * (q + 1) + (xcd - r) * q) + off; }
        const int nig = WGM * nN, gid = wgid / nig, fm = gid * WGM, gsz = (nM - fm) < WGM ? (nM - fm) : WGM;
        u.pm = fm + ((wgid % nig) % gsz); u.pn = (wgid % nig) / gsz; return true;
    }
};
template <class Epi>
__device__ __forceinline__ void gemm_phase(LAS unsigned char* lds, const Gemm g, const StaticOrder& S, const Epi& E, const int tid) {
    const int wid = __builtin_amdgcn_readfirstlane(tid >> 6), lane = tid & 63, wr = wid >> 2, wc = wid & 3, fr = lane & 15, fq = lane >> 4;
    const int K = g.K, nt = K / BK;
    unsigned voffA[2], voffB[2], voffB1[2];
#pragma unroll
    for (int i = 0; i < 2; ++i) { int R, C; stage_rc(tid * 16 + i * 8192, R, C); const int Rb = 64 * (R >> 5) + perm32(R & 31);
        voffA[i] = (unsigned)(R * g.lda + C) * 2u; voffB[i] = (unsigned)(Rb * g.ldb + C) * 2u; voffB1[i] = (unsigned)((Rb + 32) * g.ldb + C) * 2u; }
    struct GOff { __amdgpu_buffer_rsrc_t rs; unsigned so; __device__ __forceinline__ GOff operator+(unsigned d) const { return GOff{rs, so + d}; } };
    const unsigned kstep = (unsigned)(BK * 2);
    const unsigned hstepA = (unsigned)HALF * (unsigned)g.lda * 2u, hstepB = (unsigned)HALF * (unsigned)g.ldb * 2u;
    const unsigned tstepA = 2u * hstepA, tstepB = 2u * hstepB;
    const __amdgpu_buffer_rsrc_t rsA = __builtin_amdgcn_make_buffer_rsrc((void*)g.A, (short)0, (int)0xFFFFFFF0u, 0x00020000), rsB = __builtin_amdgcn_make_buffer_rsrc((void*)g.Bt, (short)0, (int)0xFFFFFFF0u, 0x00020000);
    const unsigned ldsw = (unsigned)wid * 1024u;
    const int aoff = lds_byte(wr * 64 + fr, fq * 8), boff = lds_byte(wc * 32 + fr, fq * 8);
#define PG8_SA(b, h) (((b) * 2 + (h)) * HTB)
#define PG8_SB(b, h) ((4 + (b) * 2 + (h)) * HTB)
#define PG8_STAGE(bufoff, gbase, voff) do { _Pragma("unroll") for (int _i = 0; _i < 2; ++_i) \
        __builtin_amdgcn_raw_ptr_buffer_load_lds((gbase).rs, (LAS void*)(lds + (bufoff) + ldsw + _i * 8192), 16, (int)(voff)[_i], (int)(gbase).so, 0, 0); } while (0)
#define PG8_LDA(dst, b, h) do { _Pragma("unroll") for (int m = 0; m < 4; ++m) _Pragma("unroll") for (int k = 0; k < 2; ++k) dst[m][k] = *(const LAS bf16x8*)(lds + PG8_SA(b, h) + aoff + m * 2048 + k * 1024); } while (0)
#define PG8_LDB(dst, b, h) do { _Pragma("unroll") for (int n = 0; n < 2; ++n) _Pragma("unroll") for (int k = 0; k < 2; ++k) dst[n][k] = *(const LAS bf16x8*)(lds + PG8_SB(b, h) + boff + n * 2048 + k * 1024); } while (0)
#define PG8_MMA(ai, bj, At, Bt) do { __builtin_amdgcn_s_setprio(1); _Pragma("unroll") for (int m = 0; m < 4; ++m) _Pragma("unroll") for (int n = 0; n < 2; ++n) _Pragma("unroll") for (int k = 0; k < 2; ++k) \
        acc[ai][bj][m][n] = __builtin_amdgcn_mfma_f32_16x16x32_bf16(Bt[n][k], At[m][k], acc[ai][bj][m][n], 0, 0, 0); __builtin_amdgcn_s_setprio(0); } while (0)
#define PG8_WAIT_V(n) asm volatile("s_waitcnt vmcnt(" #n ")" ::: "memory")
#define PG8_WAIT_L(n) asm volatile("s_waitcnt lgkmcnt(" #n ")" ::: "memory")
#define PG8_BAR __builtin_amdgcn_s_barrier()
#define PG8_SCHED __builtin_amdgcn_sched_barrier(0)
    Unit cur, nxt; int ui = 0;
    if (!S.next(0, cur)) return;
    f32x4 acc[2][2][4][2];
#pragma unroll
    for (int a = 0; a < 2; ++a)
#pragma unroll
        for (int b = 0; b < 2; ++b)
#pragma unroll
            for (int m = 0; m < 4; ++m)
#pragma unroll
                for (int n = 0; n < 2; ++n) acc[a][b][m][n] = (f32x4){0.f, 0.f, 0.f, 0.f};
    bf16x8 At[4][2], B0[2][2], B1[2][2];
    GOff cA{rsA, (unsigned)cur.pm * tstepA}, cB{rsB, (unsigned)cur.pn * tstepB};
    PG8_STAGE(PG8_SB(0, 0), cB, voffB); PG8_STAGE(PG8_SA(0, 0), cA, voffA); PG8_STAGE(PG8_SB(0, 1), cB, voffB1); PG8_STAGE(PG8_SA(0, 1), cA + hstepA, voffA);
    if (wr == 1) PG8_BAR;
    PG8_WAIT_V(4); PG8_BAR;
    PG8_STAGE(PG8_SB(1, 0), cB + kstep, voffB); PG8_STAGE(PG8_SA(1, 0), cA + kstep, voffA); PG8_STAGE(PG8_SB(1, 1), cB + kstep, voffB1);
    PG8_WAIT_V(6); PG8_BAR;
    for (;;) {
        const bool has_next = S.next(ui + 1, nxt);
        const GOff nA{rsA, has_next ? (unsigned)nxt.pm * tstepA : cA.so}, nB{rsB, has_next ? (unsigned)nxt.pn * tstepB : cB.so};
#pragma unroll 1
        for (int t = 0; t < nt; t += 2) {
            const bool last = (t == nt - 2);
            const GOff a1 = cA + (unsigned)(t + 1) * kstep;
            const GOff a2 = last ? nA : cA + (unsigned)(t + 2) * kstep, b2 = last ? nB : cB + (unsigned)(t + 2) * kstep;
            const GOff a3 = a2 + kstep, b3 = b2 + kstep;
            PG8_LDB(B0, 0, 0); PG8_SCHED; PG8_LDA(At, 0, 0); PG8_STAGE(PG8_SA(1, 1), a1 + hstepA, voffA);
            PG8_WAIT_L(8); PG8_BAR; PG8_WAIT_L(0); PG8_MMA(0, 0, At, B0); PG8_BAR; PG8_SCHED;
            PG8_LDB(B1, 0, 1); PG8_STAGE(PG8_SB(0, 0), b2, voffB);
            PG8_BAR; PG8_WAIT_L(0); PG8_MMA(0, 1, At, B1); PG8_BAR;
            PG8_LDA(At, 0, 1); PG8_STAGE(PG8_SA(0, 0), a2, voffA);
            PG8_BAR; PG8_WAIT_L(0); PG8_MMA(1, 0, At, B0); PG8_BAR; PG8_SCHED;
            PG8_STAGE(PG8_SB(0, 1), b2, voffB1);
            PG8_WAIT_V(6); PG8_BAR; PG8_MMA(1, 1, At, B1); PG8_BAR;
            PG8_LDB(B0, 1, 0); PG8_SCHED; PG8_LDA(At, 1, 0); PG8_STAGE(PG8_SA(0, 1), a2 + hstepA, voffA);
            PG8_WAIT_L(8); PG8_BAR; PG8_WAIT_L(0); PG8_MMA(0, 0, At, B0); PG8_BAR; PG8_SCHED;
            PG8_LDB(B1, 1, 1); PG8_STAGE(PG8_SB(1, 0), b3, voffB);
            PG8_BAR; PG8_WAIT_L(0); PG8_MMA(0, 1, At, B1); PG8_BAR;
            PG8_LDA(At, 1, 1); PG8_STAGE(PG8_SA(1, 0), a3, voffA);
            PG8_BAR; PG8_WAIT_L(0); PG8_MMA(1, 0, At, B0); PG8_BAR; PG8_SCHED;
            PG8_STAGE(PG8_SB(1, 1), b3, voffB1);
            PG8_WAIT_V(6); PG8_BAR; PG8_MMA(1, 1, At, B1); PG8_BAR;
        }
        E(acc, cur, wr, wc, fr, fq);
        if (!has_next) break;
#pragma unroll
        for (int a = 0; a < 2; ++a)
#pragma unroll
            for (int b = 0; b < 2; ++b)
#pragma unroll
                for (int m = 0; m < 4; ++m)
#pragma unroll
                    for (int n = 0; n < 2; ++n) acc[a][b][m][n] = (f32x4){0.f, 0.f, 0.f, 0.f};
        cur = nxt; cA = nA; cB = nB; ++ui;
    }
    PG8_WAIT_V(0);
    if (wr == 0) PG8_BAR;
    PG8_BAR;
#undef PG8_SA
#undef PG8_SB
#undef PG8_STAGE
#undef PG8_LDA
#undef PG8_LDB
#undef PG8_MMA
#undef PG8_WAIT_V
#undef PG8_WAIT_L
#undef PG8_BAR
#undef PG8_SCHED
}
}

constexpr int NTHR = 512, NWAVE = 8;
constexpr int LDS_MISC = 0;
constexpr int LDS_RING = 512;
constexpr int LDS_BYTES = 155648;
constexpr int RING_BYTES = LDS_BYTES - LDS_RING;

#ifndef REPMASK
#define REPMASK 0
#endif
#define REP(b) _Pragma("unroll 1") for (int rep_ = 0; rep_ < 1 + ((REPMASK >> (b)) & 1); ++rep_)
struct Args {
    const float* in[24]; float* out; unsigned char* ws;
    int ph_lo, ph_hi;
};
struct Frame {
    LAS unsigned char* lds; unsigned char* ws; int tid, lane, wave, G, bid;
    const float *x, *c, *ctx, *c_ctx, *w_mod, *b_mod, *g_pre, *g_post, *w_in, *w_out, *conv_w, *conv_b, *lam, *wa, *ba, *wx, *bx, *sink, *q_norm, *w_uq, *kv_norm, *w_ukv, *gate_b, *head_norm;
    float* out;
};
constexpr int LDS_PTRS = 64;
__device__ __forceinline__ const float* lds_ptr(LAS unsigned char* lds, int k) {
    const LAS unsigned* p = (const LAS unsigned*)(lds + LDS_PTRS) + 2 * k;
    const unsigned lo = __builtin_amdgcn_readfirstlane(p[0]), hi = __builtin_amdgcn_readfirstlane(p[1]);
    typedef __attribute__((address_space(1))) const float gcf_t;
    return (const float*)(gcf_t*)(((unsigned long long)hi << 32) | lo);
}
__device__ __forceinline__ bool ph_in(LAS unsigned char* lds, int k) {
    const int lo = __builtin_amdgcn_readfirstlane(((const LAS int*)(lds + LDS_MISC))[8]), hi = __builtin_amdgcn_readfirstlane(((const LAS int*)(lds + LDS_MISC))[9]);
    return lo <= k && k < hi;
}
__device__ __forceinline__ void grid_barrier(LAS unsigned char* lds) {
    XcdBarrier b; b.bar = (unsigned*)((unsigned char*)lds_ptr(lds, 25) + WS_CTL); b.x = xb_xcc_id(); b.st = (volatile LAS unsigned*)(lds + LDS_MISC);
    xcd_barrier(b);
}
__device__ __forceinline__ Frame load_frame(LAS unsigned char* lds, const int wave0) {
    Frame F; F.lds = lds;
    unsigned z0 = 0u; asm volatile("" : "+v"(z0));
    int t = wave0 * 64 + (int)__builtin_amdgcn_mbcnt_hi(~0u, __builtin_amdgcn_mbcnt_lo(~0u, z0)); asm volatile("" : "+v"(t));
    F.tid = t; F.lane = t & 63; F.wave = wave0; F.G = gridDim.x; F.bid = blockIdx.x;
    F.x = lds_ptr(lds, 0); F.c = lds_ptr(lds, 1); F.ctx = lds_ptr(lds, 2); F.c_ctx = lds_ptr(lds, 3); F.w_mod = lds_ptr(lds, 4); F.b_mod = lds_ptr(lds, 5); F.g_pre = lds_ptr(lds, 6); F.g_post = lds_ptr(lds, 7);
    F.w_in = lds_ptr(lds, 8); F.w_out = lds_ptr(lds, 9); F.conv_w = lds_ptr(lds, 10); F.conv_b = lds_ptr(lds, 11); F.lam = lds_ptr(lds, 12); F.wa = lds_ptr(lds, 13); F.ba = lds_ptr(lds, 14); F.wx = lds_ptr(lds, 15);
    F.bx = lds_ptr(lds, 16); F.sink = lds_ptr(lds, 17); F.q_norm = lds_ptr(lds, 18); F.w_uq = lds_ptr(lds, 19); F.kv_norm = lds_ptr(lds, 20); F.w_ukv = lds_ptr(lds, 21); F.gate_b = lds_ptr(lds, 22); F.head_norm = lds_ptr(lds, 23);
    F.out = (float*)lds_ptr(lds, 24); F.ws = (unsigned char*)lds_ptr(lds, 25);
    return F;
}
#define WSP(T_, off) ((T_*)(F.ws + (off)))

__device__ __forceinline__ void rope4(f32x4& x1, f32x4& x2, const float* tp) {
    const f32x4 a = *(const f32x4*)tp, b = *(const f32x4*)(tp + 4);
    const float c0 = a[0], s0 = a[1], c1 = a[2], s1 = a[3], c2 = b[0], s2 = b[1], c3 = b[2], s3 = b[3];
    f32x4 o1, o2;
    o1[0] = x1[0] * c0 - x2[0] * s0; o2[0] = x2[0] * c0 + x1[0] * s0;
    o1[1] = x1[1] * c1 - x2[1] * s1; o2[1] = x2[1] * c1 + x1[1] * s1;
    o1[2] = x1[2] * c2 - x2[2] * s2; o2[2] = x2[2] * c2 + x1[2] * s2;
    o1[3] = x1[3] * c3 - x2[3] * s3; o2[3] = x2[3] * c3 + x1[3] * s3;
    x1 = o1; x2 = o2;
}
__device__ __forceinline__ void rope4v(f32x4& x1, f32x4& x2, const f32x4& a, const f32x4& b) {
    const float c0 = a[0], s0 = a[1], c1 = a[2], s1 = a[3], c2 = b[0], s2 = b[1], c3 = b[2], s3 = b[3];
    f32x4 o1, o2;
    o1[0] = x1[0] * c0 - x2[0] * s0; o2[0] = x2[0] * c0 + x1[0] * s0;
    o1[1] = x1[1] * c1 - x2[1] * s1; o2[1] = x2[1] * c1 + x1[1] * s1;
    o1[2] = x1[2] * c2 - x2[2] * s2; o2[2] = x2[2] * c2 + x1[2] * s2;
    o1[3] = x1[3] * c3 - x2[3] * s3; o2[3] = x2[3] * c3 + x1[3] * s3;
    x1 = o1; x2 = o2;
}
__device__ __forceinline__ u32x4 pack8(const f32x4& v0, const f32x4& v1) {
    u32x4 w; w.x = cvt_pk_bf16(v0[0], v0[1]); w.y = cvt_pk_bf16(v0[2], v0[3]); w.z = cvt_pk_bf16(v1[0], v1[1]); w.w = cvt_pk_bf16(v1[2], v1[3]); return w;
}
__device__ __forceinline__ float dot4(const f32x4& v) { return v[0] * v[0] + v[1] * v[1] + v[2] * v[2] + v[3] * v[3]; }

struct EpiIn {
    static constexpr bool PERM = true;
    bf16_t* P; bf16_t* KR; float* G; float* ST1; const float* tab16; const float* tab32; const float* gate_b; const LAS float* lt32;
    __device__ __forceinline__ void operator()(const f32x4 (&acc)[2][2][4][2], const pg8::Unit& u, int wr, int wc, int fr, int fq) const {
        const int pn = u.pn, rowb = u.pm * 256 + wr * 64 + fr;
        if (pn < 46) {
            const bool rope = (pn >= 8 && pn <= 12) && (u.pm >= 1);
            const bool stat = (pn >= 18 && pn <= 21);
            if (rope) {
#pragma unroll
                for (int ai = 0; ai < 2; ++ai) {
                    f32x4 ra[2], rb[2];
                    if (!(wc & 1)) {
#pragma unroll
                        for (int bj = 0; bj < 2; ++bj) { const float* tp = tab32 + ((4 * (u.pm - 1) + wr + 2 * ai) * 32 + 16 * bj + 4 * fq) * 2; ra[bj] = *(const f32x4*)tp; rb[bj] = *(const f32x4*)(tp + 4); }
                    }
#pragma unroll
                    for (int m = 0; m < 4; ++m) { const int row = rowb + ai * 128 + m * 16;
#pragma unroll
                        for (int bj = 0; bj < 2; ++bj) {
                            f32x4 v0 = acc[ai][bj][m][0], v1 = acc[ai][bj][m][1];
                            if (wc & 1) { const LAS float* tp = lt32 + ((fr + 16 * m) * 32 + 16 * bj + 4 * fq) * 2; const f32x4 ca_ = *(const LAS f32x4*)tp, cb_ = *(const LAS f32x4*)(tp + 4); rope4v(v0, v1, ca_, cb_); }
                            else rope4v(v0, v1, ra[bj], rb[bj]);
                            *(u32x4*)(P + (size_t)row * PW + pn * 256 + wc * 64 + bj * 32 + 8 * fq) = pack8(v0, v1);
                        }
                    }
                }
            } else {
#pragma unroll
            for (int ai = 0; ai < 2; ++ai)
#pragma unroll
                for (int m = 0; m < 4; ++m) {
                    const int row = rowb + ai * 128 + m * 16;
                    float ss = 0.f;
#pragma unroll
                    for (int bj = 0; bj < 2; ++bj) {
                        const f32x4 v0 = acc[ai][bj][m][0], v1 = acc[ai][bj][m][1];
                        if (stat) ss += dot4(v0) + dot4(v1);
                        *(u32x4*)(P + (size_t)row * PW + pn * 256 + wc * 64 + bj * 32 + 8 * fq) = pack8(v0, v1);
                    }
                    if (stat) { ss += __shfl_xor(ss, 16); ss += __shfl_xor(ss, 32); if (fq == 0) ST1[(size_t)row * 16 + (pn - 18) * 4 + wc] = ss; }
                }
            }
        } else {
#pragma unroll
            for (int ai = 0; ai < 2; ++ai)
#pragma unroll
                for (int m = 0; m < 4; ++m) {
                    const int row = rowb + ai * 128 + m * 16, t = row - 256, trow = t >> 6, tcol = t & 63;
                    if (wc == 0) {
#pragma unroll
                        for (int bj = 0; bj < 2; ++bj) { f32x4 v0 = acc[ai][bj][m][0], v1 = acc[ai][bj][m][1];
                            if (u.pm >= 1) { const int pos = (bj == 0) ? trow : tcol; rope4(v0, v1, tab16 + (pos * 16 + 4 * fq) * 2); }
                            *(u32x4*)(KR + (size_t)row * LDKV + 2048 + 32 * bj + 8 * fq) = pack8(v0, v1); }
                    } else if (wc == 1) {
                        const f32x4 v0 = acc[ai][0][m][0], v1 = acc[ai][0][m][1];
                        const f32x4 b0 = *(const f32x4*)(gate_b + 8 * fq), b1 = *(const f32x4*)(gate_b + 8 * fq + 4);
                        *(f32x4*)(G + (size_t)row * 32 + 8 * fq) = v0 + b0; *(f32x4*)(G + (size_t)row * 32 + 8 * fq + 4) = v1 + b1;
                    }
                }
        }
    }
};
struct EpiUq {
    static constexpr bool PERM = true;
    bf16_t* QM; const float* ST1; const float* tab16; const LAS float* lt16;
    __device__ __forceinline__ void operator()(const f32x4 (&acc)[2][2][4][2], const pg8::Unit& u, int wr, int wc, int fr, int fq) const {
        const int pn = u.pn, rowb = u.pm * 256 + wr * 64 + fr;
        const bool ropew = ((8 * pn + 2 * wc) % 6 == 4) && (u.pm >= 1);
        f32x4 ra[2], rb[2];
#pragma unroll
        for (int ai = 0; ai < 2; ++ai) { const float* tp = tab16 + ((ropew ? 4 * (u.pm - 1) + wr + 2 * ai : 0) * 16 + 4 * fq) * 2; ra[ai] = *(const f32x4*)tp; rb[ai] = *(const f32x4*)(tp + 4); }
        float rstd[2][4];
#pragma unroll
        for (int ai = 0; ai < 2; ++ai)
#pragma unroll
            for (int m = 0; m < 4; ++m) { const int row = rowb + ai * 128 + m * 16;
                const f32x4 s0 = *(const f32x4*)(ST1 + (size_t)row * 16 + (fq < 3 ? fq : 0) * 4);
                float ssum = fq < 3 ? (s0[0] + s0[1]) + (s0[2] + s0[3]) : 0.f; ssum += __shfl_xor(ssum, 16); ssum += __shfl_xor(ssum, 32);
                rstd[ai][m] = rsqrtf(ssum * (1.f / 768.f) + EPS) * (0.07216878364870322f * 1.4426950408889634f); }
#pragma unroll
        for (int ai = 0; ai < 2; ++ai)
#pragma unroll
            for (int m = 0; m < 4; ++m) { const int row = rowb + ai * 128 + m * 16;
#pragma unroll
                for (int bj = 0; bj < 2; ++bj) {
                    f32x4 v0 = acc[ai][bj][m][0] * rstd[ai][m], v1 = acc[ai][bj][m][1] * rstd[ai][m];
                    if (ropew) { if (bj == 0) rope4v(v0, v1, ra[ai], rb[ai]);
                                 else { const LAS float* tp = lt16 + ((fr + 16 * m) * 16 + 4 * fq) * 2; const f32x4 ca_ = *(const LAS f32x4*)tp, cb_ = *(const LAS f32x4*)(tp + 4); rope4v(v0, v1, ca_, cb_); } }
                    *(u32x4*)(QM + (size_t)row * 1536 + pn * 256 + wc * 64 + bj * 32 + 8 * fq) = pack8(v0, v1);
                }
            }
    }
};
struct EpiUkv {
    static constexpr bool PERM = true;
    bf16_t* KV; const float* ST1;
    __device__ __forceinline__ void operator()(const f32x4 (&acc)[2][2][4][2], const pg8::Unit& u, int wr, int wc, int fr, int fq) const {
        const int pn = u.pn, rowb = u.pm * 256 + wr * 64 + fr;
        float rstdv[2][4];
#pragma unroll
        for (int ai = 0; ai < 2; ++ai)
#pragma unroll
            for (int m = 0; m < 4; ++m) { const f32x4 s0 = *(const f32x4*)(ST1 + (size_t)(rowb + ai * 128 + m * 16) * 16 + 12);
                rstdv[ai][m] = rsqrtf((s0[0] + s0[1] + s0[2] + s0[3]) * (1.f / 256.f) + EPS); }
#pragma unroll
        for (int ai = 0; ai < 2; ++ai)
#pragma unroll
            for (int m = 0; m < 4; ++m) {
                const int row = rowb + ai * 128 + m * 16;
                const float rstd = rstdv[ai][m];
#pragma unroll
                for (int bj = 0; bj < 2; ++bj) {
                    const f32x4 v0 = acc[ai][bj][m][0] * rstd, v1 = acc[ai][bj][m][1] * rstd;
                    *(u32x4*)(KV + (size_t)row * LDKV + pn * 256 + wc * 64 + bj * 32 + 8 * fq) = pack8(v0, v1);
                }
            }
    }
};
struct EpiOut {
    static constexpr bool PERM = true;
    bf16_t* Z; float* ST2; int row0;
    __device__ __forceinline__ void operator()(const f32x4 (&acc)[2][2][4][2], const pg8::Unit& u, int wr, int wc, int fr, int fq) const {
        const int pn = u.pn, rowb = row0 + u.pm * 256 + wr * 64 + fr;
#pragma unroll
        for (int ai = 0; ai < 2; ++ai)
#pragma unroll
            for (int m = 0; m < 4; ++m) {
                const int row = rowb + ai * 128 + m * 16;
                float ss = 0.f;
#pragma unroll
                for (int bj = 0; bj < 2; ++bj) {
                    const f32x4 v0 = acc[ai][bj][m][0], v1 = acc[ai][bj][m][1];
                    ss += dot4(v0) + dot4(v1);
                    *(u32x4*)(Z + (size_t)row * DM + pn * 256 + wc * 64 + bj * 32 + 8 * fq) = pack8(v0, v1);
                }
                ss += __shfl_xor(ss, 16); ss += __shfl_xor(ss, 32);
                if (fq == 0) ST2[(size_t)row * 64 + pn * 4 + wc] = ss;
            }
    }
};

__device__ __forceinline__ int swa_perm(int sh) { const int g = sh >> 5, fq = (sh >> 3) & 3, n = (sh >> 2) & 1, j = sh & 3; return 64 * (g >> 1) + 32 * n + 16 * (g & 1) + 4 * fq + j; }
__device__ __forceinline__ int rope64_perm(int s) { const int g = s >> 5, fq = (s >> 3) & 3, n = (s >> 2) & 1, j = s & 3; return 32 * g + 16 * n + 4 * fq + j; }
struct CmWin {
    __device__ __forceinline__ int operator()(int s, float& sc) const {
        if (s < S_SWA_Q) return s;
        if (s < S_SWA_K) { const int x = s - S_SWA_Q; sc = 0.08838834764831845f * 1.4426950408889634f; return O_SWA_Q + (x & ~127) + swa_perm(x & 127); }
        if (s < S_SWA_V) { const int x = s - S_SWA_K; return O_SWA_K + (x & ~127) + swa_perm(x & 127); }
        if (s < S_MLA_G) return s;
        if (s < S_ML_Q) return O_MLA_G + (s - S_MLA_G);
        if (s < S_ML_K) return O_ML_Q + (s - S_ML_Q);
        if (s < S_ML_V) { sc = 0.08838834764831845f; return O_ML_K + (s - S_ML_K); }
        if (s < S_ML_O) return O_ML_V + (s - S_ML_V);
        if (s < S_ML_G) return O_ML_O + (s - S_ML_O);
        if (s < S_MISC) return O_ML_G + (s - S_ML_G);
        const int x = s - S_MISC;
        if (x < 64) return O_KR + rope64_perm(x);
        if (x < 96) return O_ML_GT + (x - 64);
        return -1;
    }
};
struct CmId { __device__ __forceinline__ int operator()(int s, float&) const { return s; } };
struct CmUq { __device__ __forceinline__ int operator()(int s, float&) const { const int h = s / 192, x = s - h * 192; return x < 128 ? s : h * 192 + 128 + rope64_perm(x - 128); } };

template <int KT, class CM>
__device__ __forceinline__ void transpose_item(const Frame& F, const float* __restrict__ src, int ld_src, int K, bf16_t* __restrict__ dst, const float* __restrict__ rowscale, const CM& cm, int s0, int k0) {
    constexpr int PW_ = KT / 2 + 1, NJ = KT / 64;
    LAS unsigned* tile = (LAS unsigned*)(F.lds + LDS_RING);
    const int q = F.tid & 15, kp = F.tid >> 4;
    float sc = 1.f; const int col = cm(s0 + 4 * q, sc);
    f32x4 v0[NJ], v1[NJ];
#pragma unroll
    for (int j = 0; j < NJ; ++j) { v0[j] = (f32x4){0.f, 0.f, 0.f, 0.f}; v1[j] = v0[j]; }
    if (col >= 0) {
#pragma unroll
        for (int j = 0; j < NJ; ++j) { const int k = k0 + 2 * (kp + 32 * j);
            v0[j] = __builtin_nontemporal_load((const f32x4*)(src + (size_t)k * ld_src + col)); v1[j] = __builtin_nontemporal_load((const f32x4*)(src + (size_t)(k + 1) * ld_src + col)); }
#pragma unroll
        for (int j = 0; j < NJ; ++j) { const int k = k0 + 2 * (kp + 32 * j); float r0 = sc, r1 = sc; if (rowscale) { r0 *= rowscale[k]; r1 *= rowscale[k + 1]; } v0[j] *= r0; v1[j] *= r1; }
    }
#pragma unroll
    for (int j = 0; j < NJ; ++j)
#pragma unroll
        for (int e = 0; e < 4; ++e) tile[(4 * q + e) * PW_ + kp + 32 * j] = cvt_pk_bf16(v0[j][e], v1[j][e]);
    __syncthreads();
    const int sr = F.tid >> 3, c8 = F.tid & 7;
#pragma unroll
    for (int j = 0; j < NJ; ++j) { const int kc = (c8 + 8 * j) * 4;
        u32x4 w; w.x = tile[sr * PW_ + kc]; w.y = tile[sr * PW_ + kc + 1]; w.z = tile[sr * PW_ + kc + 2]; w.w = tile[sr * PW_ + kc + 3];
        *(u32x4*)(dst + (size_t)(s0 + sr) * K + k0 + 2 * kc) = w; }
    __syncthreads();
}

struct ModPre { f32x4 w[16]; };
__device__ __forceinline__ void mod_pre_issue(ModPre& R, const Frame& F, int item) {
    const int l = item / 384, r = item % 384, kh = r / 192, n0 = (r % 192) * 64;
    const int cq = F.lane & 15, kl = (F.lane >> 4) + 4 * F.wave;
    const float* wp = F.w_mod + ((size_t)l * DM + kh * 2048) * 12288 + n0 + 4 * cq;
#pragma unroll
    for (int i = 0; i < 16; ++i) R.w[i] = __builtin_nontemporal_load((const f32x4*)(wp + (size_t)(kl + 32 * i) * 12288));
}
__device__ __forceinline__ void mod_loop(const Frame& F) {
    if (F.bid >= 768) return;
    LAS float* sc = (LAS float*)(F.lds + LDS_RING); LAS float* red = sc + 4096;
    ModPre R; mod_pre_issue(R, F, F.bid);
#pragma unroll 1
    for (int item = F.bid; item < 768; item += F.G) {
        const int l = item / 384, r = item % 384, kh = r / 192, n0 = (r % 192) * 64;
        for (int i = F.tid; i < 2048; i += NTHR) { sc[i] = siluf_(F.c[kh * 2048 + i]); sc[2048 + i] = siluf_(F.c_ctx[kh * 2048 + i]); }
        __syncthreads();
        const int cq = F.lane & 15, kl = (F.lane >> 4) + 4 * F.wave;
        f32x4 a0 = {0.f, 0.f, 0.f, 0.f}, a1 = {0.f, 0.f, 0.f, 0.f};
        const float* wp = F.w_mod + ((size_t)l * DM + kh * 2048) * 12288 + n0 + 4 * cq;
#pragma unroll
        for (int i = 0; i < 16; ++i) { const int k = kl + 32 * i; a0 += R.w[i] * sc[k]; a1 += R.w[i] * sc[2048 + k]; }
#pragma unroll 16
        for (int i = 16; i < 64; ++i) { const int k = kl + 32 * i; const f32x4 w = __builtin_nontemporal_load((const f32x4*)(wp + (size_t)k * 12288)); a0 += w * sc[k]; a1 += w * sc[2048 + k]; }
        mod_pre_issue(R, F, item + F.G < 768 ? item + F.G : item);
#pragma unroll
        for (int j = 0; j < 4; ++j) { red[(kl * 64 + 4 * cq + j) * 2] = a0[j]; red[(kl * 64 + 4 * cq + j) * 2 + 1] = a1[j]; }
        __syncthreads();
        if (F.tid < 128) { const int col = F.tid & 63, v = F.tid >> 6; float s_ = 0.f;
            for (int k2 = 0; k2 < 32; ++k2) s_ += red[(k2 * 64 + col) * 2 + v];
            if (kh == 0) s_ += F.b_mod[l * 12288 + n0 + col];
            atomicAdd(WSP(float, WS_MOD) + (size_t)(l * 2 + v) * 12288 + n0 + col, s_); }
        __syncthreads();
    }
}

__device__ __forceinline__ void rope_tables(const Frame& F) {
    if (F.tid < 48) {
        const bool is32 = F.tid >= 16; const int i = is32 ? F.tid - 16 : F.tid, half = is32 ? 32 : 16;
        const double r = is32 ? 0.7498942093324558 : 0.5623413251903491;
        double f = 1.0; for (int q = 0; q < i; ++q) f *= r;
        double cb = 1.0, sb = f, term_c = 1.0, term_s = f; const double f2 = f * f;
        for (int q = 1; q < 14; ++q) { term_c *= -f2 / (double)((2 * q - 1) * (2 * q)); term_s *= -f2 / (double)((2 * q) * (2 * q + 1)); cb += term_c; sb += term_s; }
        float* tab = is32 ? WSP(float, WS_TAB32) : WSP(float, WS_TAB16);
        double c = 1.0, s = 0.0;
        for (int pos = 0; pos < 256; ++pos) { tab[(pos * half + i) * 2] = (float)c; tab[(pos * half + i) * 2 + 1] = (float)s; const double c2 = c * cb - s * sb; s = s * cb + c * sb; c = c2; }
    }
}

constexpr int NB_WIN = 188 * 16, NB_WOUT = 64 * 16, NB_L = NB_WIN + NB_WOUT, NB_ALL = 2 * NB_L;
struct TDesc { const float* sp; bf16_t* dp; int ld; float sc; bool ok; };
__device__ __forceinline__ TDesc big_item(const Frame& F, int it, int q, int kp) {
    TDesc d; const int l = it / NB_L; int r = it - l * NB_L; d.sc = 1.f;
    if (r < NB_WIN) { const int s0 = (r >> 4) * 64, k0 = (r & 15) * 256; const int col = CmWin()(s0 + 4 * q, d.sc); d.ok = col >= 0; d.ld = NIN;
        d.sp = F.w_in + (size_t)l * DM * NIN + (size_t)(k0 + 2 * kp) * NIN + (col >= 0 ? col : 0); d.dp = WSP(bf16_t, WS_WIN) + (size_t)l * NPAD * DM + (size_t)s0 * DM + k0; }
    else { r -= NB_WIN; const int s0 = (r >> 4) * 64, k0 = (r & 15) * 256; d.ok = true; d.ld = DM;
        d.sp = F.w_out + (size_t)l * DM * DM + (size_t)(k0 + 2 * kp) * DM + s0 + 4 * q; d.dp = WSP(bf16_t, WS_WOUT) + (size_t)l * DM * DM + (size_t)s0 * DM + k0; }
    return d;
}
#define TLOAD(D, V0, V1) do { _Pragma("unroll") for (int j = 0; j < 4; ++j) { if ((D).ok) { V0[j] = __builtin_nontemporal_load((const f32x4*)((D).sp + (size_t)(64 * j) * (D).ld)); \
        V1[j] = __builtin_nontemporal_load((const f32x4*)((D).sp + (size_t)(64 * j + 1) * (D).ld)); } else { V0[j] = (f32x4){0.f, 0.f, 0.f, 0.f}; V1[j] = V0[j]; } } } while (0)
#define TSTEP(D, V0, V1, ITN) do { \
        _Pragma("unroll") for (int j = 0; j < 4; ++j) _Pragma("unroll") for (int e = 0; e < 4; ++e) tile[(4 * q + e) * 129 + kp + 32 * j] = cvt_pk_bf16(V0[j][e] * (D).sc, V1[j][e] * (D).sc); \
        __syncthreads(); \
        bf16_t* dp_ = (D).dp; const int itn_ = (ITN); \
        if (itn_ < NB_ALL) { (D) = big_item(F, itn_, q, kp); TLOAD(D, V0, V1); }       \
        _Pragma("unroll") for (int j = 0; j < 4; ++j) { const int kc = (c8 + 8 * j) * 4; \
            u32x4 w; w.x = tile[sr * 129 + kc]; w.y = tile[sr * 129 + kc + 1]; w.z = tile[sr * 129 + kc + 2]; w.w = tile[sr * 129 + kc + 3]; \
            *(u32x4*)(dp_ + (size_t)sr * DM + 2 * kc) = w; } \
        __syncthreads(); } while (0)
__device__ __forceinline__ void big_transposes(const Frame& F) {
    LAS unsigned* tile = (LAS unsigned*)(F.lds + LDS_RING);
    const int q = F.tid & 15, kp = F.tid >> 4, sr = F.tid >> 3, c8 = F.tid & 7;
    int it = F.bid; if (it >= NB_ALL) return;
    TDesc da = big_item(F, it, q, kp), db = da; f32x4 a0[4], a1[4], b0[4], b1[4];
    TLOAD(da, a0, a1);
    const bool hasb = it + F.G < NB_ALL;
    if (hasb) { db = big_item(F, it + F.G, q, kp); TLOAD(db, b0, b1); }
    for (; it < NB_ALL; it += 2 * F.G) {
        TSTEP(da, a0, a1, it + 2 * F.G);
        if (it + F.G < NB_ALL) TSTEP(db, b0, b1, it + 3 * F.G);
    }
}
#undef TLOAD
#undef TSTEP

__device__ __forceinline__ void p0_prologue(const Frame& F) {
    if (F.bid == 0) rope_tables(F);
    mod_loop(F);
    REP(14) big_transposes(F);
    constexpr int N_UQ = 24 * 3, N_UKV = 32, N_LRU = 32 * 4, N_L = N_UQ + N_UKV + N_LRU;
    for (int it = F.bid; it < 2 * N_L; it += F.G) {
        const int l = it / N_L; int r = it - l * N_L;
        if (r < N_UQ) { transpose_item<256>(F, F.w_uq + (size_t)l * 768 * 1536, 1536, 768, WSP(bf16_t, WS_WUQ) + (size_t)l * 1536 * 768, F.q_norm + l * 768, CmUq(), (r / 3) * 64, (r % 3) * 256); continue; }
        r -= N_UQ;
        if (r < N_UKV) { transpose_item<256>(F, F.w_ukv + (size_t)l * 256 * 2048, 2048, 256, WSP(bf16_t, WS_WUKV) + (size_t)l * 2048 * 256, F.kv_norm + l * 256, CmId(), r * 64, 0); continue; }
        r -= N_UKV;
        { const int mat = r >> 2, q = r & 3, gate = mat >> 4, db = mat & 15;
          const float* src = (gate ? F.wx : F.wa) + ((size_t)l * 16 + db) * 16384;
          bf16_t* dst = WSP(bf16_t, WS_LRUW) + (((size_t)l * 2 + (db >> 3)) * 2 + gate) * 8 * 16384 + (size_t)(db & 7) * 16384;
          transpose_item<64>(F, src, 128, 128, dst, nullptr, CmId(), (q >> 1) * 64, (q & 1) * 64); }
    }
}

__device__ __forceinline__ float wave_sum(float v) {
#pragma unroll
    for (int o = 32; o >= 1; o >>= 1) v += __shfl_xor(v, o);
    return v;
}
typedef unsigned int u32x2v __attribute__((__vector_size__(8)));
__device__ __forceinline__ __amdgpu_buffer_rsrc_t mk_rsrc(const void* p, size_t bytes) { return __builtin_amdgcn_make_buffer_rsrc((void*)p, (short)0, (int)bytes, 0x00020000); }
__device__ __forceinline__ f32x4 bld_f4(__amdgpu_buffer_rsrc_t r, unsigned vo, unsigned so) { const u32x4v v = __builtin_amdgcn_raw_buffer_load_b128(r, (int)vo, (int)so, 0); return __builtin_bit_cast(f32x4, v); }
__device__ __forceinline__ u32x2 bld_u2(__amdgpu_buffer_rsrc_t r, unsigned vo, unsigned so) { const u32x2v v = __builtin_amdgcn_raw_buffer_load_b64(r, (int)vo, (int)so, 0); return __builtin_bit_cast(u32x2, v); }
__device__ __forceinline__ void bst_f4(__amdgpu_buffer_rsrc_t r, unsigned vo, unsigned so, f32x4 x) { __builtin_amdgcn_raw_buffer_store_b128(__builtin_bit_cast(u32x4v, x), r, (int)vo, (int)so, 0); }
__device__ __forceinline__ void bst_u2(__amdgpu_buffer_rsrc_t r, unsigned vo, unsigned so, u32x2 x) { __builtin_amdgcn_raw_buffer_store_b64(__builtin_bit_cast(u32x2v, x), r, (int)vo, (int)so, 0); }
__device__ __forceinline__ void norm_phase(const Frame& F, int l, int row_lo, int row_hi, int blk0, int nblk) {
    if (F.bid < blk0 || F.bid >= blk0 + nblk || row_lo + (F.bid - blk0) * NWAVE >= row_hi) return;
    const float* MOD = WSP(float, WS_MOD);
    const __amdgpu_buffer_rsrc_t rZ = mk_rsrc(WSP(bf16_t, WS_Z), (size_t)T * DM * 2), rH = mk_rsrc(WSP(bf16_t, WS_H), (size_t)T * DM * 2);
    const __amdgpu_buffer_rsrc_t rXC = mk_rsrc(WSP(float, WS_XC), (size_t)CTX * DM * 4), rOut = mk_rsrc(F.out, (size_t)SEQ * DM * 4);
    const __amdgpu_buffer_rsrc_t rX = mk_rsrc(F.x, (size_t)SEQ * DM * 4), rCtx = mk_rsrc(F.ctx, (size_t)CTX * DM * 4);
    const unsigned vo = (unsigned)F.lane * 16u, vo2 = (unsigned)F.lane * 8u;
    LAS float* tab = (LAS float*)(F.lds + LDS_RING);
    { const int v_lo = (l == 0) ? 0 : (row_lo < CTX ? 1 : 0), v_hi = (l == 0) ? 1 : v_lo;
      for (int v = v_lo; v <= v_hi; ++v)
#pragma unroll
          for (int k = 0; k < 2; ++k) { const int c = (F.tid + NTHR * k) * 4;
              if (l < 2) { const f32x4 gp = *(const f32x4*)(F.g_pre + l * DM + c), sc = *(const f32x4*)(MOD + (size_t)(l * 2 + v) * 12288 + DM + c), sh = *(const f32x4*)(MOD + (size_t)(l * 2 + v) * 12288 + c);
                  *(LAS f32x4*)(tab + (v * 3 + 0) * DM + c) = gp * (sc + 1.f); *(LAS f32x4*)(tab + (v * 3 + 1) * DM + c) = sh; }
              if (l >= 1) { const f32x4 gt = *(const f32x4*)(MOD + (size_t)((l - 1) * 2 + v) * 12288 + 2 * DM + c), gq = *(const f32x4*)(F.g_post + (l - 1) * DM + c);
                  *(LAS f32x4*)(tab + (v * 3 + 2) * DM + c) = gt * gq; } } }
    __syncthreads();
    for (int row = row_lo + (F.bid - blk0) * NWAVE + F.wave; row < row_hi; row += nblk * NWAVE) {
        const bool is_ctx = row < CTX;
        const unsigned rr = (unsigned)(is_ctx ? row : row - CTX) * (unsigned)(DM * 4);
        const LAS float* tv = tab + (is_ctx ? 3 : 0) * DM + F.lane * 4;
        f32x4 xv[16];
        if (l <= 1) {
#pragma unroll
            for (int i = 0; i < 16; ++i) xv[i] = is_ctx ? bld_f4(rCtx, vo, rr + i * 1024u) : bld_f4(rX, vo, rr + i * 1024u);
        } else {
#pragma unroll
            for (int i = 0; i < 16; ++i) { if (is_ctx) xv[i] = bld_f4(rXC, vo, rr + i * 1024u);
                else { const u32x2 t = bld_u2(rOut, vo2, rr + i * 512u); xv[i] = (f32x4){bflo(t.x), bfhi(t.x), bflo(t.y), bfhi(t.y)}; } }
        }
        if (l >= 1) {
            u32x2 zzv[16]; const unsigned zo = (unsigned)row * (unsigned)(DM * 2);
            const float st2v = WSP(float, WS_ST2)[(size_t)row * 64 + F.lane];
#pragma unroll
            for (int i = 0; i < 16; ++i) zzv[i] = bld_u2(rZ, vo2, zo + i * 512u);
            const float rstd_z = rsqrtf(wave_sum(st2v) * (1.f / DM) + EPS);
#pragma unroll
            for (int i = 0; i < 16; ++i) {
                const u32x2 zz = zzv[i]; const f32x4 g4 = *(const LAS f32x4*)(tv + 2 * DM + i * 256);
                xv[i][0] += g4[0] * (bflo(zz.x) * rstd_z); xv[i][1] += g4[1] * (bfhi(zz.x) * rstd_z);
                xv[i][2] += g4[2] * (bflo(zz.y) * rstd_z); xv[i][3] += g4[3] * (bfhi(zz.y) * rstd_z);
                if (is_ctx) bst_f4(rXC, vo, rr + i * 1024u, xv[i]);
                else if (l == 1) { u32x2 w; w.x = cvt_pk_bf16(xv[i][0], xv[i][1]); w.y = cvt_pk_bf16(xv[i][2], xv[i][3]); bst_u2(rOut, vo2, rr + i * 512u, w); }
                else bst_f4(rOut, vo, rr + i * 1024u, xv[i]); }
        }
        if (l < 2) {
            float ss = 0.f;
#pragma unroll
            for (int i = 0; i < 16; ++i) ss += dot4(xv[i]);
            const float rstd = rsqrtf(wave_sum(ss) * (1.f / DM) + EPS);
            const unsigned ho = (unsigned)row * (unsigned)(DM * 2);
#pragma unroll
            for (int i = 0; i < 16; ++i) {
                const f32x4 a4 = *(const LAS f32x4*)(tv + i * 256), b4 = *(const LAS f32x4*)(tv + DM + i * 256);
                const float h0 = xv[i][0] * rstd * a4[0] + b4[0], h1 = xv[i][1] * rstd * a4[1] + b4[1];
                const float h2 = xv[i][2] * rstd * a4[2] + b4[2], h3 = xv[i][3] * rstd * a4[3] + b4[3];
                u32x2 w; w.x = cvt_pk_bf16(h0, h1); w.y = cvt_pk_bf16(h2, h3); bst_u2(rH, vo2, ho + i * 512u, w); }
        }
    }
    __syncthreads();
}

#define SBAR() __builtin_amdgcn_sched_barrier(0)
__device__ __forceinline__ int crow(int r, int hi) { return (r & 3) + 8 * (r >> 2) + 4 * hi; }
__device__ __forceinline__ int v_st(int k, int c) { const int kk = (k & ~0xC) | ((k & 4) << 1) | ((k & 8) >> 1); return ((kk >> 3) * 4 + (c >> 5)) * 512 + ((kk & 7) * 32 + (c & 31)) * 2; }
__device__ __forceinline__ int v_rd_base(int lane) { return ((lane & 3) << 3) | (((lane >> 2) & 3) << 6) | (((lane >> 4) & 1) << 5) | (((lane >> 5) & 1) << 8); }
constexpr int v_rd_off(int d0, int ks, int half) { return d0 * 512 + ks * 4096 + half * 2048; }
template <int OFF> __device__ __forceinline__ s16x4 tr_read(int vb) {
    s16x4 r; asm volatile("ds_read_b64_tr_b16 %0, %1 offset:%2" : "=&v"(r) : "v"(vb), "i"(OFF) : "memory"); return r;
}
template <int S> __device__ __forceinline__ void pv_rd(int vb, s16x4& a, s16x4& b, s16x4& c, s16x4& d) {
    a = tr_read<v_rd_off(S >> 1, 2 * (S & 1), 0)>(vb); b = tr_read<v_rd_off(S >> 1, 2 * (S & 1), 1)>(vb);
    c = tr_read<v_rd_off(S >> 1, 2 * (S & 1) + 1, 0)>(vb); d = tr_read<v_rd_off(S >> 1, 2 * (S & 1) + 1, 1)>(vb);
}
#define PVPK(L, H) (bf16x8){L[0], L[1], L[2], L[3], H[0], H[1], H[2], H[3]}
#define PV_STEP(S, OD, PA, PB, CA, CB, CC, CD, NA, NB, NC, ND_) do { if (S < 7) pv_rd<(S < 7 ? S + 1 : 7)>(vb, NA, NB, NC, ND_); \
    if (S < 7) asm volatile("s_waitcnt lgkmcnt(4)" : "+v"(CA), "+v"(CB), "+v"(CC), "+v"(CD) :: "memory"); else asm volatile("s_waitcnt lgkmcnt(0)" : "+v"(CA), "+v"(CB), "+v"(CC), "+v"(CD) :: "memory"); \
    OD = __builtin_amdgcn_mfma_f32_32x32x16_bf16(PVPK(CA, CB), PA, OD, 0, 0, 0); OD = __builtin_amdgcn_mfma_f32_32x32x16_bf16(PVPK(CC, CD), PB, OD, 0, 0, 0); } while (0)
__device__ __forceinline__ void pv_d0(f32x16* o, int vb, bf16x8 pa0, bf16x8 pa1, bf16x8 pa2, bf16x8 pa3) {
    s16x4 a0, b0, c0, d0, a1, b1, c1, d1;
    pv_rd<0>(vb, a0, b0, c0, d0);
    PV_STEP(0, o[0], pa0, pa1, a0, b0, c0, d0, a1, b1, c1, d1);
    PV_STEP(1, o[0], pa2, pa3, a1, b1, c1, d1, a0, b0, c0, d0);
    PV_STEP(2, o[1], pa0, pa1, a0, b0, c0, d0, a1, b1, c1, d1);
    PV_STEP(3, o[1], pa2, pa3, a1, b1, c1, d1, a0, b0, c0, d0);
    PV_STEP(4, o[2], pa0, pa1, a0, b0, c0, d0, a1, b1, c1, d1);
    PV_STEP(5, o[2], pa2, pa3, a1, b1, c1, d1, a0, b0, c0, d0);
    PV_STEP(6, o[3], pa0, pa1, a0, b0, c0, d0, a1, b1, c1, d1);
    PV_STEP(7, o[3], pa2, pa3, a1, b1, c1, d1, a0, b0, c0, d0);
}
#undef PV_STEP
#undef PVPK
constexpr float THR2 = 11.5415603f;
template <int ABL = 0>
__device__ __forceinline__ void partialSM(f32x16& p0, f32x16& p1, float& m_reg, float& alpha) {
    if (ABL == 1) { alpha = 1.f; return; }
    float pmax = p0[0];
#pragma unroll
    for (int r = 1; r < 16; ++r) pmax = fmaxf(pmax, p0[r]);
#pragma unroll
    for (int r = 0; r < 16; ++r) pmax = fmaxf(pmax, p1[r]);
    { auto rr = __builtin_amdgcn_permlane32_swap(__float_as_uint(pmax), __float_as_uint(pmax), false, false);
      pmax = fmaxf(__uint_as_float(rr[0]), __uint_as_float(rr[1])); }
    if (__builtin_expect(__all(pmax <= THR2), 1)) { alpha = 1.f; }
    else { const float sh = fmaxf(pmax, 0.f); alpha = __builtin_amdgcn_exp2f(-sh); m_reg += sh;
#pragma unroll
        for (int r = 0; r < 16; ++r) { p0[r] -= sh; p1[r] -= sh; } }
#pragma unroll
    for (int r = 0; r < 16; ++r) p0[r] = __builtin_amdgcn_exp2f(p0[r]);
}
template <int ABL = 0>
__device__ __forceinline__ void finishSM(f32x16& p0, f32x16& p1, float alpha, float& l_reg, bf16x8& pa0, bf16x8& pa1, bf16x8& pa2, bf16x8& pa3) {
    if (ABL != 1) {
#pragma unroll
    for (int r = 0; r < 16; ++r) p1[r] = __builtin_amdgcn_exp2f(p1[r]); }
    float ps = 0;
    if (ABL != 1) {
#pragma unroll
    for (int r = 0; r < 16; ++r) ps += p0[r];
#pragma unroll
    for (int r = 0; r < 16; ++r) ps += p1[r]; }
    { auto rr = __builtin_amdgcn_permlane32_swap(__float_as_uint(ps), __float_as_uint(ps), false, false);
      ps = __uint_as_float(rr[0]) + __uint_as_float(rr[1]); }
    l_reg = l_reg * alpha + ps;
#define PK4(P, BASE, OUT) do { unsigned a0 = cvt_pk_bf16(P[BASE + 0], P[BASE + 1]), a1 = cvt_pk_bf16(P[BASE + 2], P[BASE + 3]);   \
    unsigned b0 = cvt_pk_bf16(P[BASE + 4], P[BASE + 5]), b1 = cvt_pk_bf16(P[BASE + 6], P[BASE + 7]);                              \
    auto r0 = __builtin_amdgcn_permlane32_swap(a0, b0, false, false); auto r1 = __builtin_amdgcn_permlane32_swap(a1, b1, false, false); \
    u32x4 w = {r0[0], r1[0], r0[1], r1[1]}; OUT = *reinterpret_cast<bf16x8*>(&w); } while (0)
    PK4(p0, 0, pa0); PK4(p0, 8, pa1); PK4(p1, 0, pa2); PK4(p1, 8, pa3);
#undef PK4
}

template <int N> __device__ __forceinline__ void sg_rmv() { if constexpr (N > 0) { __builtin_amdgcn_sched_group_barrier(0x008, 2, 0); __builtin_amdgcn_sched_group_barrier(0x100, 2, 0); sg_rmv<N - 1>(); } }
template <int N> __device__ __forceinline__ void sg_mv() { if constexpr (N > 0) { __builtin_amdgcn_sched_group_barrier(0x008, 2, 0); sg_mv<N - 1>(); } }
struct TsDense { __device__ __forceinline__ int row(int j) const { return 64 * j; } __device__ __forceinline__ int tok(int) const { return 0; } __device__ __forceinline__ bool masked(int) const { return false; } };
struct TsSwa {
    int tb;
    __device__ __forceinline__ int tok(int j) const { return tb + 64 * j; }
    __device__ __forceinline__ bool masked(int j) const { return j < 5 && (j == 0 || j == 4 || tb + 64 * j < 0 || tb + 64 * j + 64 > SEQ); }
    __device__ __forceinline__ int row(int j) const { if (j >= 5) return 64 * (j - 5); int t = tb + 64 * j; t = t < 0 ? 0 : (t > SEQ - 64 ? SEQ - 64 : t); return CTX + t; }
};

__device__ __forceinline__ bf16x8 buf_ld16(__amdgpu_buffer_rsrc_t rs, unsigned voff, unsigned soff) { const u32x4v v = __builtin_amdgcn_raw_buffer_load_b128(rs, (int)voff, (int)soff, 0); return __builtin_bit_cast(bf16x8, v); }
#ifndef ABL_KIND
#define ABL_KIND 0
#endif

constexpr int TLD = 136;
__device__ __forceinline__ bf16x8 frag_kc(const LAS bf16_t* base, int ld, int idx0, int k0, int lane) {
    return *(const LAS bf16x8*)(base + (idx0 + (lane & 15)) * ld + k0 + 8 * (lane >> 4));
}
struct TrFrag { s16x4 lo, hi; };
__device__ __forceinline__ void frag_tr_issue(TrFrag& f, const LAS bf16_t* base, int ld, int idx0, int k0, int lane) {
    const int g = lane >> 4, i = lane & 15, q = i >> 2, p = i & 3;
    const int a = (int)(uintptr_t)(base + (k0 + 8 * g + q) * ld + idx0 + 4 * p);
    asm volatile("ds_read_b64_tr_b16 %0, %1" : "=&v"(f.lo) : "v"(a) : "memory");
    asm volatile("ds_read_b64_tr_b16 %0, %1" : "=&v"(f.hi) : "v"(a + 4 * ld * 2) : "memory");
}
__device__ __forceinline__ void frag_tr_issue_p(TrFrag& f, const LAS bf16_t* base, int ld, int idx32, int nn, int k0, int lane) {
    const int g = lane >> 4, i = lane & 15, q = i >> 2, p = i & 3;
    const int a = (int)(uintptr_t)(base + (k0 + 8 * g + q) * ld + idx32 + 8 * p + 4 * nn);
    asm volatile("ds_read_b64_tr_b16 %0, %1" : "=&v"(f.lo) : "v"(a) : "memory");
    asm volatile("ds_read_b64_tr_b16 %0, %1" : "=&v"(f.hi) : "v"(a + 4 * ld * 2) : "memory");
}
#define TRGET(f) ((bf16x8){(f).lo[0], (f).lo[1], (f).lo[2], (f).lo[3], (f).hi[0], (f).hi[1], (f).hi[2], (f).hi[3]})
#define LDS_WAIT(n) asm volatile("s_waitcnt lgkmcnt(" #n ")" ::: "memory")
__device__ __forceinline__ void load_tile128(LAS bf16_t* dst, const bf16_t* __restrict__ src, size_t ld, int tid) {
#pragma unroll
    for (int i = 0; i < 4; ++i) { const int idx = tid + NTHR * i, r = idx >> 4, oc = idx & 15;
        *(LAS bf16x8*)(dst + r * TLD + oc * 8) = *(const bf16x8*)(src + (size_t)r * ld + oc * 8); }
}
__device__ __forceinline__ float wave_scan_add(float v, int lane) {
#pragma unroll
    for (int o = 1; o < 64; o <<= 1) { const float t = __shfl_up(v, o); if (lane >= o) v += t; }
    return v;
}
__device__ __forceinline__ float wave_scan_max(float v, int lane) {
#pragma unroll
    for (int o = 1; o < 64; o <<= 1) { const float t = __shfl_up(v, o); if (lane >= o) v = fmaxf(v, t); }
    return v;
}
__device__ __forceinline__ float wave_max(float v) {
#pragma unroll
    for (int o = 32; o >= 1; o >>= 1) v = fmaxf(v, __shfl_xor(v, o));
    return v;
}
__device__ __forceinline__ int chunk_at(int dir, int s) { return dir == 0 ? s : (s == 0 ? 1 : (s == 1 ? 0 : 131 - s)); }

constexpr int XLD = 68;
constexpr size_t WS_LH = WS_Z, WS_LA = WS_Z + (size_t)2 * T * 1024 * 2;
__device__ __forceinline__ float fast_sigmoid(float x) { return __builtin_amdgcn_rcpf(1.f + __expf(-x)); }
__device__ __forceinline__ float one_minus_sq(float la, float a) {
    const float x = 2.f * la;
    const float p = -x * (1.f + x * 0.5f * (1.f + x * (1.f / 3.f) * (1.f + x * 0.25f * (1.f + x * 0.2f))));
    return x < -0.25f ? 1.f - a * a : p;
}
#define LRU_F8(CTL) \
    "s_nop 4\n" \
    "v_fmac_f32_dpp %0, %0, %8 " CTL " row_mask:0xf bank_mask:0xf\n" "v_fmac_f32_dpp %1, %1, %9 " CTL " row_mask:0xf bank_mask:0xf\n" \
    "v_fmac_f32_dpp %2, %2, %10 " CTL " row_mask:0xf bank_mask:0xf\n" "v_fmac_f32_dpp %3, %3, %11 " CTL " row_mask:0xf bank_mask:0xf\n" \
    "v_fmac_f32_dpp %4, %4, %12 " CTL " row_mask:0xf bank_mask:0xf\n" "v_fmac_f32_dpp %5, %5, %13 " CTL " row_mask:0xf bank_mask:0xf\n" \
    "v_fmac_f32_dpp %6, %6, %14 " CTL " row_mask:0xf bank_mask:0xf\n" "v_fmac_f32_dpp %7, %7, %15 " CTL " row_mask:0xf bank_mask:0xf\n" \
    "v_mul_f32_dpp %8, %8, %8 " CTL " row_mask:0xf bank_mask:0xf\n" "v_mul_f32_dpp %9, %9, %9 " CTL " row_mask:0xf bank_mask:0xf\n" \
    "v_mul_f32_dpp %10, %10, %10 " CTL " row_mask:0xf bank_mask:0xf\n" "v_mul_f32_dpp %11, %11, %11 " CTL " row_mask:0xf bank_mask:0xf\n" \
    "v_mul_f32_dpp %12, %12, %12 " CTL " row_mask:0xf bank_mask:0xf\n" "v_mul_f32_dpp %13, %13, %13 " CTL " row_mask:0xf bank_mask:0xf\n" \
    "v_mul_f32_dpp %14, %14, %14 " CTL " row_mask:0xf bank_mask:0xf\n" "v_mul_f32_dpp %15, %15, %15 " CTL " row_mask:0xf bank_mask:0xf\n"
#define LRU_STEP8(CTL, A, B) asm volatile(LRU_F8(CTL) : "+v"(B[0]), "+v"(B[1]), "+v"(B[2]), "+v"(B[3]), "+v"(B[4]), "+v"(B[5]), "+v"(B[6]), "+v"(B[7]), \
                                                         "+v"(A[0]), "+v"(A[1]), "+v"(A[2]), "+v"(A[3]), "+v"(A[4]), "+v"(A[5]), "+v"(A[6]), "+v"(A[7]))
template <int DIR> __device__ __forceinline__ void lru_row_scan8(float (&A)[8], float (&B)[8]) {
    if (DIR == 0) { LRU_STEP8("row_shr:1", A, B); LRU_STEP8("row_shr:2", A, B); LRU_STEP8("row_shr:4", A, B); LRU_STEP8("row_shr:8", A, B); }
    else          { LRU_STEP8("row_shl:1", A, B); LRU_STEP8("row_shl:2", A, B); LRU_STEP8("row_shl:4", A, B); LRU_STEP8("row_shl:8", A, B); }
}
#define LRU_C8(CTL) \
    "s_nop 4\n" \
    "v_fmac_f32_dpp %0, %16, %8 " CTL " row_mask:0xf bank_mask:0xf\n" "v_fmac_f32_dpp %1, %17, %9 " CTL " row_mask:0xf bank_mask:0xf\n" \
    "v_fmac_f32_dpp %2, %18, %10 " CTL " row_mask:0xf bank_mask:0xf\n" "v_fmac_f32_dpp %3, %19, %11 " CTL " row_mask:0xf bank_mask:0xf\n" \
    "v_fmac_f32_dpp %4, %20, %12 " CTL " row_mask:0xf bank_mask:0xf\n" "v_fmac_f32_dpp %5, %21, %13 " CTL " row_mask:0xf bank_mask:0xf\n" \
    "v_fmac_f32_dpp %6, %22, %14 " CTL " row_mask:0xf bank_mask:0xf\n" "v_fmac_f32_dpp %7, %23, %15 " CTL " row_mask:0xf bank_mask:0xf\n" \
    "v_mul_f32_dpp %8, %24, %8 " CTL " row_mask:0xf bank_mask:0xf\n" "v_mul_f32_dpp %9, %25, %9 " CTL " row_mask:0xf bank_mask:0xf\n" \
    "v_mul_f32_dpp %10, %26, %10 " CTL " row_mask:0xf bank_mask:0xf\n" "v_mul_f32_dpp %11, %27, %11 " CTL " row_mask:0xf bank_mask:0xf\n" \
    "v_mul_f32_dpp %12, %28, %12 " CTL " row_mask:0xf bank_mask:0xf\n" "v_mul_f32_dpp %13, %29, %13 " CTL " row_mask:0xf bank_mask:0xf\n" \
    "v_mul_f32_dpp %14, %30, %14 " CTL " row_mask:0xf bank_mask:0xf\n" "v_mul_f32_dpp %15, %31, %15 " CTL " row_mask:0xf bank_mask:0xf\n"
#define LRU_CARRY8(CTL, As, Bs, Af, Bf) asm volatile(LRU_C8(CTL) : "+v"(Bs[0]), "+v"(Bs[1]), "+v"(Bs[2]), "+v"(Bs[3]), "+v"(Bs[4]), "+v"(Bs[5]), "+v"(Bs[6]), "+v"(Bs[7]), \
        "+v"(As[0]), "+v"(As[1]), "+v"(As[2]), "+v"(As[3]), "+v"(As[4]), "+v"(As[5]), "+v"(As[6]), "+v"(As[7]) \
        : "v"(Bf[0]), "v"(Bf[1]), "v"(Bf[2]), "v"(Bf[3]), "v"(Bf[4]), "v"(Bf[5]), "v"(Bf[6]), "v"(Bf[7]), "v"(Af[0]), "v"(Af[1]), "v"(Af[2]), "v"(Af[3]), "v"(Af[4]), "v"(Af[5]), "v"(Af[6]), "v"(Af[7]))
template <int DIR>
__device__ __forceinline__ void lru_dir(const Frame& F, int n, int blk, int hf, const LAS bf16_t* Ub, const LAS bf16_t* Wl, LAS float* seg, const LAS float* par, int wr, int wc, int li, int lq, int lane) {
    constexpr int dir = DIR;
    LAS float* segA = seg + dir * 512; LAS float* segH = segA + 256;
    const LAS bf16_t* Wa = Wl + (dir * 2 + 0) * 64 * TLD; const LAS bf16_t* Wx = Wl + (dir * 2 + 1) * 64 * TLD;
    f32x4 ar[2][2], ai[2][2];
#pragma unroll
    for (int m = 0; m < 2; ++m)
#pragma unroll
        for (int nn = 0; nn < 2; ++nn) { ar[m][nn] = (f32x4){0.f, 0.f, 0.f, 0.f}; ai[m][nn] = (f32x4){0.f, 0.f, 0.f, 0.f}; }
#pragma unroll
    for (int ks = 0; ks < 4; ++ks) {
        bf16x8 fu[2], fa[1][2], fx[1][2];
#pragma unroll
        for (int nn = 0; nn < 2; ++nn) { fa[0][nn] = frag_kc(Wa, TLD, 32 * wc + 16 * nn, 32 * ks, lane); fx[0][nn] = frag_kc(Wx, TLD, 32 * wc + 16 * nn, 32 * ks, lane); }
#pragma unroll
        for (int m = 0; m < 2; ++m) fu[m] = frag_kc(Ub, TLD, 32 * wr + 16 * m, 32 * ks, lane);
#pragma unroll
        for (int m = 0; m < 2; ++m)
#pragma unroll
            for (int nn = 0; nn < 2; ++nn) { ar[m][nn] = __builtin_amdgcn_mfma_f32_16x16x32_bf16(fa[0][nn], fu[m], ar[m][nn], 0, 0, 0);
                                             ai[m][nn] = __builtin_amdgcn_mfma_f32_16x16x32_bf16(fx[0][nn], fu[m], ai[m][nn], 0, 0, 0); }
    }
    float A[2][8], B[2][8];
#pragma unroll
    for (int m = 0; m < 2; ++m)
#pragma unroll
        for (int nn = 0; nn < 2; ++nn) { const int tt = 32 * wr + 16 * m + li, chb = 32 * wc + 16 * nn + 4 * lq;
            const u32x2 uu = *(const LAS u32x2*)(Ub + tt * TLD + hf * 64 + chb); const float u4[4] = {bflo(uu.x), bfhi(uu.x), bflo(uu.y), bfhi(uu.y)};
            const f32x4 pa = *(const LAS f32x4*)(par + 128 + dir * 64 + chb), px = *(const LAS f32x4*)(par + 256 + dir * 64 + chb), ps = *(const LAS f32x4*)(par + dir * 64 + chb);
#pragma unroll
            for (int e = 0; e < 4; e += 2) {
                const f32x2 xa = {ar[m][nn][e], ar[m][nn][e + 1]}, xi = {ai[m][nn][e], ai[m][nn][e + 1]};
                const f32x2 ta = xa * (-LOG2E) + (f32x2){pa[e], pa[e + 1]}, ti = xi * (-LOG2E) + (f32x2){px[e], px[e + 1]};
                const f32x2 da = (f32x2){__builtin_amdgcn_exp2f(ta[0]), __builtin_amdgcn_exp2f(ta[1])} + 1.f, di = (f32x2){__builtin_amdgcn_exp2f(ti[0]), __builtin_amdgcn_exp2f(ti[1])} + 1.f;
                const f32x2 r = {__builtin_amdgcn_rcpf(da[0]), __builtin_amdgcn_rcpf(da[1])}, ig = {__builtin_amdgcn_rcpf(di[0]), __builtin_amdgcn_rcpf(di[1])};
                const f32x2 l2 = r * (f32x2){ps[e], ps[e + 1]};
                const f32x2 a_ = {__builtin_amdgcn_exp2f(l2[0]), __builtin_amdgcn_exp2f(l2[1])};
                const f32x2 x = l2 * 1.3862943611198906f;
                f32x2 t = x * (1.f / 24.f) + (1.f / 6.f); t = x * t + 0.5f; t = x * t + 1.f;
                const f32x2 p = -x * t, d = 1.f - a_ * a_;
                const float o0 = x[0] < -0.0625f ? d[0] : p[0], o1 = x[1] < -0.0625f ? d[1] : p[1];
                const f32x2 sq = {__builtin_amdgcn_sqrtf(fmaxf(o0, 0.f)), __builtin_amdgcn_sqrtf(fmaxf(o1, 0.f))};
                const f32x2 b_ = sq * (ig * (f32x2){u4[e], u4[e + 1]});
                A[m][4 * nn + e] = a_[0]; A[m][4 * nn + e + 1] = a_[1]; B[m][4 * nn + e] = b_[0]; B[m][4 * nn + e + 1] = b_[1]; } }
    lru_row_scan8<DIR>(A[0], B[0]); lru_row_scan8<DIR>(A[1], B[1]);
    constexpr int mf = DIR ? 1 : 0, ms = 1 - mf, last = DIR ? 0 : 15;
    if (DIR == 0) LRU_CARRY8("row_newbcast:15", A[ms], B[ms], A[mf], B[mf]); else LRU_CARRY8("row_newbcast:0", A[ms], B[ms], A[mf], B[mf]);
    if (li == last) {
#pragma unroll
        for (int nn = 0; nn < 2; ++nn) { const int chb = 32 * wc + 16 * nn + 4 * lq;
            *(LAS f32x4*)(segA + wr * 64 + chb) = (f32x4){A[ms][4 * nn], A[ms][4 * nn + 1], A[ms][4 * nn + 2], A[ms][4 * nn + 3]};
            *(LAS f32x4*)(segH + wr * 64 + chb) = (f32x4){B[ms][4 * nn], B[ms][4 * nn + 1], B[ms][4 * nn + 2], B[ms][4 * nn + 3]}; } }
    __syncthreads();
    const int pos = DIR ? 3 - wr : wr;
    f32x4 c[2], Pp[2];
#pragma unroll
    for (int nn = 0; nn < 2; ++nn) { c[nn] = (f32x4){0.f, 0.f, 0.f, 0.f}; Pp[nn] = (f32x4){1.f, 1.f, 1.f, 1.f}; }
    for (int s2 = 0; s2 < pos; ++s2) { const int w2 = DIR ? 3 - s2 : s2;
#pragma unroll
        for (int nn = 0; nn < 2; ++nn) { const int chb = 32 * wc + 16 * nn + 4 * lq; const f32x4 a = *(const LAS f32x4*)(segA + w2 * 64 + chb), h = *(const LAS f32x4*)(segH + w2 * 64 + chb);
            c[nn] = a * c[nn] + h; Pp[nn] = Pp[nn] * a; } }
    const size_t r0 = (size_t)n * 128;
    if (pos == 3 && li == last) {
        float* LS = WSP(float, WS_LSUM) + (((size_t)n * 2 + dir) * 2) * 1024 + blk * 128 + hf * 64;
#pragma unroll
        for (int nn = 0; nn < 2; ++nn) { const int chb = 32 * wc + 16 * nn + 4 * lq; f32x4 ta, th;
#pragma unroll
            for (int e = 0; e < 4; ++e) { ta[e] = Pp[nn][e] * A[ms][4 * nn + e]; th[e] = A[ms][4 * nn + e] * c[nn][e] + B[ms][4 * nn + e]; }
            *(f32x4*)(LS + chb) = ta; *(f32x4*)(LS + 1024 + chb) = th; } }
#pragma unroll
    for (int m = 0; m < 2; ++m)
#pragma unroll
        for (int nn = 0; nn < 2; ++nn) { const int tt = 32 * wr + 16 * m + li, chb = 32 * wc + 16 * nn + 4 * lq;
            const size_t go = ((size_t)dir * T + r0 + tt) * 1024 + blk * 128 + hf * 64 + chb;
            u32x2 hw, aw;
            const float* Am = A[m] + 4 * nn; const float* Bm = B[m] + 4 * nn;
            hw.x = cvt_pk_bf16(Bm[0] + Am[0] * c[nn][0], Bm[1] + Am[1] * c[nn][1]); hw.y = cvt_pk_bf16(Bm[2] + Am[2] * c[nn][2], Bm[3] + Am[3] * c[nn][3]);
            aw.x = cvt_pk_bf16(Am[0] * Pp[nn][0], Am[1] * Pp[nn][1]); aw.y = cvt_pk_bf16(Am[2] * Pp[nn][2], Am[3] * Pp[nn][3]);
            *(u32x2*)(WSP(bf16_t, WS_LH) + go) = hw; *(u32x2*)(WSP(bf16_t, WS_LA) + go) = aw; }
}
struct LruIn { u32x4 v[7]; };
__device__ __forceinline__ void lru_in_issue(LruIn& X, const Frame& F, int item, int tid, bool live) {
    const int n = item >> 4, blk = (item >> 1) & 7, oc = tid & 15, tq = tid >> 4, c0 = blk * 128 + oc * 8;
    const int r0 = n * 128, seg_lo = (n < 2) ? 0 : CTX, seg_hi = (n < 2) ? CTX : T;
    const bf16_t* P = WSP(bf16_t, WS_P);
#pragma unroll
    for (int q = 0; q < 7; ++q) { const int r = r0 + tq * 4 - 2 + q;
        u32x4 v = {0u, 0u, 0u, 0u}; if (live && r >= seg_lo && r < seg_hi) v = *(const u32x4*)(P + (size_t)r * PW + S_LRU_U + c0); X.v[q] = v; }
}
__device__ __forceinline__ void lru_conv(const LruIn& X, LAS bf16_t* Ub, const LAS float* cw, int tid) {
    const int oc = tid & 15, tq = tid >> 4;
    float w[4][8], bb[8];
#pragma unroll
    for (int j = 0; j < 4; ++j) { const f32x4 a = *(const LAS f32x4*)(cw + j * 128 + oc * 8), b = *(const LAS f32x4*)(cw + j * 128 + oc * 8 + 4);
        w[j][0] = a[0]; w[j][1] = a[1]; w[j][2] = a[2]; w[j][3] = a[3]; w[j][4] = b[0]; w[j][5] = b[1]; w[j][6] = b[2]; w[j][7] = b[3]; }
    { const f32x4 a = *(const LAS f32x4*)(cw + 512 + oc * 8), b = *(const LAS f32x4*)(cw + 512 + oc * 8 + 4);
        bb[0] = a[0]; bb[1] = a[1]; bb[2] = a[2]; bb[3] = a[3]; bb[4] = b[0]; bb[5] = b[1]; bb[6] = b[2]; bb[7] = b[3]; }
    float xin[7][8];
#pragma unroll
    for (int q = 0; q < 7; ++q) { const u32x4 v = X.v[q];
        xin[q][0] = bflo(v.x); xin[q][1] = bfhi(v.x); xin[q][2] = bflo(v.y); xin[q][3] = bfhi(v.y); xin[q][4] = bflo(v.z); xin[q][5] = bfhi(v.z); xin[q][6] = bflo(v.w); xin[q][7] = bfhi(v.w); }
#pragma unroll
    for (int t4 = 0; t4 < 4; ++t4) { float o[8];
#pragma unroll
        for (int e = 0; e < 8; ++e) o[e] = bb[e] + w[0][e] * xin[t4][e] + w[1][e] * xin[t4 + 1][e] + w[2][e] * xin[t4 + 2][e] + w[3][e] * xin[t4 + 3][e];
        u32x4 pk; pk.x = cvt_pk_bf16(o[0], o[1]); pk.y = cvt_pk_bf16(o[2], o[3]); pk.z = cvt_pk_bf16(o[4], o[5]); pk.w = cvt_pk_bf16(o[6], o[7]);
        *(LAS u32x4*)(Ub + (tq * 4 + t4) * TLD + oc * 8) = pk; }
}
__device__ __forceinline__ void lru_loop(const Frame& F, int l, int it0) {
    if (it0 >= NCH * 16) return;
    const int blk = (it0 >> 1) & 7, hf = it0 & 1;
    LAS bf16_t* Ub0 = (LAS bf16_t*)(F.lds + LDS_RING);
    LAS bf16_t* Wl = Ub0 + 2 * 128 * TLD;
    LAS float* segA = (LAS float*)(Wl + 4 * 64 * TLD);
    LAS float* par = segA + 1024;
    LAS float* cw = par + 384;
    { const int tid = F.tid;
      if (tid < 128) { const int d = tid >> 6, ch = tid & 63, gc = blk * 128 + hf * 64 + ch;
          par[d * 64 + ch] = -8.f * LOG2E * softplusf_(-F.lam[(l * 2 + d) * 1024 + gc]);
          par[128 + d * 64 + ch] = -LOG2E * F.ba[(l * 2 + d) * 1024 + gc]; par[256 + d * 64 + ch] = -LOG2E * F.bx[(l * 2 + d) * 1024 + gc]; }
      if (tid >= 128 && tid < 128 + 160) { const int i = tid - 128, j = i >> 5, c4 = (i & 31) * 4;
          *(LAS f32x4*)(cw + j * 128 + c4) = (j < 4) ? *(const f32x4*)(F.conv_w + ((size_t)l * 4 + j) * 1024 + blk * 128 + c4) : *(const f32x4*)(F.conv_b + l * 1024 + blk * 128 + c4); }
#pragma unroll
      for (int i = 0; i < 8; ++i) { const int idx = tid + NTHR * i, mat = idx >> 10, row = (idx >> 4) & 63, oc = idx & 15;
          const bf16_t* W = WSP(bf16_t, WS_LRUW) + ((((size_t)l * 2 + (mat >> 1)) * 2 + (mat & 1)) * 8 + blk) * 16384;
          *(LAS bf16x8*)(Wl + (mat * 64 + row) * TLD + oc * 8) = *(const bf16x8*)(W + (hf * 64 + row) * 128 + oc * 8); } }
    __syncthreads();
    { LruIn X0; lru_in_issue(X0, F, it0, F.tid, true); lru_conv(X0, Ub0, cw, F.tid); }
    __syncthreads();
    int cur = 0;
#pragma unroll 1
    for (int item = it0; item < NCH * 16; item += F.G) {
        int tz_ = F.tid; asm volatile("" : "+v"(tz_));
        const int tid = tz_, lane = tz_ & 63, wave = F.wave, n = item >> 4;
        const bool has_next = item + F.G < NCH * 16;
        LruIn X; lru_in_issue(X, F, has_next ? item + F.G : item, tid, has_next);
        const int wr = wave >> 1, wc = wave & 1, li = lane & 15, lq = lane >> 4;
        const LAS bf16_t* Ub = Ub0 + cur * 128 * TLD;
        lru_dir<0>(F, n, blk, hf, Ub, Wl, segA, par, wr, wc, li, lq, lane);
        lru_dir<1>(F, n, blk, hf, Ub, Wl, segA, par, wr, wc, li, lq, lane);
        if (has_next) lru_conv(X, Ub0 + (cur ^ 1) * 128 * TLD, cw, tid);
        __syncthreads();
        cur ^= 1;
    }
}
struct LruOutIn { u32x4 hf_, af_, hb_, ab_, gt_; f32x4 cf0, cf1, cb0, cb1; int row, c0; };
__device__ __forceinline__ void lru_out_load(LruOutIn& I, const Frame& F, long i, int row_lo) {
    const bf16_t* P = WSP(bf16_t, WS_P); const bf16_t* LH = WSP(bf16_t, WS_LH); const bf16_t* LA = WSP(bf16_t, WS_LA); const float* LC = WSP(float, WS_LCAR);
    const int row = row_lo + (int)(i >> 7), c0 = (int)(i & 127) * 8, n = row >> 7; I.row = row; I.c0 = c0;
    I.hf_ = *(const u32x4*)(LH + (size_t)row * 1024 + c0); I.af_ = *(const u32x4*)(LA + (size_t)row * 1024 + c0);
    I.hb_ = *(const u32x4*)(LH + ((size_t)T + row) * 1024 + c0); I.ab_ = *(const u32x4*)(LA + ((size_t)T + row) * 1024 + c0);
    I.gt_ = *(const u32x4*)(P + (size_t)row * PW + S_LRU_G + c0);
    I.cf0 = *(const f32x4*)(LC + ((size_t)n * 2 + 0) * 1024 + c0); I.cf1 = *(const f32x4*)(LC + ((size_t)n * 2 + 0) * 1024 + c0 + 4);
    I.cb0 = *(const f32x4*)(LC + ((size_t)n * 2 + 1) * 1024 + c0); I.cb1 = *(const f32x4*)(LC + ((size_t)n * 2 + 1) * 1024 + c0 + 4);
}
__device__ __forceinline__ void lru_out_store(const LruOutIn& I, const Frame& F) {
    bf16_t* Y = WSP(bf16_t, WS_Y);
    const unsigned hw[4] = {I.hf_.x, I.hf_.y, I.hf_.z, I.hf_.w}, aw[4] = {I.af_.x, I.af_.y, I.af_.z, I.af_.w}, hbw[4] = {I.hb_.x, I.hb_.y, I.hb_.z, I.hb_.w}, abw[4] = {I.ab_.x, I.ab_.y, I.ab_.z, I.ab_.w}, gw[4] = {I.gt_.x, I.gt_.y, I.gt_.z, I.gt_.w};
    const float cf[8] = {I.cf0[0], I.cf0[1], I.cf0[2], I.cf0[3], I.cf1[0], I.cf1[1], I.cf1[2], I.cf1[3]}, cb[8] = {I.cb0[0], I.cb0[1], I.cb0[2], I.cb0[3], I.cb1[0], I.cb1[1], I.cb1[2], I.cb1[3]};
    unsigned ow[4];
#pragma unroll
    for (int e = 0; e < 4; ++e) {
        const float y0 = (bflo(hw[e]) + bflo(aw[e]) * cf[2 * e] + bflo(hbw[e]) + bflo(abw[e]) * cb[2 * e]) * siluf_(bflo(gw[e]));
        const float y1 = (bfhi(hw[e]) + bfhi(aw[e]) * cf[2 * e + 1] + bfhi(hbw[e]) + bfhi(abw[e]) * cb[2 * e + 1]) * siluf_(bfhi(gw[e]));
        ow[e] = cvt_pk_bf16(y0, y1); }
    u32x4 o; o.x = ow[0]; o.y = ow[1]; o.z = ow[2]; o.w = ow[3];
    *(u32x4*)(Y + (size_t)I.row * DM + I.c0) = o;
}
__device__ __forceinline__ void lru_out(const Frame& F, int row_lo, int blk0) {
    const long total = (long)(T - row_lo) * 128;
    if (F.bid < blk0) return;
    const long stride = (long)(F.G - blk0) * NTHR;
    long i = (long)(F.bid - blk0) * NTHR + F.tid;
#pragma unroll 1
    for (; i + stride < total; i += 2 * stride) { LruOutIn a, b; lru_out_load(a, F, i, row_lo); lru_out_load(b, F, i + stride, row_lo); lru_out_store(a, F); lru_out_store(b, F); }
    if (i < total) { LruOutIn a; lru_out_load(a, F, i, row_lo); lru_out_store(a, F); }
}
__device__ __forceinline__ void lru_carry(const Frame& F, int chain) {
    const int dir = chain >> 10, c = chain & 1023; const float* LS = WSP(float, WS_LSUM); float* LC = WSP(float, WS_LCAR);
    float h = 0.f;
#pragma unroll 1
    for (int s0 = 0; s0 < NCH; s0 += 26) {
        float A[26], hh[26];
#pragma unroll
        for (int j = 0; j < 26; ++j) { const int n = chunk_at(dir, s0 + j); const size_t b = (((size_t)n * 2 + dir) * 2) * 1024 + c; A[j] = LS[b]; hh[j] = LS[b + 1024]; }
#pragma unroll
        for (int j = 0; j < 26; ++j) { const int n = chunk_at(dir, s0 + j); LC[((size_t)n * 2 + dir) * 1024 + c] = h; h = A[j] * h + hh[j]; }
    }
}

struct MlStats { float cum0, cum1, u0, u1; };
__device__ __forceinline__ MlStats ml_cum(const LAS float* lf, const LAS float* ig, int dir, int lane) {
    MlStats s;
    if (dir == 0) { const float e0 = lf[2 * lane], e1 = lf[2 * lane + 1]; const float inc = wave_scan_add(e0 + e1, lane), pre = inc - (e0 + e1);
        s.cum0 = pre + e0; s.cum1 = inc; }
    else { const float e0 = lf[127 - 2 * lane], e1 = lf[126 - 2 * lane]; const float inc = wave_scan_add(e0 + e1, lane), pre = inc - (e0 + e1);
        s.cum0 = pre + e0; s.cum1 = inc; }
    const int t0 = dir == 0 ? 2 * lane : 127 - 2 * lane, t1 = dir == 0 ? 2 * lane + 1 : 126 - 2 * lane;
    s.u0 = ig[t0] - s.cum0; s.u1 = ig[t1] - s.cum1;
    return s;
}

struct ClPre { bf16x8 k[4], v[4]; float g[4]; };
__device__ __forceinline__ void cl_pre_issue(ClPre& R, const Frame& F, int item, int tid, bool live) {
    const int hd = item & 7, n = item >> 3;
    const __amdgpu_buffer_rsrc_t rp = mk_rsrc(WSP(bf16_t, WS_P) + (size_t)n * 128 * PW + hd * 128, live ? (size_t)128 * PW * 2 : 0);
    const unsigned vp = (unsigned)((tid >> 4) * PW + (tid & 15) * 8) * 2u;
#pragma unroll
    for (int i = 0; i < 4; ++i) { R.k[i] = buf_ld16(rp, vp, (unsigned)(i * 32 * PW + S_ML_K) * 2u); R.v[i] = buf_ld16(rp, vp, (unsigned)(i * 32 * PW + S_ML_V) * 2u); }
    if (tid < 128) { const float* g = WSP(float, WS_G) + ((size_t)n * 128 + tid) * 32; R.g[0] = g[8 + hd]; R.g[1] = g[hd]; R.g[2] = g[24 + hd]; R.g[3] = g[16 + hd]; }
}
__device__ __forceinline__ void cl_pre_commit(const ClPre& R, LAS bf16_t* Kt, LAS float* vec, int tid) {
    LAS bf16_t* Vt = Kt + 128 * TLD;
#pragma unroll
    for (int i = 0; i < 4; ++i) { const int idx = tid + NTHR * i, o = (idx >> 4) * TLD + (idx & 15) * 8; *(LAS bf16x8*)(Kt + o) = R.k[i]; *(LAS bf16x8*)(Vt + o) = R.v[i]; }
    if (tid < 128) { vec[tid] = log_sigmoidf_(R.g[0]); vec[128 + tid] = R.g[1]; vec[256 + tid] = log_sigmoidf_(R.g[2]); vec[384 + tid] = R.g[3]; }
}
__device__ __forceinline__ void ml_cloc_loop(const Frame& F, int it0) {
  if (it0 >= NCH * 8) return;
  LAS bf16_t* Kt = (LAS bf16_t*)(F.lds + LDS_RING); LAS bf16_t* Vt = Kt + 128 * TLD; LAS bf16_t* WK0 = Vt + 128 * TLD; LAS bf16_t* WK1 = WK0 + 128 * TLD;
  LAS float* vec = (LAS float*)(WK1 + 128 * TLD);
  { ClPre R0; cl_pre_issue(R0, F, it0, F.tid, true); cl_pre_commit(R0, Kt, vec, F.tid); }
  __syncthreads();
#pragma unroll 1
  for (int item = it0; item < NCH * 8; item += F.G) {
    int tz_ = F.tid; asm volatile("" : "+v"(tz_));
    const int hd = item & 7, n = item >> 3; const int tid = tz_, lane = tz_ & 63, wave = F.wave;
    const bool has_next = item + F.G < NCH * 8;
    ClPre R; cl_pre_issue(R, F, has_next ? item + F.G : item, tid, has_next);
    if (wave < 2) { const int dir = wave; const MlStats s = ml_cum(vec + dir * 256, vec + dir * 256 + 128, dir, lane);
        const float umax = wave_max(fmaxf(s.u0, s.u1));
        const int t0 = dir == 0 ? 2 * lane : 127 - 2 * lane, t1 = dir == 0 ? 2 * lane + 1 : 126 - 2 * lane;
        vec[512 + dir * 128 + t0] = __expf(s.u0 - umax); vec[512 + dir * 128 + t1] = __expf(s.u1 - umax);
        const float gtot = __shfl(s.cum1, 63);
        if (lane == 0) { float* gm = WSP(float, WS_GM) + ((size_t)n * 16 + dir * 8 + hd) * 2; gm[0] = gtot; gm[1] = gtot + umax; } }
    __syncthreads();
#pragma unroll
    for (int i = 0; i < 4; ++i) { const int idx = tid + NTHR * i, r = idx >> 4, oc = idx & 15; const u32x4 kv = *(const LAS u32x4*)(Kt + r * TLD + oc * 8);
        const float k0 = bflo(kv.x), k1 = bfhi(kv.x), k2 = bflo(kv.y), k3 = bfhi(kv.y), k4 = bflo(kv.z), k5 = bfhi(kv.z), k6 = bflo(kv.w), k7 = bfhi(kv.w);
#pragma unroll
        for (int dir = 0; dir < 2; ++dir) { const float w = vec[512 + dir * 128 + r]; u32x4 o; o.x = cvt_pk_bf16(w * k0, w * k1); o.y = cvt_pk_bf16(w * k2, w * k3); o.z = cvt_pk_bf16(w * k4, w * k5); o.w = cvt_pk_bf16(w * k6, w * k7);
            *(LAS u32x4*)((dir ? WK1 : WK0) + r * TLD + oc * 8) = o; } }
    { const int dir = tid >> 8, d = tid & 127, half = (tid >> 7) & 1; float s_ = 0.f;
#pragma unroll 8
        for (int q = 0; q < 64; ++q) s_ += vec[512 + dir * 128 + half * 64 + q] * bf2f(Kt[(half * 64 + q) * TLD + d]);
        vec[768 + tid] = s_; }
    __syncthreads();
    if (tid < 256) { const int dir = tid >> 7, d = tid & 127; WSP(float, WS_NLOC)[((size_t)n * 16 + dir * 8 + hd) * 128 + d] = vec[768 + dir * 256 + d] + vec[768 + dir * 256 + 128 + d]; }
    const int wr = wave >> 2, wc = wave & 3, li = lane & 15, lq = lane >> 4;
#pragma unroll 1
    for (int dir = 0; dir < 2; ++dir) {
        const LAS bf16_t* WK = dir ? WK1 : WK0;
        f32x4 acc[4][2];
#pragma unroll
        for (int m = 0; m < 4; ++m)
#pragma unroll
            for (int nn = 0; nn < 2; ++nn) acc[m][nn] = (f32x4){0.f, 0.f, 0.f, 0.f};
        TrFrag tk[2][4], tv[2][2];
#define CL_ISSUE(ks, st) do { _Pragma("unroll") for (int m = 0; m < 4; ++m) frag_tr_issue(tk[st][m], WK, TLD, 64 * wr + 16 * m, 32 * (ks), lane); \
            _Pragma("unroll") for (int nn = 0; nn < 2; ++nn) frag_tr_issue_p(tv[st][nn], Vt, TLD, 32 * wc, nn, 32 * (ks), lane); } while (0)
#define CL_MMA(st) do { SBAR(); _Pragma("unroll") for (int m = 0; m < 4; ++m) _Pragma("unroll") for (int nn = 0; nn < 2; ++nn) \
            acc[m][nn] = __builtin_amdgcn_mfma_f32_16x16x32_bf16(TRGET(tv[st][nn]), TRGET(tk[st][m]), acc[m][nn], 0, 0, 0); SBAR(); } while (0)
        CL_ISSUE(0, 0);
        CL_ISSUE(1, 1); LDS_WAIT(12); CL_MMA(0);
        CL_ISSUE(2, 0); LDS_WAIT(12); CL_MMA(1);
        CL_ISSUE(3, 1); LDS_WAIT(12); CL_MMA(0);
        LDS_WAIT(0); CL_MMA(1);
#undef CL_ISSUE
#undef CL_MMA
        bf16_t* CL = WSP(bf16_t, WS_CLOC) + ((size_t)n * 16 + dir * 8 + hd) * 16384;
#pragma unroll
        for (int m = 0; m < 4; ++m) *(u32x4*)(CL + (64 * wr + 16 * m + li) * 128 + 32 * wc + 8 * lq) = pack8(acc[m][0], acc[m][1]);
    }
    __syncthreads();
    if (has_next) cl_pre_commit(R, Kt, vec, tid);
    __syncthreads();
  }
}

constexpr int SCB = 13;
__device__ __forceinline__ void ml_scan(const Frame& F, int chain, int q, const LAS float* sg, const LAS float* sml) {
    const int dir = chain >> 3;
    const bf16_t* CL = WSP(bf16_t, WS_CLOC) + (size_t)chain * 16384 + q * 8; bf16_t* CI = WSP(bf16_t, WS_CIN) + (size_t)chain * 16384 + q * 8; float* MI = WSP(float, WS_MIN) + chain;
    f32x4 C0 = {0.f, 0.f, 0.f, 0.f}, C1 = {0.f, 0.f, 0.f, 0.f}; float m = 0.f;
    u32x4 ca[SCB], cb[SCB];
#define SC_LOAD(buf, s0) do { _Pragma("unroll") for (int j = 0; j < SCB; ++j) { const int n = chunk_at(dir, (s0) + j); buf[j] = *(const u32x4*)(CL + (size_t)n * (16 * 16384)); } } while (0)
#define SC_STEP(buf, s0) do { _Pragma("unroll") for (int j = 0; j < SCB; ++j) { const int s = (s0) + j, n = chunk_at(dir, s); const float g = sg[s], ml = sml[s]; \
        *(u32x4*)(CI + (size_t)n * (16 * 16384)) = pack8(C0, C1); if (q == 0) MI[n * 16] = m; \
        const float mnew = fmaxf(g + m, ml), a = __expf(g + m - mnew), e = __expf(ml - mnew); const u32x4 cl = buf[j]; \
        const f32x4 l0 = {bflo(cl.x), bfhi(cl.x), bflo(cl.y), bfhi(cl.y)}, l1 = {bflo(cl.z), bfhi(cl.z), bflo(cl.w), bfhi(cl.w)}; \
        C0 = C0 * a + l0 * e; C1 = C1 * a + l1 * e; m = mnew; } } while (0)
    SC_LOAD(ca, 0);
#pragma unroll 1
    for (int s0 = 0; s0 < NCH - 2 * SCB; s0 += 2 * SCB) { SC_LOAD(cb, s0 + SCB); SC_STEP(ca, s0); SC_LOAD(ca, s0 + 2 * SCB); SC_STEP(cb, s0 + SCB); }
    SC_LOAD(cb, NCH - SCB); SC_STEP(ca, NCH - 2 * SCB); SC_STEP(cb, NCH - SCB);
#undef SC_LOAD
#undef SC_STEP
}
__device__ __forceinline__ void ml_nscan(const Frame& F, int chain, int q4, const LAS float* sg, const LAS float* sml) {
    const int dir = chain >> 3;
    const float* NL = WSP(float, WS_NLOC) + (size_t)chain * 128 + q4 * 4; float* NI = WSP(float, WS_NIN) + (size_t)chain * 128 + q4 * 4;
    f32x4 nv = {0.f, 0.f, 0.f, 0.f}; float m = 0.f;
#pragma unroll 1
    for (int s0 = 0; s0 < NCH; s0 += SCB) {
        f32x4 nl[SCB];
#pragma unroll
        for (int j = 0; j < SCB; ++j) { const int n = chunk_at(dir, s0 + j); nl[j] = *(const f32x4*)(NL + (size_t)n * 2048); }
#pragma unroll
        for (int j = 0; j < SCB; ++j) { const int s = s0 + j, n = chunk_at(dir, s); const float g = sg[s], ml = sml[s];
            *(f32x4*)(NI + (size_t)n * 2048) = nv;
            const float mnew = fmaxf(g + m, ml), a = __expf(g + m - mnew), e = __expf(ml - mnew);
            nv = nv * a + nl[j] * e; m = mnew; }
    }
}

struct MlPre { bf16x8 q[4], k[4], v[4], c[4]; float g[4], nin, min_; };
__device__ __forceinline__ void ml_pre_issue(MlPre& R, const Frame& F, int item, int tid, int wave, bool live = true) {
    const int hd = item & 7, n = item >> 3;
    const bf16_t* P = WSP(bf16_t, WS_P);
    const __amdgpu_buffer_rsrc_t rp = mk_rsrc(P + (size_t)n * 128 * PW + hd * 128, live ? (size_t)128 * PW * 2 : 0), rc = mk_rsrc(WSP(bf16_t, WS_CIN) + ((size_t)n * 16 + hd) * 16384, live ? 32768 : 0);
    const unsigned vp = (unsigned)((tid >> 4) * PW + (tid & 15) * 8) * 2u;
#pragma unroll
    for (int i = 0; i < 4; ++i) { R.q[i] = buf_ld16(rp, vp, (unsigned)(i * 32 * PW + S_ML_Q) * 2u); R.k[i] = buf_ld16(rp, vp, (unsigned)(i * 32 * PW + S_ML_K) * 2u);
        R.v[i] = buf_ld16(rp, vp, (unsigned)(i * 32 * PW + S_ML_V) * 2u); R.c[i] = buf_ld16(rc, (unsigned)tid * 16u, (unsigned)i * 8192u); }
    if (tid < 128) { const float* g = WSP(float, WS_G) + ((size_t)n * 128 + tid) * 32; R.g[0] = g[8 + hd]; R.g[1] = g[hd]; R.g[2] = g[24 + hd]; R.g[3] = g[16 + hd]; }
    if (tid < 256) R.nin = WSP(float, WS_NIN)[((size_t)n * 16 + (tid >> 7) * 8 + hd) * 128 + (tid & 127)];
    if (wave < 2) R.min_ = WSP(float, WS_MIN)[(size_t)n * 16 + wave * 8 + hd];
}
__device__ __forceinline__ void ml_pre_commit(const MlPre& R, LAS bf16_t* Qt, LAS float* vec, int tid) {
    LAS bf16_t* KP = Qt + 128 * TLD; LAS bf16_t* Vt = KP + 128 * TLD; LAS bf16_t* Ct = Vt + 128 * TLD;
#pragma unroll
    for (int i = 0; i < 4; ++i) { const int idx = tid + NTHR * i, o = (idx >> 4) * TLD + (idx & 15) * 8;
        *(LAS bf16x8*)(Qt + o) = R.q[i]; *(LAS bf16x8*)(KP + o) = R.k[i]; *(LAS bf16x8*)(Vt + o) = R.v[i]; *(LAS bf16x8*)(Ct + o) = R.c[i]; }
    if (tid < 128) { vec[tid] = log_sigmoidf_(R.g[0]); vec[128 + tid] = R.g[1]; vec[256 + tid] = log_sigmoidf_(R.g[2]); vec[384 + tid] = R.g[3]; }
    if (tid < 256) vec[2688 + tid] = R.nin;
}
__device__ __forceinline__ void ml_out_loop(const Frame& F, int l, int it0) {
  if (it0 >= NCH * 8) return;
  LAS bf16_t* Qt = (LAS bf16_t*)(F.lds + LDS_RING); LAS bf16_t* KP = Qt + 128 * TLD; LAS bf16_t* Vt = KP + 128 * TLD; LAS bf16_t* Ct = Vt + 128 * TLD;
  LAS float* vec = (LAS float*)(Ct + 128 * TLD);
  float m_cur;
  { MlPre R0; ml_pre_issue(R0, F, it0, F.tid, F.wave); ml_pre_commit(R0, Qt, vec, F.tid); m_cur = R0.min_; }
  __syncthreads();
#pragma unroll 1
  for (int item = it0; item < NCH * 8; item += F.G) {
    int tz_ = F.tid; asm volatile("" : "+v"(tz_));
    const int hd = item & 7, n = item >> 3; const int tid = tz_, lane = tz_ & 63, wave = F.wave;
    const bf16_t* P = WSP(bf16_t, WS_P);
    const size_t r0 = (size_t)n * 128;
    bf16x8 c1r[4];
    if (wave < 2) { const int dir = wave; const MlStats s = ml_cum(vec + dir * 256, vec + dir * 256 + 128, dir, lane);
        const float m_in = m_cur;
        const float inc = wave_scan_max(fmaxf(s.u0, s.u1), lane); float pre = __shfl_up(inc, 1); if (lane == 0) pre = -3.0e38f;
        const float M0 = fmaxf(pre, s.u0), M1 = inc;
        const float mu0 = fmaxf(m_in, M0), mu1 = fmaxf(m_in, M1);
        const int t0 = dir == 0 ? 2 * lane : 127 - 2 * lane, t1 = dir == 0 ? 2 * lane + 1 : 126 - 2 * lane;
        LAS float* v = vec + 512 + dir * 512;
        v[t0] = s.u0; v[t1] = s.u1; v[128 + t0] = mu0; v[128 + t1] = mu1; v[256 + t0] = __expf(m_in - mu0); v[256 + t1] = __expf(m_in - mu1);
        v[384 + t0] = __expf(-(s.cum0 + mu0)); v[384 + t1] = __expf(-(s.cum1 + mu1)); }
    const int wr = wave >> 2, wc = wave & 3, li = lane & 15, lq = lane >> 4;
    f32x4 sacc[4][2];
#pragma unroll
    for (int m = 0; m < 4; ++m)
#pragma unroll
        for (int nn = 0; nn < 2; ++nn) sacc[m][nn] = (f32x4){0.f, 0.f, 0.f, 0.f};
#pragma unroll
    for (int ks = 0; ks < 4; ++ks) {
        bf16x8 fq_[4], fk_[2];
#pragma unroll
        for (int m = 0; m < 4; ++m) fq_[m] = frag_kc(Qt, TLD, 64 * wr + 16 * m, 32 * ks, lane);
#pragma unroll
        for (int nn = 0; nn < 2; ++nn) fk_[nn] = frag_kc(KP, TLD, 32 * wc + 16 * nn, 32 * ks, lane);
#pragma unroll
        for (int m = 0; m < 4; ++m)
#pragma unroll
            for (int nn = 0; nn < 2; ++nn) sacc[m][nn] = __builtin_amdgcn_mfma_f32_16x16x32_bf16(fk_[nn], fq_[m], sacc[m][nn], 0, 0, 0);
    }
    __syncthreads();
    f32x4 hs[4][2];
#pragma unroll
    for (int m = 0; m < 4; ++m)
#pragma unroll
        for (int nn = 0; nn < 2; ++nn) hs[m][nn] = (f32x4){0.f, 0.f, 0.f, 0.f};
#pragma unroll 1
    for (int dir = 0; dir < 2; ++dir) {
        const LAS float* v = vec + 512 + dir * 512; const size_t cc = (size_t)n * 16 + dir * 8 + hd;
        if (dir == 1) { const __amdgpu_buffer_rsrc_t rc = __builtin_amdgcn_make_buffer_rsrc((void*)(WSP(bf16_t, WS_CIN) + cc * 16384), (short)0, 32768, 0x00020000);
#pragma unroll
            for (int i = 0; i < 4; ++i) c1r[i] = buf_ld16(rc, (unsigned)tid * 16u, (unsigned)i * 8192u); }
#pragma unroll
        for (int m = 0; m < 4; ++m) { const int j = 64 * wr + 16 * m + li; const float muj = v[128 + j]; float ps = 0.f;
#pragma unroll
            for (int nn = 0; nn < 2; ++nn) { const int s0 = 32 * wc + 16 * nn + 4 * lq; float pv[4];
#pragma unroll
                for (int e = 0; e < 4; ++e) { const int s = s0 + e; const bool ok = dir == 0 ? (s <= j) : (s >= j);
                    pv[e] = ok ? __expf(v[s] - muj) * sacc[m][nn][e] : 0.f; ps += pv[e]; }
                u32x2 w; w.x = cvt_pk_bf16(pv[0], pv[1]); w.y = cvt_pk_bf16(pv[2], pv[3]); *(LAS u32x2*)(KP + j * TLD + s0) = w; }
            ps += __shfl_xor(ps, 16); ps += __shfl_xor(ps, 32);
            if (lq == 0) vec[1664 + j * 4 + wc] = ps; }
        if (dir == 1) {
#pragma unroll
            for (int i = 0; i < 4; ++i) { const int idx = tid + NTHR * i, r = idx >> 4, oc = idx & 15; *(LAS bf16x8*)(Ct + r * TLD + oc * 8) = c1r[i]; } }
        { const int j = tid >> 2, qd = tid & 3; float s_ = 0.f;
          const LAS f32x4* np = (const LAS f32x4*)(vec + 2688 + dir * 128 + qd * 32);
#pragma unroll
          for (int d4 = 0; d4 < 8; ++d4) { const f32x4 nv = np[d4]; const u32x2 qq = *(const LAS u32x2*)(Qt + j * TLD + qd * 32 + d4 * 4);
              s_ += bflo(qq.x) * nv[0] + bfhi(qq.x) * nv[1] + bflo(qq.y) * nv[2] + bfhi(qq.y) * nv[3]; }
          s_ += __shfl_xor(s_, 1); s_ += __shfl_xor(s_, 2);
          if (qd == 0) vec[1536 + j] = s_; }
        __syncthreads();
        f32x4 acc[4][2];
#pragma unroll
        for (int m = 0; m < 4; ++m)
#pragma unroll
            for (int nn = 0; nn < 2; ++nn) acc[m][nn] = (f32x4){0.f, 0.f, 0.f, 0.f};
        { TrFrag tc[2][2]; bf16x8 fq_[4];
#define OC_ISSUE(ks, st) do { _Pragma("unroll") for (int nn = 0; nn < 2; ++nn) frag_tr_issue_p(tc[st][nn], Ct, TLD, 32 * wc, nn, 32 * (ks), lane); } while (0)
#define OC_STEP(ks, st, NW_) do { _Pragma("unroll") for (int m = 0; m < 4; ++m) fq_[m] = frag_kc(Qt, TLD, 64 * wr + 16 * m, 32 * (ks), lane); \
            if ((ks) < 3) OC_ISSUE((ks) + 1, 1 - (st)); if ((ks) < 3) LDS_WAIT(4); else LDS_WAIT(0); SBAR(); \
            _Pragma("unroll") for (int m = 0; m < 4; ++m) _Pragma("unroll") for (int nn = 0; nn < 2; ++nn) \
                acc[m][nn] = __builtin_amdgcn_mfma_f32_16x16x32_bf16(TRGET(tc[st][nn]), fq_[m], acc[m][nn], 0, 0, 0); SBAR(); } while (0)
          OC_ISSUE(0, 0); OC_STEP(0, 0, 0); OC_STEP(1, 1, 0); OC_STEP(2, 0, 0); OC_STEP(3, 1, 0);
#undef OC_ISSUE
#undef OC_STEP
        }
#pragma unroll
        for (int m = 0; m < 4; ++m) { const float ej = v[256 + 64 * wr + 16 * m + li];
#pragma unroll
            for (int nn = 0; nn < 2; ++nn) acc[m][nn] *= ej; }
        { TrFrag tv[2][2]; bf16x8 fp_[4];
#define OV_ISSUE(ks, st) do { _Pragma("unroll") for (int nn = 0; nn < 2; ++nn) frag_tr_issue_p(tv[st][nn], Vt, TLD, 32 * wc, nn, 32 * (ks), lane); } while (0)
#define OV_STEP(ks, st) do { _Pragma("unroll") for (int m = 0; m < 4; ++m) fp_[m] = frag_kc(KP, TLD, 64 * wr + 16 * m, 32 * (ks), lane); \
            if ((ks) < 3) OV_ISSUE((ks) + 1, 1 - (st)); if ((ks) < 3) LDS_WAIT(4); else LDS_WAIT(0); SBAR(); \
            _Pragma("unroll") for (int m = 0; m < 4; ++m) _Pragma("unroll") for (int nn = 0; nn < 2; ++nn) \
                acc[m][nn] = __builtin_amdgcn_mfma_f32_16x16x32_bf16(TRGET(tv[st][nn]), fp_[m], acc[m][nn], 0, 0, 0); SBAR(); } while (0)
          OV_ISSUE(0, 0); OV_STEP(0, 0); OV_STEP(1, 1); OV_STEP(2, 0); OV_STEP(3, 1);
#undef OV_ISSUE
#undef OV_STEP
        }
#pragma unroll
        for (int m = 0; m < 4; ++m) { const int j = 64 * wr + 16 * m + li;
            const float den = v[256 + j] * vec[1536 + j] + (vec[1664 + j * 4] + vec[1664 + j * 4 + 1] + vec[1664 + j * 4 + 2] + vec[1664 + j * 4 + 3]);
            const float inv = __builtin_amdgcn_rcpf(fmaxf(fabsf(den), v[384 + j]));
#pragma unroll
            for (int nn = 0; nn < 2; ++nn) hs[m][nn] += acc[m][nn] * inv; }
        __syncthreads();
    }
    const bool has_next = item + F.G < NCH * 8;
    MlPre R;
    ml_pre_issue(R, F, has_next ? item + F.G : item, tid, wave, has_next);
#pragma unroll
    for (int m = 0; m < 4; ++m) { float ss = dot4(hs[m][0]) + dot4(hs[m][1]); ss += __shfl_xor(ss, 16); ss += __shfl_xor(ss, 32);
        if (lq == 0) vec[2176 + (64 * wr + 16 * m + li) * 4 + wc] = ss; }
    __syncthreads();
    bf16_t* Y = WSP(bf16_t, WS_Y);
#pragma unroll
    for (int m = 0; m < 4; ++m) { const int j = 64 * wr + 16 * m + li; const size_t row = r0 + j;
        const float rstd = rsqrtf((vec[2176 + j * 4] + vec[2176 + j * 4 + 1] + vec[2176 + j * 4 + 2] + vec[2176 + j * 4 + 3]) * (1.f / 128.f) + EPS);
        { const int e0 = 32 * wc + 8 * lq;
            const f32x4 hn0 = *(const f32x4*)(F.head_norm + l * 1024 + hd * 128 + e0), hn1 = *(const f32x4*)(F.head_norm + l * 1024 + hd * 128 + e0 + 4);
            const u32x4 ov = *(const u32x4*)(P + row * PW + S_ML_O + hd * 128 + e0), gv = *(const u32x4*)(P + row * PW + S_ML_G + hd * 128 + e0);
            const float ow[8] = {bflo(ov.x), bfhi(ov.x), bflo(ov.y), bfhi(ov.y), bflo(ov.z), bfhi(ov.z), bflo(ov.w), bfhi(ov.w)};
            const float gw[8] = {bflo(gv.x), bfhi(gv.x), bflo(gv.y), bfhi(gv.y), bflo(gv.z), bfhi(gv.z), bflo(gv.w), bfhi(gv.w)};
            f32x4 y0, y1;
#pragma unroll
            for (int e = 0; e < 4; ++e) {
                y0[e] = (hs[m][0][e] * rstd * hn0[e]) * (gw[e] * __builtin_amdgcn_rcpf((1.f + __expf(-ow[e])) * (1.f + __expf(-gw[e]))));
                y1[e] = (hs[m][1][e] * rstd * hn1[e]) * (gw[4 + e] * __builtin_amdgcn_rcpf((1.f + __expf(-ow[4 + e])) * (1.f + __expf(-gw[4 + e])))); }
            *(u32x4*)(Y + row * DM + 3072 + hd * 128 + e0) = pack8(y0, y1); }
        __builtin_amdgcn_sched_barrier(0); }
    if (has_next) { ml_pre_commit(R, Qt, vec, tid); m_cur = R.min_; }
    __syncthreads();
  }
}

template <int DQK, int LDROW>
__device__ __forceinline__ unsigned dma_src_off(int c, int lane, int kcol, int vcol, int rcol) {
    constexpr int KP_ = DQK * 2 + 16, KB_ = 64 * KP_;
    const int B = 1024 * c + 16 * lane;
    if (B < KB_) { const int row = B / KP_, cb = B - row * KP_;
        const int col = cb < 256 ? kcol * 2 + cb : ((DQK == 192 && cb < 384) ? rcol * 2 + (cb - 256) : kcol * 2);
        return (unsigned)(row * (LDROW * 2) + col); }
    const int Bv = B - KB_, sid = Bv >> 9, w16 = (Bv & 511) >> 4, kk = (sid >> 2) * 8 + (w16 >> 2);
    const int key = (kk & ~0xC) | ((kk & 4) << 1) | ((kk & 8) >> 1), col = (sid & 3) * 32 + (w16 & 3) * 8;
    return (unsigned)(key * (LDROW * 2) + (vcol + col) * 2);
}
template <int DQK, bool MASK, int LDROW, class TS, int ABL, bool ODD = false>
__device__ __forceinline__ void attn_dma(const bf16_t* __restrict__ Qrow, const bf16_t* __restrict__ base, int kcol, int vcol, int rcol, const TS ts, int NT, float m_init, float l_init, int qtok,
                                         const bf16_t* __restrict__ Gb, int ldg, bf16_t* __restrict__ Ob, int ldo, LAS unsigned char* ldsb, const int tid_, const int wave) {
    constexpr int KP_ = DQK * 2 + 16, ND = DQK / 16, DMA_KB = 64 * KP_, DMA_STAGE = DMA_KB + 16384, DMA_NCH = DMA_STAGE / 1024, NPW = (DMA_NCH + 7) / 8;
    static_assert(DMA_KB % 1024 == 0, "K region must be whole 1 KiB chunks");
    int tl = tid_; asm volatile("" : "+v"(tl));
    const int tid = tl, lane = tid & 63, r32 = lane & 31, hi = lane >> 5;
    float m_reg = m_init, l_reg = l_init; f32x16 o[4] = {}; bf16x8 qr[ND];
    f32x16 negm;
#pragma unroll
    for (int r = 0; r < 16; ++r) negm[r] = -m_init;
    const bf16_t* Qw = Qrow + hi * 8;
#pragma unroll
    for (int d0 = 0; d0 < ND; ++d0) qr[d0] = *reinterpret_cast<const bf16x8*>(Qw + d0 * 16);
    const __amdgpu_buffer_rsrc_t rs = __builtin_amdgcn_make_buffer_rsrc((void*)base, (short)0, (int)((size_t)T * LDROW * 2), 0x00020000);
    unsigned vsrc[NPW];
#pragma unroll
    for (int i = 0; i < NPW; ++i) { const int c = wave + 8 * i; vsrc[i] = dma_src_off<DQK, LDROW>(c < DMA_NCH ? c : wave, lane, kcol, vcol, rcol); }
    const int krow0 = (int)(uintptr_t)ldsb + r32 * KP_ + hi * 16, vb00 = (int)(uintptr_t)ldsb + DMA_KB + v_rd_base(lane);
#define DMA_TILE(j, stg) do { if (ABL != 2) { const unsigned so_ = (unsigned)ts.row(j) * (unsigned)(LDROW * 2); _Pragma("unroll") for (int i = 0; i < NPW - 1; ++i) \
        __builtin_amdgcn_raw_ptr_buffer_load_lds(rs, (LAS void*)(ldsb + (stg) + 1024 * (wave + 8 * i)), 16, (int)vsrc[i], (int)so_, 0, 0); \
        if (wave + 8 * (NPW - 1) < DMA_NCH) __builtin_amdgcn_raw_ptr_buffer_load_lds(rs, (LAS void*)(ldsb + (stg) + 1024 * (wave + 8 * (NPW - 1))), 16, (int)vsrc[NPW - 1], (int)so_, 0, 0); } } while (0)
#define DMA_WAIT_BAR() do { asm volatile("s_waitcnt vmcnt(0)" ::: "memory"); __builtin_amdgcn_s_barrier(); asm volatile("" ::: "memory"); } while (0)
#define RESC(a) do { if (__any((a) < 1.f)) { const float a_ = (a); _Pragma("unroll") for (int d = 0; d < 4; ++d) _Pragma("unroll") for (int r = 0; r < 16; ++r) o[d][r] *= a_; \
    { const float nm_ = -m_reg; _Pragma("unroll") for (int r = 0; r < 16; ++r) negm[r] = nm_; } } } while (0)
#define KRD(d0, KB_, B0, B1) do { const int ad_ = (KB_) + (d0) * 32; B0 = *(const LAS bf16x8*)(ad_); B1 = *(const LAS bf16x8*)(ad_ + 32 * KP_); } while (0)
#define QKT(P0, P1, KB_) do { \
    bf16x8 kf0[3], kf1[3]; KRD(0, KB_, kf0[0], kf1[0]); KRD(1, KB_, kf0[1], kf1[1]); \
    _Pragma("unroll") for (int d0 = 0; d0 < ND; ++d0) { \
        if (d0 + 2 < ND) KRD(d0 + 2, KB_, kf0[(d0 + 2) % 3], kf1[(d0 + 2) % 3]); \
        if (d0 == 0) { P0 = __builtin_amdgcn_mfma_f32_32x32x16_bf16(kf0[0], qr[0], negm, 0, 0, 0); P1 = __builtin_amdgcn_mfma_f32_32x32x16_bf16(kf1[0], qr[0], negm, 0, 0, 0); }     \
        else { P0 = __builtin_amdgcn_mfma_f32_32x32x16_bf16(kf0[d0 % 3], qr[d0], P0, 0, 0, 0); P1 = __builtin_amdgcn_mfma_f32_32x32x16_bf16(kf1[d0 % 3], qr[d0], P1, 0, 0, 0); } } \
    __builtin_amdgcn_sched_group_barrier(0x100, 4, 0); sg_rmv<ND - 2>(); sg_mv<2>(); } while (0)
#define AMASK(P0, P1, j) do { if (MASK && ts.masked(j)) { const int kt0 = ts.tok(j); _Pragma("unroll") for (int r = 0; r < 16; ++r) { \
    const int k0_ = kt0 + crow(r, hi), k1_ = k0_ + 32; const int d0_ = qtok - k0_, d1_ = qtok - k1_; \
    if (d0_ > 128 || d0_ < -128 || k0_ < 0 || k0_ >= SEQ) P0[r] = -1e30f; if (d1_ > 128 || d1_ < -128 || k1_ < 0 || k1_ >= SEQ) P1[r] = -1e30f; } } } while (0)
    f32x16 pA0, pA1, pB0, pB1; float alA, alB; bf16x8 pa0, pa1, pa2, pa3;
    int s_prev = 0, s_cur = DMA_STAGE, s_next = 2 * DMA_STAGE;
    DMA_TILE(0, 0); DMA_TILE(1, DMA_STAGE); DMA_WAIT_BAR();
    QKT(pA0, pA1, krow0); AMASK(pA0, pA1, 0); partialSM<ABL>(pA0, pA1, m_reg, alA);
    RESC(alA);
    for (int j = 1; j + 1 < NT; j += 2) {
        DMA_TILE(j + 1, s_next);
        SBAR(); QKT(pB0, pB1, krow0 + s_cur); AMASK(pB0, pB1, j);
        finishSM<ABL>(pA0, pA1, alA, l_reg, pa0, pa1, pa2, pa3); SBAR();
        pv_d0(o, vb00 + s_prev, pa0, pa1, pa2, pa3); partialSM<ABL>(pB0, pB1, m_reg, alB);
        RESC(alB); DMA_WAIT_BAR();
        { const int t_ = s_prev; s_prev = s_cur; s_cur = s_next; s_next = t_; }
        if (j + 2 < NT) DMA_TILE(j + 2, s_next);
        SBAR(); QKT(pA0, pA1, krow0 + s_cur); AMASK(pA0, pA1, j + 1);
        finishSM<ABL>(pB0, pB1, alB, l_reg, pa0, pa1, pa2, pa3); SBAR();
        pv_d0(o, vb00 + s_prev, pa0, pa1, pa2, pa3); partialSM<ABL>(pA0, pA1, m_reg, alA);
        RESC(alA); DMA_WAIT_BAR();
        { const int t_ = s_prev; s_prev = s_cur; s_cur = s_next; s_next = t_; }
    }
    if (!ODD) {
        SBAR(); QKT(pB0, pB1, krow0 + s_cur); AMASK(pB0, pB1, NT - 1);
        finishSM<ABL>(pA0, pA1, alA, l_reg, pa0, pa1, pa2, pa3); SBAR();
        pv_d0(o, vb00 + s_prev, pa0, pa1, pa2, pa3); partialSM<ABL>(pB0, pB1, m_reg, alB);
        RESC(alB);
        finishSM<ABL>(pB0, pB1, alB, l_reg, pa0, pa1, pa2, pa3); SBAR();
        pv_d0(o, vb00 + s_cur, pa0, pa1, pa2, pa3);
    } else {
        finishSM<ABL>(pA0, pA1, alA, l_reg, pa0, pa1, pa2, pa3); SBAR();
        pv_d0(o, vb00 + s_prev, pa0, pa1, pa2, pa3);
    }
    { const float rl = __builtin_amdgcn_rcpf(l_reg);
      int lz = lane; asm volatile("" : "+v"(lz));
      const int qz = lz & 31, hz = lz >> 5;
      const bf16_t* grow = Gb + (size_t)qz * ldg + 4 * hz; bf16_t* orow = Ob + (size_t)qz * ldo + 8 * hz;
      u32x2 gav[8], gbv[8];
      if (DQK == 128) {
#pragma unroll
          for (int kk = 0; kk < 8; ++kk) { gav[kk] = *(const u32x2*)(grow + 16 * kk); gbv[kk] = *(const u32x2*)(grow + 16 * kk + 8); } }
#pragma unroll
      for (int d0 = 0; d0 < 4; ++d0)
#pragma unroll
          for (int gp = 0; gp < 2; ++gp) {
              const int k = 4 * d0 + 2 * gp;
              u32x2 ga, gb;
              if (DQK == 128) { ga = gav[2 * d0 + gp]; gb = gbv[2 * d0 + gp]; } else { ga = *(const u32x2*)(grow + 8 * k); gb = *(const u32x2*)(grow + 8 * k + 8); }
              const f32x16& od = o[d0];
              const float a0 = od[8 * gp + 0] * rl * siluf_(bflo(ga.x)), a1 = od[8 * gp + 1] * rl * siluf_(bfhi(ga.x)), a2 = od[8 * gp + 2] * rl * siluf_(bflo(ga.y)), a3 = od[8 * gp + 3] * rl * siluf_(bfhi(ga.y));
              const float b0 = od[8 * gp + 4] * rl * siluf_(bflo(gb.x)), b1 = od[8 * gp + 5] * rl * siluf_(bfhi(gb.x)), b2 = od[8 * gp + 6] * rl * siluf_(bflo(gb.y)), b3 = od[8 * gp + 7] * rl * siluf_(bfhi(gb.y));
              const unsigned ax = cvt_pk_bf16(a0, a1), ay = cvt_pk_bf16(a2, a3), bx = cvt_pk_bf16(b0, b1), by = cvt_pk_bf16(b2, b3);
              auto rx = __builtin_amdgcn_permlane32_swap(ax, bx, false, false); auto ry = __builtin_amdgcn_permlane32_swap(ay, by, false, false);
              u32x4 w; w.x = rx[0]; w.y = ry[0]; w.z = rx[1]; w.w = ry[1];
              *(u32x4*)(orow + 8 * k) = w; } }
    __builtin_amdgcn_s_barrier();
#undef DMA_TILE
#undef DMA_WAIT_BAR
#undef RESC
#undef KRD
#undef QKT
#undef AMASK
}

constexpr float SCALE_SWA = 0.08838834764831845f, SCALE_MLA = 0.07216878364870322f;
__device__ __forceinline__ void swa_unit(const Frame& F, int l, int unit) {
    const bf16_t* P = WSP(bf16_t, WS_P); bf16_t* Y = WSP(bf16_t, WS_Y);
    const bf16_t* Pq = P; asm volatile("" : "+s"(Pq), "+s"(Y));
    int lz = F.lane; asm volatile("" : "+v"(lz));
    const int r32 = lz & 31;
    const bool is_ctx = unit >= 512; const int u2 = is_ctx ? unit - 512 : unit, g2 = u2 & 1, qc = u2 >> 1;
    const int hq = 4 * g2 + (F.wave >> 1), rloc = 32 * (F.wave & 1);
    const int row0 = (is_ctx ? 0 : CTX) + qc * 64 + rloc;
    const bf16_t* Qrow = Pq + (size_t)(row0 + r32) * PW + S_SWA_Q + hq * 128;
    const bf16_t* Gb = Pq + (size_t)row0 * PW + S_SWA_G + hq * 128; bf16_t* Ob = Y + (size_t)row0 * DM + 1024 + hq * 128;
    const float m_init = F.sink[l * 8 + hq] * LOG2E;
    if (!is_ctx) { TsSwa ts; ts.tb = qc * 64 - 128;
        attn_dma<128, true, PW, TsSwa, 0, true>(Qrow, P, S_SWA_K + g2 * 128, S_SWA_V + g2 * 128, 0, ts, 9, m_init, 1.f, qc * 64 + rloc + r32, Gb, PW, Ob, DM, F.lds + LDS_RING, F.tid, F.wave); }
    else { TsDense ts;
        attn_dma<128, false, PW, TsDense, 0>(Qrow, P, S_SWA_K + g2 * 128, S_SWA_V + g2 * 128, 0, ts, 4, m_init, 1.f, 0, Gb, PW, Ob, DM, F.lds + LDS_RING, F.tid, F.wave); }
}
template <int ABL = 0>
__device__ __forceinline__ void mla_unit(const Frame& F, int unit) {
    const bf16_t* P = WSP(bf16_t, WS_P); bf16_t* Y = WSP(bf16_t, WS_Y); const bf16_t* QM = WSP(bf16_t, WS_QM); const bf16_t* KV = WSP(bf16_t, WS_KV);
    asm volatile("" : "+s"(P), "+s"(Y), "+s"(QM));
    int lz = F.lane; asm volatile("" : "+v"(lz));
    const int r32 = lz & 31;
    const bool is_ctx = unit >= 512; const int h = unit & 7, qb = is_ctx ? 0 : (unit >> 3);
    const int row0 = (is_ctx ? 0 : CTX + qb * 256) + 32 * F.wave;
    const bf16_t* Qrow = QM + (size_t)(row0 + r32) * 1536 + h * 192;
    const bf16_t* Gb = P + (size_t)row0 * PW + S_MLA_G + h * 128; bf16_t* Ob = (ABL ? WSP(bf16_t, WS_H) : Y) + (size_t)row0 * DM + 2048 + h * 128;
    attn_dma<192, false, LDKV, TsDense, ABL>(Qrow, KV, h * 256, h * 256 + 128, 2048, TsDense(), is_ctx ? 4 : T / 64, 0.f, 0.f, 0, Gb, PW, Ob, DM, F.lds + LDS_RING, F.tid, F.wave);
}

#ifndef PHMASK
#define PHMASK 0xFFFF
#endif
#define EN(b) ((PHMASK >> (b)) & 1)
#define IN(k) ph_in(lds, (k))
#define SEAM(k) do { if (IN(k) && IN((k) + 1)) grid_barrier(lds); } while (0)

template <int l>
__device__ __forceinline__ void layer_phases(LAS unsigned char* lds, const int wave0) {
        const int pb = 1 + 7 * l;
        const bool need_ctx = (l == 0);
        if (EN(1) && IN(pb + 0)) REP(1) {
            const Frame F = load_frame(lds, wave0);
            if (l == 0) norm_phase(F, 0, 0, T, 0, F.G);
            else {
                if (F.bid < 16) {
                    pg8::Gemm g{WSP(bf16_t, WS_Y), WSP(bf16_t, WS_WOUT) + (size_t)(l - 1) * DM * DM, CTX, DM, DM, DM, DM};
                    pg8::StaticOrder S; S.init(CTX, DM, 16, F.bid);
                    EpiOut E{WSP(bf16_t, WS_Z), WSP(float, WS_ST2), 0};
                    pg8::gemm_phase<EpiOut>(F.lds + LDS_RING, g, S, E, F.tid);
                }
                { const Frame F2 = load_frame(lds, wave0); norm_phase(F2, l, CTX, T, 16, F2.G - 16); }
            }
        }
        if (l > 0) SEAM(pb + 0);
        if (l > 0 && EN(1) && IN(pb + 1)) { const Frame F = load_frame(lds, wave0); norm_phase(F, l, 0, CTX, 0, F.G); }
        SEAM(pb + 1);
        if (EN(2) && IN(pb + 2)) REP(2) {
            const Frame F = load_frame(lds, wave0);
            pg8::Gemm g{WSP(bf16_t, WS_H), WSP(bf16_t, WS_WIN) + (size_t)l * NPAD * DM, T, NPAD, DM, DM, DM};
            pg8::StaticOrder S; S.init(T, NPAD, F.G, F.bid);
            LAS float* lt32 = (LAS float*)(F.lds + LDS_RING + pg8::STAGE_BYTES);
#pragma unroll
            for (int i = 0; i < 2; ++i) *(LAS f32x4*)(lt32 + 4 * (F.tid + NTHR * i)) = *(const f32x4*)(WSP(float, WS_TAB32) + 4 * (F.tid + NTHR * i));
            __syncthreads();
            EpiIn E{WSP(bf16_t, WS_P), WSP(bf16_t, WS_KV), WSP(float, WS_G), WSP(float, WS_ST1), WSP(float, WS_TAB16), WSP(float, WS_TAB32), F.gate_b + l * 32, lt32};
            pg8::gemm_phase<EpiIn>(F.lds + LDS_RING, g, S, E, F.tid);
        }
        SEAM(pb + 2);
        if (IN(pb + 3)) {
            if (EN(3)) REP(3) { const Frame F = load_frame(lds, wave0); pg8::Gemm g{WSP(bf16_t, WS_P) + S_CQ, WSP(bf16_t, WS_WUQ) + (size_t)l * 1536 * 768, T, 1536, 768, PW, 768};
              pg8::StaticOrder S; S.init(T, 1536, F.G, F.bid);
              LAS float* lt16 = (LAS float*)(F.lds + LDS_RING + pg8::STAGE_BYTES);
              *(LAS f32x4*)(lt16 + 4 * F.tid) = *(const f32x4*)(WSP(float, WS_TAB16) + 4 * F.tid);
              __syncthreads();
              EpiUq E{WSP(bf16_t, WS_QM), WSP(float, WS_ST1), WSP(float, WS_TAB16), lt16};
              pg8::gemm_phase<EpiUq>(F.lds + LDS_RING, g, S, E, F.tid); }
            if (EN(4)) REP(4) { const Frame F = load_frame(lds, wave0); pg8::Gemm g{WSP(bf16_t, WS_P) + S_CKV, WSP(bf16_t, WS_WUKV) + (size_t)l * 2048 * 256, T, 2048, 256, PW, 256};
              pg8::StaticOrder S; S.init(T, 2048, F.G, (F.bid + F.G - 136) % F.G);
              EpiUkv E{WSP(bf16_t, WS_KV), WSP(float, WS_ST1)};
              pg8::gemm_phase<EpiUkv>(F.lds + LDS_RING, g, S, E, F.tid); }
            const int nswa = 512 + (need_ctx ? 8 : 0);
            if (EN(5)) REP(5) { const Frame F = load_frame(lds, wave0); for (int u = (F.bid + F.G - 144) % F.G; u < nswa; u += F.G) swa_unit(F, l, u); }
            if (EN(6)) REP(6) { const Frame F = load_frame(lds, wave0); ml_cloc_loop(F, (F.bid + F.G - 152) % F.G); }
            if (EN(7)) REP(7) { const Frame F = load_frame(lds, wave0); lru_loop(F, l, (F.bid + F.G - 168) % F.G); }
        }
        SEAM(pb + 3);
        if (IN(pb + 4)) {
            if (EN(8)) REP(8) { const Frame F = load_frame(lds, wave0);
                LAS float* sg = (LAS float*)(F.lds + LDS_RING); LAS float* sml = sg + 192;
                const int chain = F.bid >> 4;
                if (F.tid < NCH) { const int n = chunk_at(chain >> 3, F.tid); const float* gm = WSP(float, WS_GM) + ((size_t)n * 16 + chain) * 2; sg[F.tid] = gm[0]; sml[F.tid] = gm[1]; }
                __syncthreads();
                if (F.tid < 128) ml_scan(F, chain, (F.bid & 15) * 128 + F.tid, sg, sml);
                else if (F.tid < 160 && (F.bid & 15) == 0) ml_nscan(F, chain, F.tid - 128, sg, sml);
                else if (F.tid >= 256 && F.bid < 8) lru_carry(F, F.bid * 256 + (F.tid - 256));
                __syncthreads(); }
            const int nmla = 512 + (need_ctx ? 8 : 0);
            if (EN(9)) { const Frame F = load_frame(lds, wave0); for (int u = F.bid; u < nmla; u += F.G) mla_unit<0>(F, u); }
            if (EN(9) && ((REPMASK >> 9) & 1)) { const Frame F = load_frame(lds, wave0); for (int u = F.bid; u < nmla; u += F.G) mla_unit<ABL_KIND>(F, u); }
        }
        SEAM(pb + 4);
        if (IN(pb + 5)) {
            const int n0 = need_ctx ? 0 : 2;
            if (EN(10)) REP(10) { const Frame F = load_frame(lds, wave0); lru_out(F, n0 * 128, need_ctx ? 16 : 0); }
            if (EN(11)) REP(11) { const Frame F = load_frame(lds, wave0); ml_out_loop(F, l, n0 * 8 + F.bid); }
        }
        SEAM(pb + 5);
        if (EN(12) && IN(pb + 6)) REP(12) {
            const Frame F = load_frame(lds, wave0);
            pg8::Gemm g{WSP(bf16_t, WS_Y) + (size_t)CTX * DM, WSP(bf16_t, WS_WOUT) + (size_t)l * DM * DM, SEQ, DM, DM, DM, DM};
            pg8::StaticOrder S; S.init(SEQ, DM, F.G, F.bid);
            EpiOut E{WSP(bf16_t, WS_Z), WSP(float, WS_ST2), CTX};
            pg8::gemm_phase<EpiOut>(F.lds + LDS_RING, g, S, E, F.tid);
        }
        SEAM(pb + 6);
}

constexpr int N_PHASES = 16;
__global__ void __launch_bounds__(NTHR, 2) hybrid_fwd(Args args) {
    extern __shared__ __attribute__((aligned(16))) unsigned char lds_raw[];
    LAS unsigned char* const lds = (LAS unsigned char*)lds_raw;
    const int wave0 = __builtin_amdgcn_readfirstlane((int)threadIdx.x >> 6);
    if (threadIdx.x < 16) ((LAS unsigned*)(lds + LDS_MISC))[threadIdx.x] = 0u;
    if (threadIdx.x < 26) { const unsigned long long p = threadIdx.x < 24 ? (unsigned long long)args.in[threadIdx.x] : (threadIdx.x == 24 ? (unsigned long long)args.out : (unsigned long long)args.ws);
        ((LAS unsigned*)(lds + LDS_PTRS))[2 * threadIdx.x] = (unsigned)p; ((LAS unsigned*)(lds + LDS_PTRS))[2 * threadIdx.x + 1] = (unsigned)(p >> 32); }
    if (threadIdx.x == 0) { ((LAS int*)(lds + LDS_MISC))[8] = args.ph_lo; ((LAS int*)(lds + LDS_MISC))[9] = args.ph_hi; }
    __syncthreads();
    const int lo = args.ph_lo, hi = args.ph_hi;
    if (hi - lo > 1) (void)xcd_barrier_post((unsigned*)(args.ws + WS_CTL), (volatile LAS unsigned*)(lds + LDS_MISC));

    if (EN(0) && IN(0)) REP(0) { const Frame F = load_frame(lds, wave0); p0_prologue(F); }
    SEAM(0);
    layer_phases<0>(lds, wave0);
    layer_phases<1>(lds, wave0);
    if (EN(13) && IN(15)) { const Frame F = load_frame(lds, wave0); norm_phase(F, 2, CTX, T, 0, F.G); }
#undef IN
#undef SEAM
}

#ifndef N_LAUNCHES
#define N_LAUNCHES 1
#endif
extern "C" void kernel_launch(void* const* d_in, const int* in_sizes, int n_in, void* d_out, int out_size, void* d_ws, size_t ws_size, hipStream_t stream) {
    static int grid = 0;
    if (grid == 0) {
        if (n_in != 24 || in_sizes[0] != SEQ * DM || out_size != SEQ * DM || ws_size < WS_END) {
            fprintf(stderr, "kernel_launch: unexpected shapes (n_in %d, in0 %d, out %d, ws %zu, need %zu); nothing launched\n", n_in, n_in > 0 ? in_sizes[0] : -1, out_size, ws_size, (size_t)WS_END); grid = -1; return; }
        int dev = 0, cus = 0;
        if (hipGetDevice(&dev) != hipSuccess || hipDeviceGetAttribute(&cus, hipDeviceAttributeMultiprocessorCount, dev) != hipSuccess) { grid = -1; return; }
        if (hipFuncSetAttribute((const void*)hybrid_fwd, hipFuncAttributeMaxDynamicSharedMemorySize, LDS_BYTES) != hipSuccess) { fprintf(stderr, "kernel_launch: hipFuncSetAttribute failed\n"); grid = -1; return; }
        int per_cu = 0;
        if (hipOccupancyMaxActiveBlocksPerMultiprocessor(&per_cu, (const void*)hybrid_fwd, NTHR, LDS_BYTES) != hipSuccess || per_cu < 1) { fprintf(stderr, "kernel_launch: occupancy query says %d\n", per_cu); }
        (void)hipGetLastError();
        grid = cus;
    }
    if (grid < 0) return;
    (void)hipMemsetAsync((char*)d_ws + WS_CTL, 0, CTL_BYTES + (size_t)2 * 2 * 12288 * 4, stream);
    Args a{};
    for (int i = 0; i < 24; ++i) a.in[i] = (const float*)d_in[i];
    a.out = (float*)d_out; a.ws = (unsigned char*)d_ws;
#ifndef MAX_PHASE
#define MAX_PHASE N_PHASES
#endif
    for (int li = 0; li < N_LAUNCHES && li < MAX_PHASE; ++li) {
        a.ph_lo = (N_LAUNCHES == 1) ? 0 : li; a.ph_hi = (N_LAUNCHES == 1) ? MAX_PHASE : li + 1;
        hipLaunchKernelGGL(hybrid_fwd, dim3(grid), dim3(NTHR), LDS_BYTES, stream, a);
    }
}
```

```cpp
#include <hip/hip_runtime.h>
#include <cstdio>
#include <cstdint>
#include <cmath>

#define LAS __attribute__((address_space(3)))
typedef unsigned short bf16_t;
typedef short bf16x8 __attribute__((ext_vector_type(8)));
typedef short s16x4 __attribute__((ext_vector_type(4)));
typedef float f32x2 __attribute__((ext_vector_type(2)));
typedef float f32x4 __attribute__((ext_vector_type(4)));
typedef float f32x16 __attribute__((ext_vector_type(16)));
typedef unsigned u32x2 __attribute__((ext_vector_type(2)));
typedef unsigned u32x4 __attribute__((ext_vector_type(4)));
typedef unsigned int u32x4v __attribute__((__vector_size__(16)));

constexpr int DM = 4096, SEQ = 16384, CTX = 256, T = SEQ + CTX  , DEPTH = 2;
constexpr int NIN = 11872;
constexpr int PW = 11776;
constexpr int NPAD = 12032;
constexpr int NCH = T / 128;
constexpr int S_LRU_U = 0, S_LRU_G = 1024, S_SWA_Q = 2048, S_SWA_K = 3072, S_SWA_V = 3328, S_SWA_G = 3584, S_CQ = 4608, S_CKV = 5376,
              S_MLA_G = 5632, S_ML_Q = 6656, S_ML_K = 7680, S_ML_V = 8704, S_ML_O = 9728, S_ML_G = 10752, S_MISC = 11776;
constexpr int O_LRU_U = 0, O_LRU_G = 1024, O_SWA_Q = 2048, O_SWA_K = 3072, O_SWA_V = 3328, O_SWA_G = 3584, O_CQ = 4608, O_CKV = 5376, O_KR = 5632,
              O_MLA_G = 5696, O_ML_Q = 6720, O_ML_K = 7744, O_ML_V = 8768, O_ML_O = 9792, O_ML_GT = 10816, O_ML_G = 10848;
constexpr float EPS = 1e-6f;

constexpr size_t al256(size_t x) { return (x + 255) / 256 * 256; }
constexpr size_t WS_CTL = 0;
constexpr size_t CTL_BYTES = 65536;
constexpr size_t WS_MOD = WS_CTL + CTL_BYTES;
constexpr size_t WS_TAB16 = WS_MOD + al256((size_t)2 * 2 * 12288 * 4);
constexpr size_t WS_TAB32 = WS_TAB16 + 256 * 16 * 2 * 4;
constexpr size_t WS_WIN = WS_TAB32 + 256 * 32 * 2 * 4;
constexpr size_t WS_WOUT = WS_WIN + (size_t)2 * NPAD * DM * 2;
constexpr size_t WS_WUQ = WS_WOUT + (size_t)2 * DM * DM * 2;
constexpr size_t WS_WUKV = WS_WUQ + (size_t)2 * 1536 * 768 * 2;
constexpr size_t WS_LRUW = WS_WUKV + (size_t)2 * 2048 * 256 * 2;
constexpr size_t WS_H = WS_LRUW + (size_t)2 * 2 * 2 * 8 * 128 * 128 * 2;
constexpr size_t WS_P = WS_H + (size_t)T * DM * 2;
constexpr size_t WS_KR = WS_P + (size_t)T * PW * 2;
constexpr size_t WS_G = WS_KR + (size_t)T * 64 * 2;
constexpr size_t WS_ST1 = WS_G + (size_t)T * 32 * 4;
constexpr size_t WS_QM = WS_ST1 + (size_t)T * 16 * 4;
constexpr int LDKV = 2112;
constexpr size_t WS_KV = WS_QM + (size_t)T * 1536 * 2;
constexpr size_t WS_Y = WS_KV + (size_t)T * LDKV * 2;
constexpr size_t WS_Z = WS_Y + (size_t)T * DM * 2;
constexpr size_t WS_ST2 = WS_Z + (size_t)T * DM * 2;
constexpr size_t WS_XC = WS_ST2 + (size_t)T * 64 * 4;
constexpr size_t WS_LSUM = WS_XC + (size_t)CTX * DM * 4;
constexpr size_t WS_LCAR = WS_LSUM + (size_t)NCH * 2 * 2 * 1024 * 4;
constexpr size_t WS_CLOC = WS_LCAR + (size_t)NCH * 2 * 1024 * 4;
constexpr size_t WS_NLOC = WS_CLOC + (size_t)NCH * 16 * 16384 * 4;
constexpr size_t WS_GM = WS_NLOC + (size_t)NCH * 16 * 128 * 4;
constexpr size_t WS_CIN = WS_GM + al256((size_t)NCH * 16 * 2 * 4);
constexpr size_t WS_NIN = WS_CIN + (size_t)NCH * 16 * 16384 * 2;
constexpr size_t WS_MIN = WS_NIN + (size_t)NCH * 16 * 128 * 4;
constexpr size_t WS_END = WS_MIN + al256((size_t)NCH * 16 * 4);

__device__ __forceinline__ unsigned cvt_pk_bf16(float lo, float hi) { unsigned r; asm volatile("v_cvt_pk_bf16_f32 %0, %1, %2" : "=v"(r) : "v"(lo), "v"(hi)); return r; }
__device__ __forceinline__ bf16_t f2bf(float x) { return (bf16_t)(cvt_pk_bf16(x, x) & 0xffffu); }
__device__ __forceinline__ float bf2f(bf16_t u) { return __uint_as_float(((unsigned)u) << 16); }
__device__ __forceinline__ float bflo(unsigned w) { return __uint_as_float(w << 16); }
__device__ __forceinline__ float bfhi(unsigned w) { return __uint_as_float(w & 0xffff0000u); }
constexpr float LOG2E = 1.4426950408889634f;
__device__ __forceinline__ float sigmoidf_(float x) { return __builtin_amdgcn_rcpf(1.f + __expf(-x)); }
__device__ __forceinline__ float siluf_(float x) { return x * __builtin_amdgcn_rcpf(1.f + __expf(-x)); }
__device__ __forceinline__ float log_sigmoidf_(float x) { return fminf(x, 0.f) - log1pf(__expf(-fabsf(x))); }
__device__ __forceinline__ float softplusf_(float x) { return fmaxf(x, 0.f) + log1pf(__expf(-fabsf(x))); }

#define XB_TMO      128
#define XB_XCNT(j)  (256  + 64 * (j))
#define XB_XSUB(j)  (1280 + 64 * (j))
#define XB_XGEN(j)  (2304 + 64 * (j))
#define XB_TOP      3328
#define XB_TOPGEN   3392
#define XCD_BAR_WORDS 3456
#define XB_SPIN_CAP (1u << 24)
__device__ __forceinline__ unsigned xb_ld(unsigned* p)              { return __hip_atomic_load(p, __ATOMIC_RELAXED, __HIP_MEMORY_SCOPE_AGENT); }
__device__ __forceinline__ unsigned xb_add(unsigned* p, unsigned v) { return __hip_atomic_fetch_add(p, v, __ATOMIC_RELAXED, __HIP_MEMORY_SCOPE_AGENT); }
__device__ __forceinline__ unsigned xb_xcc_id() { return (unsigned)__builtin_amdgcn_s_getreg((3 << 11) | 20) & 0xFu; }
#define XB_SPIN(cond, bar) do { unsigned _sp = 0; while (cond) { __builtin_amdgcn_s_sleep(1); \
    if ((++_sp & 255u) == 0u) { if (xb_ld(&(bar)[XB_TMO])) break; if (_sp > XB_SPIN_CAP) { atomicAdd(&(bar)[XB_TMO], 1u); break; } } } } while (0)
struct XcdBarrier { unsigned* bar; unsigned x; volatile LAS unsigned* st; };
__device__ __forceinline__ XcdBarrier xcd_barrier_post(unsigned* bar, volatile LAS unsigned* st) {
    XcdBarrier b; b.bar = bar; b.x = xb_xcc_id(); b.st = st;
    if (threadIdx.x == 0) (void)xb_add(&bar[XB_XCNT(b.x)], 1u);
    return b;
}
__device__ __forceinline__ void xcd_barrier_complete(unsigned* bar, unsigned x, unsigned& nloc, unsigned& nx) {
    const unsigned G = gridDim.x * gridDim.y * gridDim.z;
    unsigned sum, cnt, mine, sp = 0u;
    for (;;) {
        sum = 0u; cnt = 0u; mine = 0u;
#pragma unroll
        for (unsigned j = 0; j < 16; ++j) { const unsigned c = xb_ld(&bar[XB_XCNT(j)]); sum += c; cnt += (c > 0u) ? 1u : 0u; mine = (j == x) ? c : mine; }
        if (sum == G) break;
        __builtin_amdgcn_s_sleep(1);
        if ((++sp & 255u) == 0u) { if (xb_ld(&bar[XB_TMO])) break; if (sp > XB_SPIN_CAP) { atomicAdd(&bar[XB_TMO], 1u); break; } }
    }
    nloc = mine > 0u ? mine : 1u; nx = cnt > 0u ? cnt : 1u;
}
__device__ __forceinline__ void xcd_barrier(const XcdBarrier& b) {
    asm volatile("s_waitcnt vmcnt(0)" ::: "memory");
    __syncthreads();
    if (threadIdx.x == 0) {
        unsigned* bar = b.bar;
        __builtin_amdgcn_s_waitcnt(0);
        unsigned nloc = b.st[0], nx = b.st[1];
        if (nloc == 0u) { xcd_barrier_complete(bar, b.x, nloc, nx); b.st[0] = nloc; b.st[1] = nx; }
        const unsigned old = xb_add(&bar[XB_XSUB(b.x)], 1u);
        const unsigned gen = old / nloc;
        if (old + 1u == (gen + 1u) * nloc) {
            __builtin_amdgcn_fence(__ATOMIC_RELEASE, "agent");
            asm volatile("s_waitcnt vmcnt(0)" ::: "memory");
            const unsigned og = xb_add(&bar[XB_TOP], 1u);
            const unsigned tg = og / nx;
            if (og + 1u == (tg + 1u) * nx) xb_add(&bar[XB_TOPGEN], 1u);
            else XB_SPIN(xb_ld(&bar[XB_TOPGEN]) == tg, bar);
            __builtin_amdgcn_fence(__ATOMIC_ACQUIRE, "agent");
            xb_add(&bar[XB_XGEN(b.x)], 1u);
            asm volatile("s_waitcnt vmcnt(0)" ::: "memory");
        } else {
            XB_SPIN(xb_ld(&bar[XB_XGEN(b.x)]) == gen, bar);
            __builtin_amdgcn_fence(__ATOMIC_ACQUIRE, "agent");
            asm volatile("s_waitcnt vmcnt(0)" ::: "memory");
        }
    }
    __syncthreads();
}

namespace pg8 {
constexpr int BM = 256, BK = 64, HALF = 128, HTB = HALF * BK * 2, STAGE_BYTES = 8 * HTB, NXCD = 8, WGM = 8;
__host__ __device__ __forceinline__ int lds_byte(int r, int c) { const int st = (r >> 4) * 2 + (c >> 5), rr = r & 15, cc = c & 31, ob = rr * 64 + cc * 2; return st * 1024 + (ob ^ (((ob >> 9) & 1) << 5)); }
__host__ __device__ __forceinline__ void stage_rc(int b, int& R, int& C) { const int st = b / 1024, sb = b % 1024, swz = sb ^ (((sb >> 9) & 1) << 5); R = (st >> 1) * 16 + swz / 64; C = (st & 1) * 32 + (swz % 64) / 2; }
__host__ __device__ __forceinline__ int perm32(int rho) { const int n = rho >> 4, i = rho & 15; return 8 * (i >> 2) + 4 * n + (i & 3); }
struct Unit { int pm, pn; };
struct Gemm { const bf16_t* A; const bf16_t* Bt; int M, N, K, lda, ldb; };
struct StaticOrder {
    int nM, nN, nwg, G, c;
    __host__ __device__ void init(int M, int N, int G_, int c_) { nM = M / BM; nN = N / BM; nwg = nM * nN; G = G_; c = c_; }
    __host__ __device__ bool next(int i, Unit& u) const {
        const long L = (long)i * G + c; if (L >= nwg) return false;
        int wgid = (int)L; { const int q = nwg / NXCD, r = nwg % NXCD, xcd = wgid % NXCD, off = wgid / NXCD; wgid = (xcd < r ? xcd * (q + 1) : r * (q + 1) + (xcd - r) * q) + off; }
        const int nig = WGM * nN, gid = wgid / nig, fm = gid * WGM, gsz = (nM - fm) < WGM ? (nM - fm) : WGM;
        u.pm = fm + ((wgid % nig) % gsz); u.pn = (wgid % nig) / gsz; return true;
    }
};
template <class Epi>
__device__ __forceinline__ void gemm_phase(LAS unsigned char* lds, const Gemm g, const StaticOrder& S, const Epi& E, const int tid) {
    const int wid = __builtin_amdgcn_readfirstlane(tid >> 6), lane = tid & 63, wr = wid >> 2, wc = wid & 3, fr = lane & 15, fq = lane >> 4;
    const int K = g.K, nt = K / BK;
    unsigned voffA[2], voffB[2], voffB1[2];
#pragma unroll
    for (int i = 0; i < 2; ++i) { int R, C; stage_rc(tid * 16 + i * 8192, R, C); const int Rb = 64 * (R >> 5) + perm32(R & 31);
        voffA[i] = (unsigned)(R * g.lda + C) * 2u; voffB[i] = (unsigned)(Rb * g.ldb + C) * 2u; voffB1[i] = (unsigned)((Rb + 32) * g.ldb + C) * 2u; }
    struct GOff { __amdgpu_buffer_rsrc_t rs; unsigned so; __device__ __forceinline__ GOff operator+(unsigned d) const { return GOff{rs, so + d}; } };
    const unsigned kstep = (unsigned)(BK * 2);
    const unsigned hstepA = (unsigned)HALF * (unsigned)g.lda * 2u, hstepB = (unsigned)HALF * (unsigned)g.ldb * 2u;
    const unsigned tstepA = 2u * hstepA, tstepB = 2u * hstepB;
    const __amdgpu_buffer_rsrc_t rsA = __builtin_amdgcn_make_buffer_rsrc((void*)g.A, (short)0, (int)0xFFFFFFF0u, 0x00020000), rsB = __builtin_amdgcn_make_buffer_rsrc((void*)g.Bt, (short)0, (int)0xFFFFFFF0u, 0x00020000);
    const unsigned ldsw = (unsigned)wid * 1024u;
    const int aoff = lds_byte(wr * 64 + fr, fq * 8), boff = lds_byte(wc * 32 + fr, fq * 8);
#define PG8_SA(b, h) (((b) * 2 + (h)) * HTB)
#define PG8_SB(b, h) ((4 + (b) * 2 + (h)) * HTB)
#define PG8_STAGE(bufoff, gbase, voff) do { _Pragma("unroll") for (int _i = 0; _i < 2; ++_i) \
        __builtin_amdgcn_raw_ptr_buffer_load_lds((gbase).rs, (LAS void*)(lds + (bufoff) + ldsw + _i * 8192), 16, (int)(voff)[_i], (int)(gbase).so, 0, 0); } while (0)
#define PG8_LDA(dst, b, h) do { _Pragma("unroll") for (int m = 0; m < 4; ++m) _Pragma("unroll") for (int k = 0; k < 2; ++k) dst[m][k] = *(const LAS bf16x8*)(lds + PG8_SA(b, h) + aoff + m * 2048 + k * 1024); } while (0)
#define PG8_LDB(dst, b, h) do { _Pragma("unroll") for (int n = 0; n < 2; ++n) _Pragma("unroll") for (int k = 0; k < 2; ++k) dst[n][k] = *(const LAS bf16x8*)(lds + PG8_SB(b, h) + boff + n * 2048 + k * 1024); } while (0)
#define PG8_MMA(ai, bj, At, Bt) do { __builtin_amdgcn_s_setprio(1); _Pragma("unroll") for (int m = 0; m < 4; ++m) _Pragma("unroll") for (int n = 0; n < 2; ++n) _Pragma("unroll") for (int k = 0; k < 2; ++k) \
        acc[ai][bj][m][n] = __builtin_amdgcn_mfma_f32_16x16x32_bf16(Bt[n][k], At[m][k], acc[ai][bj][m][n], 0, 0, 0); __builtin_amdgcn_s_setprio(0); } while (0)
#define PG8_WAIT_V(n) asm volatile("s_waitcnt vmcnt(" #n ")" ::: "memory")
#define PG8_WAIT_L(n) asm volatile("s_waitcnt lgkmcnt(" #n ")" ::: "memory")
#define PG8_BAR __builtin_amdgcn_s_barrier()
#define PG8_SCHED __builtin_amdgcn_sched_barrier(0)
    Unit cur, nxt; int ui = 0;
    if (!S.next(0, cur)) return;
    f32x4 acc[2][2][4][2];
#pragma unroll
    for (int a = 0; a < 2; ++a)
#pragma unroll
        for (int b = 0; b < 2; ++b)
#pragma unroll
            for (int m = 0; m < 4; ++m)
#pragma unroll
                for (int n = 0; n < 2; ++n) acc[a][b][m][n] = (f32x4){0.f, 0.f, 0.f, 0.f};
    bf16x8 At[4][2], B0[2][2], B1[2][2];
    GOff cA{rsA, (unsigned)cur.pm * tstepA}, cB{rsB, (unsigned)cur.pn * tstepB};
    PG8_STAGE(PG8_SB(0, 0), cB, voffB); PG8_STAGE(PG8_SA(0, 0), cA, voffA); PG8_STAGE(PG8_SB(0, 1), cB, voffB1); PG8_STAGE(PG8_SA(0, 1), cA + hstepA, voffA);
    if (wr == 1) PG8_BAR;
    PG8_WAIT_V(4); PG8_BAR;
    PG8_STAGE(PG8_SB(1, 0), cB + kstep, voffB); PG8_STAGE(PG8_SA(1, 0), cA + kstep, voffA); PG8_STAGE(PG8_SB(1, 1), cB + kstep, voffB1);
    PG8_WAIT_V(6); PG8_BAR;
    for (;;) {
        const bool has_next = S.next(ui + 1, nxt);
        const GOff nA{rsA, has_next ? (unsigned)nxt.pm * tstepA : cA.so}, nB{rsB, has_next ? (unsigned)nxt.pn * tstepB : cB.so};
#pragma unroll 1
        for (int t = 0; t < nt; t += 2) {
            const bool last = (t == nt - 2);
            const GOff a1 = cA + (unsigned)(t + 1) * kstep;
            const GOff a2 = last ? nA : cA + (unsigned)(t + 2) * kstep, b2 = last ? nB : cB + (unsigned)(t + 2) * kstep;
            const GOff a3 = a2 + kstep, b3 = b2 + kstep;
            PG8_LDB(B0, 0, 0); PG8_SCHED; PG8_LDA(At, 0, 0); PG8_STAGE(PG8_SA(1, 1), a1 + hstepA, voffA);
            PG8_WAIT_L(8); PG8_BAR; PG8_WAIT_L(0); PG8_MMA(0, 0, At, B0); PG8_BAR; PG8_SCHED;
            PG8_LDB(B1, 0, 1); PG8_STAGE(PG8_SB(0, 0), b2, voffB);
            PG8_BAR; PG8_WAIT_L(0); PG8_MMA(0, 1, At, B1); PG8_BAR;
            PG8_LDA(At, 0, 1); PG8_STAGE(PG8_SA(0, 0), a2, voffA);
            PG8_BAR; PG8_WAIT_L(0); PG8_MMA(1, 0, At, B0); PG8_BAR; PG8_SCHED;
            PG8_STAGE(PG8_SB(0, 1), b2, voffB1);
            PG8_WAIT_V(6); PG8_BAR; PG8_MMA(1, 1, At, B1); PG8_BAR;
            PG8_LDB(B0, 1, 0); PG8_SCHED; PG8_LDA(At, 1, 0); PG8_STAGE(PG8_SA(0, 1), a2 + hstepA, voffA);
            PG8_WAIT_L(8); PG8_BAR; PG8_WAIT_L(0); PG8_MMA(0, 0, At, B0); PG8_BAR; PG8_SCHED;
            PG8_LDB(B1, 1, 1); PG8_STAGE(PG8_SB(1, 0), b3, voffB);
            PG8_BAR; PG8_WAIT_L(0); PG8_MMA(0, 1, At, B1); PG8_BAR;
            PG8_LDA(At, 1, 1); PG8_STAGE(PG8_SA(1, 0), a3, voffA);
            PG8_BAR; PG8_WAIT_L(0); PG8_MMA(1, 0, At, B0); PG8_BAR; PG8_SCHED;
            PG8_STAGE(PG8_SB(1, 1), b3, voffB1);
            PG8_WAIT_V(6); PG8_BAR; PG8_MMA(1, 1, At, B1); PG8_BAR;
        }
        E(acc, cur, wr, wc, fr, fq);
        if (!has_next) break;
#pragma unroll
        for (int a = 0; a < 2; ++a)
#pragma unroll
            for (int b = 0; b < 2; ++b)
#pragma unroll
                for (int m = 0; m < 4; ++m)
#pragma unroll
                    for (int n = 0; n < 2; ++n) acc[a][b][m][n] = (f32x4){0.f, 0.f, 0.f, 0.f};
        cur = nxt; cA = nA; cB = nB; ++ui;
    }
    PG8_WAIT_V(0);
    if (wr == 0) PG8_BAR;
    PG8_BAR;
#undef PG8_SA
#undef PG8_SB
#undef PG8_STAGE
#undef PG8_LDA
#undef PG8_LDB
#undef PG8_MMA
#undef PG8_WAIT_V
#undef PG8_WAIT_L
#undef PG8_BAR
#undef PG8_SCHED
}
}

constexpr int NTHR = 512, NWAVE = 8;
constexpr int LDS_MISC = 0;
constexpr int LDS_RING = 512;
constexpr int LDS_BYTES = 155648;
constexpr int RING_BYTES = LDS_BYTES - LDS_RING;

#ifndef REPMASK
#define REPMASK 0
#endif
#define REP(b) _Pragma("unroll 1") for (int rep_ = 0; rep_ < 1 + ((REPMASK >> (b)) & 1); ++rep_)
struct Args {
    const float* in[24]; float* out; unsigned char* ws;
    int ph_lo, ph_hi;
};
struct Frame {
    LAS unsigned char* lds; unsigned char* ws; int tid, lane, wave, G, bid;
    const float *x, *c, *ctx, *c_ctx, *w_mod, *b_mod, *g_pre, *g_post, *w_in, *w_out, *conv_w, *conv_b, *lam, *wa, *ba, *wx, *bx, *sink, *q_norm, *w_uq, *kv_norm, *w_ukv, *gate_b, *head_norm;
    float* out;
};
constexpr int LDS_PTRS = 64;
__device__ __forceinline__ const float* lds_ptr(LAS unsigned char* lds, int k) {
    const LAS unsigned* p = (const LAS unsigned*)(lds + LDS_PTRS) + 2 * k;
    const unsigned lo = __builtin_amdgcn_readfirstlane(p[0]), hi = __builtin_amdgcn_readfirstlane(p[1]);
    typedef __attribute__((address_space(1))) const float gcf_t;
    return (const float*)(gcf_t*)(((unsigned long long)hi << 32) | lo);
}
__device__ __forceinline__ bool ph_in(LAS unsigned char* lds, int k) {
    const int lo = __builtin_amdgcn_readfirstlane(((const LAS int*)(lds + LDS_MISC))[8]), hi = __builtin_amdgcn_readfirstlane(((const LAS int*)(lds + LDS_MISC))[9]);
    return lo <= k && k < hi;
}
__device__ __forceinline__ void grid_barrier(LAS unsigned char* lds) {
    XcdBarrier b; b.bar = (unsigned*)((unsigned char*)lds_ptr(lds, 25) + WS_CTL); b.x = xb_xcc_id(); b.st = (volatile LAS unsigned*)(lds + LDS_MISC);
    xcd_barrier(b);
}
__device__ __forceinline__ Frame load_frame(LAS unsigned char* lds, const int wave0) {
    Frame F; F.lds = lds;
    unsigned z0 = 0u; asm volatile("" : "+v"(z0));
    int t = wave0 * 64 + (int)__builtin_amdgcn_mbcnt_hi(~0u, __builtin_amdgcn_mbcnt_lo(~0u, z0)); asm volatile("" : "+v"(t));
    F.tid = t; F.lane = t & 63; F.wave = wave0; F.G = gridDim.x; F.bid = blockIdx.x;
    F.x = lds_ptr(lds, 0); F.c = lds_ptr(lds, 1); F.ctx = lds_ptr(lds, 2); F.c_ctx = lds_ptr(lds, 3); F.w_mod = lds_ptr(lds, 4); F.b_mod = lds_ptr(lds, 5); F.g_pre = lds_ptr(lds, 6); F.g_post = lds_ptr(lds, 7);
    F.w_in = lds_ptr(lds, 8); F.w_out = lds_ptr(lds, 9); F.conv_w = lds_ptr(lds, 10); F.conv_b = lds_ptr(lds, 11); F.lam = lds_ptr(lds, 12); F.wa = lds_ptr(lds, 13); F.ba = lds_ptr(lds, 14); F.wx = lds_ptr(lds, 15);
    F.bx = lds_ptr(lds, 16); F.sink = lds_ptr(lds, 17); F.q_norm = lds_ptr(lds, 18); F.w_uq = lds_ptr(lds, 19); F.kv_norm = lds_ptr(lds, 20); F.w_ukv = lds_ptr(lds, 21); F.gate_b = lds_ptr(lds, 22); F.head_norm = lds_ptr(lds, 23);
    F.out = (float*)lds_ptr(lds, 24); F.ws = (unsigned char*)lds_ptr(lds, 25);
    return F;
}
#define WSP(T_, off) ((T_*)(F.ws + (off)))

__device__ __forceinline__ void rope4(f32x4& x1, f32x4& x2, const float* tp) {
    const f32x4 a = *(const f32x4*)tp, b = *(const f32x4*)(tp + 4);
    const float c0 = a[0], s0 = a[1], c1 = a[2], s1 = a[3], c2 = b[0], s2 = b[1], c3 = b[2], s3 = b[3];
    f32x4 o1, o2;
    o1[0] = x1[0] * c0 - x2[0] * s0; o2[0] = x2[0] * c0 + x1[0] * s0;
    o1[1] = x1[1] * c1 - x2[1] * s1; o2[1] = x2[1] * c1 + x1[1] * s1;
    o1[2] = x1[2] * c2 - x2[2] * s2; o2[2] = x2[2] * c2 + x1[2] * s2;
    o1[3] = x1[3] * c3 - x2[3] * s3; o2[3] = x2[3] * c3 + x1[3] * s3;
    x1 = o1; x2 = o2;
}
__device__ __forceinline__ void rope4v(f32x4& x1, f32x4& x2, const f32x4& a, const f32x4& b) {
    const float c0 = a[0], s0 = a[1], c1 = a[2], s1 = a[3], c2 = b[0], s2 = b[1], c3 = b[2], s3 = b[3];
    f32x4 o1, o2;
    o1[0] = x1[0] * c0 - x2[0] * s0; o2[0] = x2[0] * c0 + x1[0] * s0;
    o1[1] = x1[1] * c1 - x2[1] * s1; o2[1] = x2[1] * c1 + x1[1] * s1;
    o1[2] = x1[2] * c2 - x2[2] * s2; o2[2] = x2[2] * c2 + x1[2] * s2;
    o1[3] = x1[3] * c3 - x2[3] * s3; o2[3] = x2[3] * c3 + x1[3] * s3;
    x1 = o1; x2 = o2;
}
__device__ __forceinline__ u32x4 pack8(const f32x4& v0, const f32x4& v1) {
    u32x4 w; w.x = cvt_pk_bf16(v0[0], v0[1]); w.y = cvt_pk_bf16(v0[2], v0[3]); w.z = cvt_pk_bf16(v1[0], v1[1]); w.w = cvt_pk_bf16(v1[2], v1[3]); return w;
}
__device__ __forceinline__ float dot4(const f32x4& v) { return v[0] * v[0] + v[1] * v[1] + v[2] * v[2] + v[3] * v[3]; }

struct EpiIn {
    static constexpr bool PERM = true;
    bf16_t* P; bf16_t* KR; float* G; float* ST1; const float* tab16; const float* tab32; const float* gate_b; const LAS float* lt32;
    __device__ __forceinline__ void operator()(const f32x4 (&acc)[2][2][4][2], const pg8::Unit& u, int wr, int wc, int fr, int fq) const {
        const int pn = u.pn, rowb = u.pm * 256 + wr * 64 + fr;
        if (pn < 46) {
            const bool rope = (pn >= 8 && pn <= 12) && (u.pm >= 1);
            const bool stat = (pn >= 18 && pn <= 21);
            if (rope) {
#pragma unroll
                for (int ai = 0; ai < 2; ++ai) {
                    f32x4 ra[2], rb[2];
                    if (!(wc & 1)) {
#pragma unroll
                        for (int bj = 0; bj < 2; ++bj) { const float* tp = tab32 + ((4 * (u.pm - 1) + wr + 2 * ai) * 32 + 16 * bj + 4 * fq) * 2; ra[bj] = *(const f32x4*)tp; rb[bj] = *(const f32x4*)(tp + 4); }
                    }
#pragma unroll
                    for (int m = 0; m < 4; ++m) { const int row = rowb + ai * 128 + m * 16;
#pragma unroll
                        for (int bj = 0; bj < 2; ++bj) {
                            f32x4 v0 = acc[ai][bj][m][0], v1 = acc[ai][bj][m][1];
                            if (wc & 1) { const LAS float* tp = lt32 + ((fr + 16 * m) * 32 + 16 * bj + 4 * fq) * 2; const f32x4 ca_ = *(const LAS f32x4*)tp, cb_ = *(const LAS f32x4*)(tp + 4); rope4v(v0, v1, ca_, cb_); }
                            else rope4v(v0, v1, ra[bj], rb[bj]);
                            *(u32x4*)(P + (size_t)row * PW + pn * 256 + wc * 64 + bj * 32 + 8 * fq) = pack8(v0, v1);
                        }
                    }
                }
            } else {
#pragma unroll
            for (int ai = 0; ai < 2; ++ai)
#pragma unroll
                for (int m = 0; m < 4; ++m) {
                    const int row = rowb + ai * 128 + m * 16;
                    float ss = 0.f;
#pragma unroll
                    for (int bj = 0; bj < 2; ++bj) {
                        const f32x4 v0 = acc[ai][bj][m][0], v1 = acc[ai][bj][m][1];
                        if (stat) ss += dot4(v0) + dot4(v1);
                        *(u32x4*)(P + (size_t)row * PW + pn * 256 + wc * 64 + bj * 32 + 8 * fq) = pack8(v0, v1);
                    }
                    if (stat) { ss += __shfl_xor(ss, 16); ss += __shfl_xor(ss, 32); if (fq == 0) ST1[(size_t)row * 16 + (pn - 18) * 4 + wc] = ss; }
                }
            }
        } else {
#pragma unroll
            for (int ai = 0; ai < 2; ++ai)
#pragma unroll
                for (int m = 0; m < 4; ++m) {
                    const int row = rowb + ai * 128 + m * 16, t = row - 256, trow = t >> 6, tcol = t & 63;
                    if (wc == 0) {
#pragma unroll
                        for (int bj = 0; bj < 2; ++bj) { f32x4 v0 = acc[ai][bj][m][0], v1 = acc[ai][bj][m][1];
                            if (u.pm >= 1) { const int pos = (bj == 0) ? trow : tcol; rope4(v0, v1, tab16 + (pos * 16 + 4 * fq) * 2); }
                            *(u32x4*)(KR + (size_t)row * LDKV + 2048 + 32 * bj + 8 * fq) = pack8(v0, v1); }
                    } else if (wc == 1) {
                        const f32x4 v0 = acc[ai][0][m][0], v1 = acc[ai][0][m][1];
                        const f32x4 b0 = *(const f32x4*)(gate_b + 8 * fq), b1 = *(const f32x4*)(gate_b + 8 * fq + 4);
                        *(f32x4*)(G + (size_t)row * 32 + 8 * fq) = v0 + b0; *(f32x4*)(G + (size_t)row * 32 + 8 * fq + 4) = v1 + b1;
                    }
                }
        }
    }
};
struct EpiUq {
    static constexpr bool PERM = true;
    bf16_t* QM; const float* ST1; const float* tab16; const LAS float* lt16;
    __device__ __forceinline__ void operator()(const f32x4 (&acc)[2][2][4][2], const pg8::Unit& u, int wr, int wc, int fr, int fq) const {
        const int pn = u.pn, rowb = u.pm * 256 + wr * 64 + fr;
        const bool ropew = ((8 * pn + 2 * wc) % 6 == 4) && (u.pm >= 1);
        f32x4 ra[2], rb[2];
#pragma unroll
        for (int ai = 0; ai < 2; ++ai) { const float* tp = tab16 + ((ropew ? 4 * (u.pm - 1) + wr + 2 * ai : 0) * 16 + 4 * fq) * 2; ra[ai] = *(const f32x4*)tp; rb[ai] = *(const f32x4*)(tp + 4); }
        float rstd[2][4];
#pragma unroll
        for (int ai = 0; ai < 2; ++ai)
#pragma unroll
            for (int m = 0; m < 4; ++m) { const int row = rowb + ai * 128 + m * 16;
                const f32x4 s0 = *(const f32x4*)(ST1 + (size_t)row * 16 + (fq < 3 ? fq : 0) * 4);
                float ssum = fq < 3 ? (s0[0] + s0[1]) + (s0[2] + s0[3]) : 0.f; ssum += __shfl_xor(ssum, 16); ssum += __shfl_xor(ssum, 32);
                rstd[ai][m] = rsqrtf(ssum * (1.f / 768.f) + EPS) * (0.07216878364870322f * 1.4426950408889634f); }
#pragma unroll
        for (int ai = 0; ai < 2; ++ai)
#pragma unroll
            for (int m = 0; m < 4; ++m) { const int row = rowb + ai * 128 + m * 16;
#pragma unroll
                for (int bj = 0; bj < 2; ++bj) {
                    f32x4 v0 = acc[ai][bj][m][0] * rstd[ai][m], v1 = acc[ai][bj][m][1] * rstd[ai][m];
                    if (ropew) { if (bj == 0) rope4v(v0, v1, ra[ai], rb[ai]);
                                 else { const LAS float* tp = lt16 + ((fr + 16 * m) * 16 + 4 * fq) * 2; const f32x4 ca_ = *(const LAS f32x4*)tp, cb_ = *(const LAS f32x4*)(tp + 4); rope4v(v0, v1, ca_, cb_); } }
                    *(u32x4*)(QM + (size_t)row * 1536 + pn * 256 + wc * 64 + bj * 32 + 8 * fq) = pack8(v0, v1);
                }
            }
    }
};
struct EpiUkv {
    static constexpr bool PERM = true;
    bf16_t* KV; const float* ST1;
    __device__ __forceinline__ void operator()(const f32x4 (&acc)[2][2][4][2], const pg8::Unit& u, int wr, int wc, int fr, int fq) const {
        const int pn = u.pn, rowb = u.pm * 256 + wr * 64 + fr;
        float rstdv[2][4];
#pragma unroll
        for (int ai = 0; ai < 2; ++ai)
#pragma unroll
            for (int m = 0; m < 4; ++m) { const f32x4 s0 = *(const f32x4*)(ST1 + (size_t)(rowb + ai * 128 + m * 16) * 16 + 12);
                rstdv[ai][m] = rsqrtf((s0[0] + s0[1] + s0[2] + s0[3]) * (1.f / 256.f) + EPS); }
#pragma unroll
        for (int ai = 0; ai < 2; ++ai)
#pragma unroll
            for (int m = 0; m < 4; ++m) {
                const int row = rowb + ai * 128 + m * 16;
                const float rstd = rstdv[ai][m];
#pragma unroll
                for (int bj = 0; bj < 2; ++bj) {
                    const f32x4 v0 = acc[ai][bj][m][0] * rstd, v1 = acc[ai][bj][m][1] * rstd;
                    *(u32x4*)(KV + (size_t)row * LDKV + pn * 256 + wc * 64 + bj * 32 + 8 * fq) = pack8(v0, v1);
                }
            }
    }
};
struct EpiOut {
    static constexpr bool PERM = true;
    bf16_t* Z; float* ST2; int row0;
    __device__ __forceinline__ void operator()(const f32x4 (&acc)[2][2][4][2], const pg8::Unit& u, int wr, int wc, int fr, int fq) const {
        const int pn = u.pn, rowb = row0 + u.pm * 256 + wr * 64 + fr;
#pragma unroll
        for (int ai = 0; ai < 2; ++ai)
#pragma unroll
            for (int m = 0; m < 4; ++m) {
                const int row = rowb + ai * 128 + m * 16;
                float ss = 0.f;
#pragma unroll
                for (int bj = 0; bj < 2; ++bj) {
                    const f32x4 v0 = acc[ai][bj][m][0], v1 = acc[ai][bj][m][1];
                    ss += dot4(v0) + dot4(v1);
                    *(u32x4*)(Z + (size_t)row * DM + pn * 256 + wc * 64 + bj * 32 + 8 * fq) = pack8(v0, v1);
                }
                ss += __shfl_xor(ss, 16); ss += __shfl_xor(ss, 32);
                if (fq == 0) ST2[(size_t)row * 64 + pn * 4 + wc] = ss;
            }
    }
};

__device__ __forceinline__ int swa_perm(int sh) { const int g = sh >> 5, fq = (sh >> 3) & 3, n = (sh >> 2) & 1, j = sh & 3; return 64 * (g >> 1) + 32 * n + 16 * (g & 1) + 4 * fq + j; }
__device__ __forceinline__ int rope64_perm(int s) { const int g = s >> 5, fq = (s >> 3) & 3, n = (s >> 2) & 1, j = s & 3; return 32 * g + 16 * n + 4 * fq + j; }
struct CmWin {
    __device__ __forceinline__ int operator()(int s, float& sc) const {
        if (s < S_SWA_Q) return s;
        if (s < S_SWA_K) { const int x = s - S_SWA_Q; sc = 0.08838834764831845f * 1.4426950408889634f; return O_SWA_Q + (x & ~127) + swa_perm(x & 127); }
        if (s < S_SWA_V) { const int x = s - S_SWA_K; return O_SWA_K + (x & ~127) + swa_perm(x & 127); }
        if (s < S_MLA_G) return s;
        if (s < S_ML_Q) return O_MLA_G + (s - S_MLA_G);
        if (s < S_ML_K) return O_ML_Q + (s - S_ML_Q);
        if (s < S_ML_V) { sc = 0.08838834764831845f; return O_ML_K + (s - S_ML_K); }
        if (s < S_ML_O) return O_ML_V + (s - S_ML_V);
        if (s < S_ML_G) return O_ML_O + (s - S_ML_O);
        if (s < S_MISC) return O_ML_G + (s - S_ML_G);
        const int x = s - S_MISC;
        if (x < 64) return O_KR + rope64_perm(x);
        if (x < 96) return O_ML_GT + (x - 64);
        return -1;
    }
};
struct CmId { __device__ __forceinline__ int operator()(int s, float&) const { return s; } };
struct CmUq { __device__ __forceinline__ int operator()(int s, float&) const { const int h = s / 192, x = s - h * 192; return x < 128 ? s : h * 192 + 128 + rope64_perm(x - 128); } };

template <int KT, class CM>
__device__ __forceinline__ void transpose_item(const Frame& F, const float* __restrict__ src, int ld_src, int K, bf16_t* __restrict__ dst, const float* __restrict__ rowscale, const CM& cm, int s0, int k0) {
    constexpr int PW_ = KT / 2 + 1, NJ = KT / 64;
    LAS unsigned* tile = (LAS unsigned*)(F.lds + LDS_RING);
    const int q = F.tid & 15, kp = F.tid >> 4;
    float sc = 1.f; const int col = cm(s0 + 4 * q, sc);
    f32x4 v0[NJ], v1[NJ];
#pragma unroll
    for (int j = 0; j < NJ; ++j) { v0[j] = (f32x4){0.f, 0.f, 0.f, 0.f}; v1[j] = v0[j]; }
    if (col >= 0) {
#pragma unroll
        for (int j = 0; j < NJ; ++j) { const int k = k0 + 2 * (kp + 32 * j);
            v0[j] = __builtin_nontemporal_load((const f32x4*)(src + (size_t)k * ld_src + col)); v1[j] = __builtin_nontemporal_load((const f32x4*)(src + (size_t)(k + 1) * ld_src + col)); }
#pragma unroll
        for (int j = 0; j < NJ; ++j) { const int k = k0 + 2 * (kp + 32 * j); float r0 = sc, r1 = sc; if (rowscale) { r0 *= rowscale[k]; r1 *= rowscale[k + 1]; } v0[j] *= r0; v1[j] *= r1; }
    }
#pragma unroll
    for (int j = 0; j < NJ; ++j)
#pragma unroll
        for (int e = 0; e < 4; ++e) tile[(4 * q + e) * PW_ + kp + 32 * j] = cvt_pk_bf16(v0[j][e], v1[j][e]);
    __syncthreads();
    const int sr = F.tid >> 3, c8 = F.tid & 7;
#pragma unroll
    for (int j = 0; j < NJ; ++j) { const int kc = (c8 + 8 * j) * 4;
        u32x4 w; w.x = tile[sr * PW_ + kc]; w.y = tile[sr * PW_ + kc + 1]; w.z = tile[sr * PW_ + kc + 2]; w.w = tile[sr * PW_ + kc + 3];
        *(u32x4*)(dst + (size_t)(s0 + sr) * K + k0 + 2 * kc) = w; }
    __syncthreads();
}

struct ModPre { f32x4 w[16]; };
__device__ __forceinline__ void mod_pre_issue(ModPre& R, const Frame& F, int item) {
    const int l = item / 384, r = item % 384, kh = r / 192, n0 = (r % 192) * 64;
    const int cq = F.lane & 15, kl = (F.lane >> 4) + 4 * F.wave;
    const float* wp = F.w_mod + ((size_t)l * DM + kh * 2048) * 12288 + n0 + 4 * cq;
#pragma unroll
    for (int i = 0; i < 16; ++i) R.w[i] = __builtin_nontemporal_load((const f32x4*)(wp + (size_t)(kl + 32 * i) * 12288));
}
__device__ __forceinline__ void mod_loop(const Frame& F) {
    if (F.bid >= 768) return;
    LAS float* sc = (LAS float*)(F.lds + LDS_RING); LAS float* red = sc + 4096;
    ModPre R; mod_pre_issue(R, F, F.bid);
#pragma unroll 1
    for (int item = F.bid; item < 768; item += F.G) {
        const int l = item / 384, r = item % 384, kh = r / 192, n0 = (r % 192) * 64;
        for (int i = F.tid; i < 2048; i += NTHR) { sc[i] = siluf_(F.c[kh * 2048 + i]); sc[2048 + i] = siluf_(F.c_ctx[kh * 2048 + i]); }
        __syncthreads();
        const int cq = F.lane & 15, kl = (F.lane >> 4) + 4 * F.wave;
        f32x4 a0 = {0.f, 0.f, 0.f, 0.f}, a1 = {0.f, 0.f, 0.f, 0.f};
        const float* wp = F.w_mod + ((size_t)l * DM + kh * 2048) * 12288 + n0 + 4 * cq;
#pragma unroll
        for (int i = 0; i < 16; ++i) { const int k = kl + 32 * i; a0 += R.w[i] * sc[k]; a1 += R.w[i] * sc[2048 + k]; }
#pragma unroll 16
        for (int i = 16; i < 64; ++i) { const int k = kl + 32 * i; const f32x4 w = __builtin_nontemporal_load((const f32x4*)(wp + (size_t)k * 12288)); a0 += w * sc[k]; a1 += w * sc[2048 + k]; }
        mod_pre_issue(R, F, item + F.G < 768 ? item + F.G : item);
#pragma unroll
        for (int j = 0; j < 4; ++j) { red[(kl * 64 + 4 * cq + j) * 2] = a0[j]; red[(kl * 64 + 4 * cq + j) * 2 + 1] = a1[j]; }
        __syncthreads();
        if (F.tid < 128) { const int col = F.tid & 63, v = F.tid >> 6; float s_ = 0.f;
            for (int k2 = 0; k2 < 32; ++k2) s_ += red[(k2 * 64 + col) * 2 + v];
            if (kh == 0) s_ += F.b_mod[l * 12288 + n0 + col];
            atomicAdd(WSP(float, WS_MOD) + (size_t)(l * 2 + v) * 12288 + n0 + col, s_); }
        __syncthreads();
    }
}

__device__ __forceinline__ void rope_tables(const Frame& F) {
    if (F.tid < 48) {
        const bool is32 = F.tid >= 16; const int i = is32 ? F.tid - 16 : F.tid, half = is32 ? 32 : 16;
        const double r = is32 ? 0.7498942093324558 : 0.5623413251903491;
        double f = 1.0; for (int q = 0; q < i; ++q) f *= r;
        double cb = 1.0, sb = f, term_c = 1.0, term_s = f; const double f2 = f * f;
        for (int q = 1; q < 14; ++q) { term_c *= -f2 / (double)((2 * q - 1) * (2 * q)); term_s *= -f2 / (double)((2 * q) * (2 * q + 1)); cb += term_c; sb += term_s; }
        float* tab = is32 ? WSP(float, WS_TAB32) : WSP(float, WS_TAB16);
        double c = 1.0, s = 0.0;
        for (int pos = 0; pos < 256; ++pos) { tab[(pos * half + i) * 2] = (float)c; tab[(pos * half + i) * 2 + 1] = (float)s; const double c2 = c * cb - s * sb; s = s * cb + c * sb; c = c2; }
    }
}

constexpr int NB_WIN = 188 * 16, NB_WOUT = 64 * 16, NB_L = NB_WIN + NB_WOUT, NB_ALL = 2 * NB_L;
struct TDesc { const float* sp; bf16_t* dp; int ld; float sc; bool ok; };
__device__ __forceinline__ TDesc big_item(const Frame& F, int it, int q, int kp) {
    TDesc d; const int l = it / NB_L; int r = it - l * NB_L; d.sc = 1.f;
    if (r < NB_WIN) { const int s0 = (r >> 4) * 64, k0 = (r & 15) * 256; const int col = CmWin()(s0 + 4 * q, d.sc); d.ok = col >= 0; d.ld = NIN;
        d.sp = F.w_in + (size_t)l * DM * NIN + (size_t)(k0 + 2 * kp) * NIN + (col >= 0 ? col : 0); d.dp = WSP(bf16_t, WS_WIN) + (size_t)l * NPAD * DM + (size_t)s0 * DM + k0; }
    else { r -= NB_WIN; const int s0 = (r >> 4) * 64, k0 = (r & 15) * 256; d.ok = true; d.ld = DM;
        d.sp = F.w_out + (size_t)l * DM * DM + (size_t)(k0 + 2 * kp) * DM + s0 + 4 * q; d.dp = WSP(bf16_t, WS_WOUT) + (size_t)l * DM * DM + (size_t)s0 * DM + k0; }
    return d;
}
#define TLOAD(D, V0, V1) do { _Pragma("unroll") for (int j = 0; j < 4; ++j) { if ((D).ok) { V0[j] = __builtin_nontemporal_load((const f32x4*)((D).sp + (size_t)(64 * j) * (D).ld)); \
        V1[j] = __builtin_nontemporal_load((const f32x4*)((D).sp + (size_t)(64 * j + 1) * (D).ld)); } else { V0[j] = (f32x4){0.f, 0.f, 0.f, 0.f}; V1[j] = V0[j]; } } } while (0)
#define TSTEP(D, V0, V1, ITN) do { \
        _Pragma("unroll") for (int j = 0; j < 4; ++j) _Pragma("unroll") for (int e = 0; e < 4; ++e) tile[(4 * q + e) * 129 + kp + 32 * j] = cvt_pk_bf16(V0[j][e] * (D).sc, V1[j][e] * (D).sc); \
        __syncthreads(); \
        bf16_t* dp_ = (D).dp; const int itn_ = (ITN); \
        if (itn_ < NB_ALL) { (D) = big_item(F, itn_, q, kp); TLOAD(D, V0, V1); }       \
        _Pragma("unroll") for (int j = 0; j < 4; ++j) { const int kc = (c8 + 8 * j) * 4; \
            u32x4 w; w.x = tile[sr * 129 + kc]; w.y = tile[sr * 129 + kc + 1]; w.z = tile[sr * 129 + kc + 2]; w.w = tile[sr * 129 + kc + 3]; \
            *(u32x4*)(dp_ + (size_t)sr * DM + 2 * kc) = w; } \
        __syncthreads(); } while (0)
__device__ __forceinline__ void big_transposes(const Frame& F) {
    LAS unsigned* tile = (LAS unsigned*)(F.lds + LDS_RING);
    const int q = F.tid & 15, kp = F.tid >> 4, sr = F.tid >> 3, c8 = F.tid & 7;
    int it = F.bid; if (it >= NB_ALL) return;
    TDesc da = big_item(F, it, q, kp), db = da; f32x4 a0[4], a1[4], b0[4], b1[4];
    TLOAD(da, a0, a1);
    const bool hasb = it + F.G < NB_ALL;
    if (hasb) { db = big_item(F, it + F.G, q, kp); TLOAD(db, b0, b1); }
    for (; it < NB_ALL; it += 2 * F.G) {
        TSTEP(da, a0, a1, it + 2 * F.G);
        if (it + F.G < NB_ALL) TSTEP(db, b0, b1, it + 3 * F.G);
    }
}
#undef TLOAD
#undef TSTEP

__device__ __forceinline__ void p0_prologue(const Frame& F) {
    if (F.bid == 0) rope_tables(F);
    mod_loop(F);
    REP(14) big_transposes(F);
    constexpr int N_UQ = 24 * 3, N_UKV = 32, N_LRU = 32 * 4, N_L = N_UQ + N_UKV + N_LRU;
    for (int it = F.bid; it < 2 * N_L; it += F.G) {
        const int l = it / N_L; int r = it - l * N_L;
        if (r < N_UQ) { transpose_item<256>(F, F.w_uq + (size_t)l * 768 * 1536, 1536, 768, WSP(bf16_t, WS_WUQ) + (size_t)l * 1536 * 768, F.q_norm + l * 768, CmUq(), (r / 3) * 64, (r % 3) * 256); continue; }
        r -= N_UQ;
        if (r < N_UKV) { transpose_item<256>(F, F.w_ukv + (size_t)l * 256 * 2048, 2048, 256, WSP(bf16_t, WS_WUKV) + (size_t)l * 2048 * 256, F.kv_norm + l * 256, CmId(), r * 64, 0); continue; }
        r -= N_UKV;
        { const int mat = r >> 2, q = r & 3, gate = mat >> 4, db = mat & 15;
          const float* src = (gate ? F.wx : F.wa) + ((size_t)l * 16 + db) * 16384;
          bf16_t* dst = WSP(bf16_t, WS_LRUW) + (((size_t)l * 2 + (db >> 3)) * 2 + gate) * 8 * 16384 + (size_t)(db & 7) * 16384;
          transpose_item<64>(F, src, 128, 128, dst, nullptr, CmId(), (q >> 1) * 64, (q & 1) * 64); }
    }
}

__device__ __forceinline__ float wave_sum(float v) {
#pragma unroll
    for (int o = 32; o >= 1; o >>= 1) v += __shfl_xor(v, o);
    return v;
}
typedef unsigned int u32x2v __attribute__((__vector_size__(8)));
__device__ __forceinline__ __amdgpu_buffer_rsrc_t mk_rsrc(const void* p, size_t bytes) { return __builtin_amdgcn_make_buffer_rsrc((void*)p, (short)0, (int)bytes, 0x00020000); }
__device__ __forceinline__ f32x4 bld_f4(__amdgpu_buffer_rsrc_t r, unsigned vo, unsigned so) { const u32x4v v = __builtin_amdgcn_raw_buffer_load_b128(r, (int)vo, (int)so, 0); return __builtin_bit_cast(f32x4, v); }
__device__ __forceinline__ u32x2 bld_u2(__amdgpu_buffer_rsrc_t r, unsigned vo, unsigned so) { const u32x2v v = __builtin_amdgcn_raw_buffer_load_b64(r, (int)vo, (int)so, 0); return __builtin_bit_cast(u32x2, v); }
__device__ __forceinline__ void bst_f4(__amdgpu_buffer_rsrc_t r, unsigned vo, unsigned so, f32x4 x) { __builtin_amdgcn_raw_buffer_store_b128(__builtin_bit_cast(u32x4v, x), r, (int)vo, (int)so, 0); }
__device__ __forceinline__ void bst_u2(__amdgpu_buffer_rsrc_t r, unsigned vo, unsigned so, u32x2 x) { __builtin_amdgcn_raw_buffer_store_b64(__builtin_bit_cast(u32x2v, x), r, (int)vo, (int)so, 0); }
__device__ __forceinline__ void norm_phase(const Frame& F, int l, int row_lo, int row_hi, int blk0, int nblk) {
    if (F.bid < blk0 || F.bid >= blk0 + nblk || row_lo + (F.bid - blk0) * NWAVE >= row_hi) return;
    const float* MOD = WSP(float, WS_MOD);
    const __amdgpu_buffer_rsrc_t rZ = mk_rsrc(WSP(bf16_t, WS_Z), (size_t)T * DM * 2), rH = mk_rsrc(WSP(bf16_t, WS_H), (size_t)T * DM * 2);
    const __amdgpu_buffer_rsrc_t rXC = mk_rsrc(WSP(float, WS_XC), (size_t)CTX * DM * 4), rOut = mk_rsrc(F.out, (size_t)SEQ * DM * 4);
    const __amdgpu_buffer_rsrc_t rX = mk_rsrc(F.x, (size_t)SEQ * DM * 4), rCtx = mk_rsrc(F.ctx, (size_t)CTX * DM * 4);
    const unsigned vo = (unsigned)F.lane * 16u, vo2 = (unsigned)F.lane * 8u;
    LAS float* tab = (LAS float*)(F.lds + LDS_RING);
    { const int v_lo = (l == 0) ? 0 : (row_lo < CTX ? 1 : 0), v_hi = (l == 0) ? 1 : v_lo;
      for (int v = v_lo; v <= v_hi; ++v)
#pragma unroll
          for (int k = 0; k < 2; ++k) { const int c = (F.tid + NTHR * k) * 4;
              if (l < 2) { const f32x4 gp = *(const f32x4*)(F.g_pre + l * DM + c), sc = *(const f32x4*)(MOD + (size_t)(l * 2 + v) * 12288 + DM + c), sh = *(const f32x4*)(MOD + (size_t)(l * 2 + v) * 12288 + c);
                  *(LAS f32x4*)(tab + (v * 3 + 0) * DM + c) = gp * (sc + 1.f); *(LAS f32x4*)(tab + (v * 3 + 1) * DM + c) = sh; }
              if (l >= 1) { const f32x4 gt = *(const f32x4*)(MOD + (size_t)((l - 1) * 2 + v) * 12288 + 2 * DM + c), gq = *(const f32x4*)(F.g_post + (l - 1) * DM + c);
                  *(LAS f32x4*)(tab + (v * 3 + 2) * DM + c) = gt * gq; } } }
    __syncthreads();
    for (int row = row_lo + (F.bid - blk0) * NWAVE + F.wave; row < row_hi; row += nblk * NWAVE) {
        const bool is_ctx = row < CTX;
        const unsigned rr = (unsigned)(is_ctx ? row : row - CTX) * (unsigned)(DM * 4);
        const LAS float* tv = tab + (is_ctx ? 3 : 0) * DM + F.lane * 4;
        f32x4 xv[16];
        if (l <= 1) {
#pragma unroll
            for (int i = 0; i < 16; ++i) xv[i] = is_ctx ? bld_f4(rCtx, vo, rr + i * 1024u) : bld_f4(rX, vo, rr + i * 1024u);
        } else {
#pragma unroll
            for (int i = 0; i < 16; ++i) { if (is_ctx) xv[i] = bld_f4(rXC, vo, rr + i * 1024u);
                else { const u32x2 t = bld_u2(rOut, vo2, rr + i * 512u); xv[i] = (f32x4){bflo(t.x), bfhi(t.x), bflo(t.y), bfhi(t.y)}; } }
        }
        if (l >= 1) {
            u32x2 zzv[16]; const unsigned zo = (unsigned)row * (unsigned)(DM * 2);
            const float st2v = WSP(float, WS_ST2)[(size_t)row * 64 + F.lane];
#pragma unroll
            for (int i = 0; i < 16; ++i) zzv[i] = bld_u2(rZ, vo2, zo + i * 512u);
            const float rstd_z = rsqrtf(wave_sum(st2v) * (1.f / DM) + EPS);
#pragma unroll
            for (int i = 0; i < 16; ++i) {
                const u32x2 zz = zzv[i]; const f32x4 g4 = *(const LAS f32x4*)(tv + 2 * DM + i * 256);
                xv[i][0] += g4[0] * (bflo(zz.x) * rstd_z); xv[i][1] += g4[1] * (bfhi(zz.x) * rstd_z);
                xv[i][2] += g4[2] * (bflo(zz.y) * rstd_z); xv[i][3] += g4[3] * (bfhi(zz.y) * rstd_z);
                if (is_ctx) bst_f4(rXC, vo, rr + i * 1024u, xv[i]);
                else if (l == 1) { u32x2 w; w.x = cvt_pk_bf16(xv[i][0], xv[i][1]); w.y = cvt_pk_bf16(xv[i][2], xv[i][3]); bst_u2(rOut, vo2, rr + i * 512u, w); }
                else bst_f4(rOut, vo, rr + i * 1024u, xv[i]); }
        }
        if (l < 2) {
            float ss = 0.f;
#pragma unroll
            for (int i = 0; i < 16; ++i) ss += dot4(xv[i]);
            const float rstd = rsqrtf(wave_sum(ss) * (1.f / DM) + EPS);
            const unsigned ho = (unsigned)row * (unsigned)(DM * 2);
#pragma unroll
            for (int i = 0; i < 16; ++i) {
                const f32x4 a4 = *(const LAS f32x4*)(tv + i * 256), b4 = *(const LAS f32x4*)(tv + DM + i * 256);
                const float h0 = xv[i][0] * rstd * a4[0] + b4[0], h1 = xv[i][1] * rstd * a4[1] + b4[1];
                const float h2 = xv[i][2] * rstd * a4[2] + b4[2], h3 = xv[i][3] * rstd * a4[3] + b4[3];
                u32x2 w; w.x = cvt_pk_bf16(h0, h1); w.y = cvt_pk_bf16(h2, h3); bst_u2(rH, vo2, ho + i * 512u, w); }
        }
    }
    __syncthreads();
}

#define SBAR() __builtin_amdgcn_sched_barrier(0)
__device__ __forceinline__ int crow(int r, int hi) { return (r & 3) + 8 * (r >> 2) + 4 * hi; }
__device__ __forceinline__ int v_st(int k, int c) { const int kk = (k & ~0xC) | ((k & 4) << 1) | ((k & 8) >> 1); return ((kk >> 3) * 4 + (c >> 5)) * 512 + ((kk & 7) * 32 + (c & 31)) * 2; }
__device__ __forceinline__ int v_rd_base(int lane) { return ((lane & 3) << 3) | (((lane >> 2) & 3) << 6) | (((lane >> 4) & 1) << 5) | (((lane >> 5) & 1) << 8); }
constexpr int v_rd_off(int d0, int ks, int half) { return d0 * 512 + ks * 4096 + half * 2048; }
template <int OFF> __device__ __forceinline__ s16x4 tr_read(int vb) {
    s16x4 r; asm volatile("ds_read_b64_tr_b16 %0, %1 offset:%2" : "=&v"(r) : "v"(vb), "i"(OFF) : "memory"); return r;
}
template <int S> __device__ __forceinline__ void pv_rd(int vb, s16x4& a, s16x4& b, s16x4& c, s16x4& d) {
    a = tr_read<v_rd_off(S >> 1, 2 * (S & 1), 0)>(vb); b = tr_read<v_rd_off(S >> 1, 2 * (S & 1), 1)>(vb);
    c = tr_read<v_rd_off(S >> 1, 2 * (S & 1) + 1, 0)>(vb); d = tr_read<v_rd_off(S >> 1, 2 * (S & 1) + 1, 1)>(vb);
}
#define PVPK(L, H) (bf16x8){L[0], L[1], L[2], L[3], H[0], H[1], H[2], H[3]}
#define PV_STEP(S, OD, PA, PB, CA, CB, CC, CD, NA, NB, NC, ND_) do { if (S < 7) pv_rd<(S < 7 ? S + 1 : 7)>(vb, NA, NB, NC, ND_); \
    if (S < 7) asm volatile("s_waitcnt lgkmcnt(4)" : "+v"(CA), "+v"(CB), "+v"(CC), "+v"(CD) :: "memory"); else asm volatile("s_waitcnt lgkmcnt(0)" : "+v"(CA), "+v"(CB), "+v"(CC), "+v"(CD) :: "memory"); \
    OD = __builtin_amdgcn_mfma_f32_32x32x16_bf16(PVPK(CA, CB), PA, OD, 0, 0, 0); OD = __builtin_amdgcn_mfma_f32_32x32x16_bf16(PVPK(CC, CD), PB, OD, 0, 0, 0); } while (0)
__device__ __forceinline__ void pv_d0(f32x16* o, int vb, bf16x8 pa0, bf16x8 pa1, bf16x8 pa2, bf16x8 pa3) {
    s16x4 a0, b0, c0, d0, a1, b1, c1, d1;
    pv_rd<0>(vb, a0, b0, c0, d0);
    PV_STEP(0, o[0], pa0, pa1, a0, b0, c0, d0, a1, b1, c1, d1);
    PV_STEP(1, o[0], pa2, pa3, a1, b1, c1, d1, a0, b0, c0, d0);
    PV_STEP(2, o[1], pa0, pa1, a0, b0, c0, d0, a1, b1, c1, d1);
    PV_STEP(3, o[1], pa2, pa3, a1, b1, c1, d1, a0, b0, c0, d0);
    PV_STEP(4, o[2], pa0, pa1, a0, b0, c0, d0, a1, b1, c1, d1);
    PV_STEP(5, o[2], pa2, pa3, a1, b1, c1, d1, a0, b0, c0, d0);
    PV_STEP(6, o[3], pa0, pa1, a0, b0, c0, d0, a1, b1, c1, d1);
    PV_STEP(7, o[3], pa2, pa3, a1, b1, c1, d1, a0, b0, c0, d0);
}
#undef PV_STEP
#undef PVPK
constexpr float THR2 = 11.5415603f;
template <int ABL = 0>
__device__ __forceinline__ void partialSM(f32x16& p0, f32x16& p1, float& m_reg, float& alpha) {
    if (ABL == 1) { alpha = 1.f; return; }
    float pmax = p0[0];
#pragma unroll
    for (int r = 1; r < 16; ++r) pmax = fmaxf(pmax, p0[r]);
#pragma unroll
    for (int r = 0; r < 16; ++r) pmax = fmaxf(pmax, p1[r]);
    { auto rr = __builtin_amdgcn_permlane32_swap(__float_as_uint(pmax), __float_as_uint(pmax), false, false);
      pmax = fmaxf(__uint_as_float(rr[0]), __uint_as_float(rr[1])); }
    if (__builtin_expect(__all(pmax <= THR2), 1)) { alpha = 1.f; }
    else { const float sh = fmaxf(pmax, 0.f); alpha = __builtin_amdgcn_exp2f(-sh); m_reg += sh;
#pragma unroll
        for (int r = 0; r < 16; ++r) { p0[r] -= sh; p1[r] -= sh; } }
#pragma unroll
    for (int r = 0; r < 16; ++r) p0[r] = __builtin_amdgcn_exp2f(p0[r]);
}
template <int ABL = 0>
__device__ __forceinline__ void finishSM(f32x16& p0, f32x16& p1, float alpha, float& l_reg, bf16x8& pa0, bf16x8& pa1, bf16x8& pa2, bf16x8& pa3) {
    if (ABL != 1) {
#pragma unroll
    for (int r = 0; r < 16; ++r) p1[r] = __builtin_amdgcn_exp2f(p1[r]); }
    float ps = 0;
    if (ABL != 1) {
#pragma unroll
    for (int r = 0; r < 16; ++r) ps += p0[r];
#pragma unroll
    for (int r = 0; r < 16; ++r) ps += p1[r]; }
    { auto rr = __builtin_amdgcn_permlane32_swap(__float_as_uint(ps), __float_as_uint(ps), false, false);
      ps = __uint_as_float(rr[0]) + __uint_as_float(rr[1]); }
    l_reg = l_reg * alpha + ps;
#define PK4(P, BASE, OUT) do { unsigned a0 = cvt_pk_bf16(P[BASE + 0], P[BASE + 1]), a1 = cvt_pk_bf16(P[BASE + 2], P[BASE + 3]);   \
    unsigned b0 = cvt_pk_bf16(P[BASE + 4], P[BASE + 5]), b1 = cvt_pk_bf16(P[BASE + 6], P[BASE + 7]);                              \
    auto r0 = __builtin_amdgcn_permlane32_swap(a0, b0, false, false); auto r1 = __builtin_amdgcn_permlane32_swap(a1, b1, false, false); \
    u32x4 w = {r0[0], r1[0], r0[1], r1[1]}; OUT = *reinterpret_cast<bf16x8*>(&w); } while (0)
    PK4(p0, 0, pa0); PK4(p0, 8, pa1); PK4(p1, 0, pa2); PK4(p1, 8, pa3);
#undef PK4
}

template <int N> __device__ __forceinline__ void sg_rmv() { if constexpr (N > 0) { __builtin_amdgcn_sched_group_barrier(0x008, 2, 0); __builtin_amdgcn_sched_group_barrier(0x100, 2, 0); sg_rmv<N - 1>(); } }
template <int N> __device__ __forceinline__ void sg_mv() { if constexpr (N > 0) { __builtin_amdgcn_sched_group_barrier(0x008, 2, 0); sg_mv<N - 1>(); } }
struct TsDense { __device__ __forceinline__ int row(int j) const { return 64 * j; } __device__ __forceinline__ int tok(int) const { return 0; } __device__ __forceinline__ bool masked(int) const { return false; } };
struct TsSwa {
    int tb;
    __device__ __forceinline__ int tok(int j) const { return tb + 64 * j; }
    __device__ __forceinline__ bool masked(int j) const { return j < 5 && (j == 0 || j == 4 || tb + 64 * j < 0 || tb + 64 * j + 64 > SEQ); }
    __device__ __forceinline__ int row(int j) const { if (j >= 5) return 64 * (j - 5); int t = tb + 64 * j; t = t < 0 ? 0 : (t > SEQ - 64 ? SEQ - 64 : t); return CTX + t; }
};

__device__ __forceinline__ bf16x8 buf_ld16(__amdgpu_buffer_rsrc_t rs, unsigned voff, unsigned soff) { const u32x4v v = __builtin_amdgcn_raw_buffer_load_b128(rs, (int)voff, (int)soff, 0); return __builtin_bit_cast(bf16x8, v); }
#ifndef ABL_KIND
#define ABL_KIND 0
#endif

constexpr int TLD = 136;
__device__ __forceinline__ bf16x8 frag_kc(const LAS bf16_t* base, int ld, int idx0, int k0, int lane) {
    return *(const LAS bf16x8*)(base + (idx0 + (lane & 15)) * ld + k0 + 8 * (lane >> 4));
}
struct TrFrag { s16x4 lo, hi; };
__device__ __forceinline__ void frag_tr_issue(TrFrag& f, const LAS bf16_t* base, int ld, int idx0, int k0, int lane) {
    const int g = lane >> 4, i = lane & 15, q = i >> 2, p = i & 3;
    const int a = (int)(uintptr_t)(base + (k0 + 8 * g + q) * ld + idx0 + 4 * p);
    asm volatile("ds_read_b64_tr_b16 %0, %1" : "=&v"(f.lo) : "v"(a) : "memory");
    asm volatile("ds_read_b64_tr_b16 %0, %1" : "=&v"(f.hi) : "v"(a + 4 * ld * 2) : "memory");
}
__device__ __forceinline__ void frag_tr_issue_p(TrFrag& f, const LAS bf16_t* base, int ld, int idx32, int nn, int k0, int lane) {
    const int g = lane >> 4, i = lane & 15, q = i >> 2, p = i & 3;
    const int a = (int)(uintptr_t)(base + (k0 + 8 * g + q) * ld + idx32 + 8 * p + 4 * nn);
    asm volatile("ds_read_b64_tr_b16 %0, %1" : "=&v"(f.lo) : "v"(a) : "memory");
    asm volatile("ds_read_b64_tr_b16 %0, %1" : "=&v"(f.hi) : "v"(a + 4 * ld * 2) : "memory");
}
#define TRGET(f) ((bf16x8){(f).lo[0], (f).lo[1], (f).lo[2], (f).lo[3], (f).hi[0], (f).hi[1], (f).hi[2], (f).hi[3]})
#define LDS_WAIT(n) asm volatile("s_waitcnt lgkmcnt(" #n ")" ::: "memory")
__device__ __forceinline__ void load_tile128(LAS bf16_t* dst, const bf16_t* __restrict__ src, size_t ld, int tid) {
#pragma unroll
    for (int i = 0; i < 4; ++i) { const int idx = tid + NTHR * i, r = idx >> 4, oc = idx & 15;
        *(LAS bf16x8*)(dst + r * TLD + oc * 8) = *(const bf16x8*)(src + (size_t)r * ld + oc * 8); }
}
__device__ __forceinline__ float wave_scan_add(float v, int lane) {
#pragma unroll
    for (int o = 1; o < 64; o <<= 1) { const float t = __shfl_up(v, o); if (lane >= o) v += t; }
    return v;
}
__device__ __forceinline__ float wave_scan_max(float v, int lane) {
#pragma unroll
    for (int o = 1; o < 64; o <<= 1) { const float t = __shfl_up(v, o); if (lane >= o) v = fmaxf(v, t); }
    return v;
}
__device__ __forceinline__ float wave_max(float v) {
#pragma unroll
    for (int o = 32; o >= 1; o >>= 1) v = fmaxf(v, __shfl_xor(v, o));
    return v;
}
__device__ __forceinline__ int chunk_at(int dir, int s) { return dir == 0 ? s : (s == 0 ? 1 : (s == 1 ? 0 : 131 - s)); }

constexpr int XLD = 68;
constexpr size_t WS_LH = WS_Z, WS_LA = WS_Z + (size_t)2 * T * 1024 * 2;
__device__ __forceinline__ float fast_sigmoid(float x) { return __builtin_amdgcn_rcpf(1.f + __expf(-x)); }
__device__ __forceinline__ float one_minus_sq(float la, float a) {
    const float x = 2.f * la;
    const float p = -x * (1.f + x * 0.5f * (1.f + x * (1.f / 3.f) * (1.f + x * 0.25f * (1.f + x * 0.2f))));
    return x < -0.25f ? 1.f - a * a : p;
}
#define LRU_F8(CTL) \
    "s_nop 4\n" \
    "v_fmac_f32_dpp %0, %0, %8 " CTL " row_mask:0xf bank_mask:0xf\n" "v_fmac_f32_dpp %1, %1, %9 " CTL " row_mask:0xf bank_mask:0xf\n" \
    "v_fmac_f32_dpp %2, %2, %10 " CTL " row_mask:0xf bank_mask:0xf\n" "v_fmac_f32_dpp %3, %3, %11 " CTL " row_mask:0xf bank_mask:0xf\n" \
    "v_fmac_f32_dpp %4, %4, %12 " CTL " row_mask:0xf bank_mask:0xf\n" "v_fmac_f32_dpp %5, %5, %13 " CTL " row_mask:0xf bank_mask:0xf\n" \
    "v_fmac_f32_dpp %6, %6, %14 " CTL " row_mask:0xf bank_mask:0xf\n" "v_fmac_f32_dpp %7, %7, %15 " CTL " row_mask:0xf bank_mask:0xf\n" \
    "v_mul_f32_dpp %8, %8, %8 " CTL " row_mask:0xf bank_mask:0xf\n" "v_mul_f32_dpp %9, %9, %9 " CTL " row_mask:0xf bank_mask:0xf\n" \
    "v_mul_f32_dpp %10, %10, %10 " CTL " row_mask:0xf bank_mask:0xf\n" "v_mul_f32_dpp %11, %11, %11 " CTL " row_mask:0xf bank_mask:0xf\n" \
    "v_mul_f32_dpp %12, %12, %12 " CTL " row_mask:0xf bank_mask:0xf\n" "v_mul_f32_dpp %13, %13, %13 " CTL " row_mask:0xf bank_mask:0xf\n" \
    "v_mul_f32_dpp %14, %14, %14 " CTL " row_mask:0xf bank_mask:0xf\n" "v_mul_f32_dpp %15, %15, %15 " CTL " row_mask:0xf bank_mask:0xf\n"
#define LRU_STEP8(CTL, A, B) asm volatile(LRU_F8(CTL) : "+v"(B[0]), "+v"(B[1]), "+v"(B[2]), "+v"(B[3]), "+v"(B[4]), "+v"(B[5]), "+v"(B[6]), "+v"(B[7]), \
                                                         "+v"(A[0]), "+v"(A[1]), "+v"(A[2]), "+v"(A[3]), "+v"(A[4]), "+v"(A[5]), "+v"(A[6]), "+v"(A[7]))
template <int DIR> __device__ __forceinline__ void lru_row_scan8(float (&A)[8], float (&B)[8]) {
    if (DIR == 0) { LRU_STEP8("row_shr:1", A, B); LRU_STEP8("row_shr:2", A, B); LRU_STEP8("row_shr:4", A, B); LRU_STEP8("row_shr:8", A, B); }
    else          { LRU_STEP8("row_shl:1", A, B); LRU_STEP8("row_shl:2", A, B); LRU_STEP8("row_shl:4", A, B); LRU_STEP8("row_shl:8", A, B); }
}
#define LRU_C8(CTL) \
    "s_nop 4\n" \
    "v_fmac_f32_dpp %0, %16, %8 " CTL " row_mask:0xf bank_mask:0xf\n" "v_fmac_f32_dpp %1, %17, %9 " CTL " row_mask:0xf bank_mask:0xf\n" \
    "v_fmac_f32_dpp %2, %18, %10 " CTL " row_mask:0xf bank_mask:0xf\n" "v_fmac_f32_dpp %3, %19, %11 " CTL " row_mask:0xf bank_mask:0xf\n" \
    "v_fmac_f32_dpp %4, %20, %12 " CTL " row_mask:0xf bank_mask:0xf\n" "v_fmac_f32_dpp %5, %21, %13 " CTL " row_mask:0xf bank_mask:0xf\n" \
    "v_fmac_f32_dpp %6, %22, %14 " CTL " row_mask:0xf bank_mask:0xf\n" "v_fmac_f32_dpp %7, %23, %15 " CTL " row_mask:0xf bank_mask:0xf\n" \
    "v_mul_f32_dpp %8, %24, %8 " CTL " row_mask:0xf bank_mask:0xf\n" "v_mul_f32_dpp %9, %25, %9 " CTL " row_mask:0xf bank_mask:0xf\n" \
    "v_mul_f32_dpp %10, %26, %10 " CTL " row_mask:0xf bank_mask:0xf\n" "v_mul_f32_dpp %11, %27, %11 " CTL " row_mask:0xf bank_mask:0xf\n" \
    "v_mul_f32_dpp %12, %28, %12 " CTL " row_mask:0xf bank_mask:0xf\n" "v_mul_f32_dpp %13, %29, %13 " CTL " row_mask:0xf bank_mask:0xf\n" \
    "v_mul_f32_dpp %14, %30, %14 " CTL " row_mask:0xf bank_mask:0xf\n" "v_mul_f32_dpp %15, %31, %15 " CTL " row_mask:0xf bank_mask:0xf\n"
#define LRU_CARRY8(CTL, As, Bs, Af, Bf) asm volatile(LRU_C8(CTL) : "+v"(Bs[0]), "+v"(Bs[1]), "+v"(Bs[2]), "+v"(Bs[3]), "+v"(Bs[4]), "+v"(Bs[5]), "+v"(Bs[6]), "+v"(Bs[7]), \
        "+v"(As[0]), "+v"(As[1]), "+v"(As[2]), "+v"(As[3]), "+v"(As[4]), "+v"(As[5]), "+v"(As[6]), "+v"(As[7]) \
        : "v"(Bf[0]), "v"(Bf[1]), "v"(Bf[2]), "v"(Bf[3]), "v"(Bf[4]), "v"(Bf[5]), "v"(Bf[6]), "v"(Bf[7]), "v"(Af[0]), "v"(Af[1]), "v"(Af[2]), "v"(Af[3]), "v"(Af[4]), "v"(Af[5]), "v"(Af[6]), "v"(Af[7]))
template <int DIR>
__device__ __forceinline__ void lru_dir(const Frame& F, int n, int blk, int hf, const LAS bf16_t* Ub, const LAS bf16_t* Wl, LAS float* seg, const LAS float* par, int wr, int wc, int li, int lq, int lane) {
    constexpr int dir = DIR;
    LAS float* segA = seg + dir * 512; LAS float* segH = segA + 256;
    const LAS bf16_t* Wa = Wl + (dir * 2 + 0) * 64 * TLD; const LAS bf16_t* Wx = Wl + (dir * 2 + 1) * 64 * TLD;
    f32x4 ar[2][2], ai[2][2];
#pragma unroll
    for (int m = 0; m < 2; ++m)
#pragma unroll
        for (int nn = 0; nn < 2; ++nn) { ar[m][nn] = (f32x4){0.f, 0.f, 0.f, 0.f}; ai[m][nn] = (f32x4){0.f, 0.f, 0.f, 0.f}; }
#pragma unroll
    for (int ks = 0; ks < 4; ++ks) {
        bf16x8 fu[2], fa[1][2], fx[1][2];
#pragma unroll
        for (int nn = 0; nn < 2; ++nn) { fa[0][nn] = frag_kc(Wa, TLD, 32 * wc + 16 * nn, 32 * ks, lane); fx[0][nn] = frag_kc(Wx, TLD, 32 * wc + 16 * nn, 32 * ks, lane); }
#pragma unroll
        for (int m = 0; m < 2; ++m) fu[m] = frag_kc(Ub, TLD, 32 * wr + 16 * m, 32 * ks, lane);
#pragma unroll
        for (int m = 0; m < 2; ++m)
#pragma unroll
            for (int nn = 0; nn < 2; ++nn) { ar[m][nn] = __builtin_amdgcn_mfma_f32_16x16x32_bf16(fa[0][nn], fu[m], ar[m][nn], 0, 0, 0);
                                             ai[m][nn] = __builtin_amdgcn_mfma_f32_16x16x32_bf16(fx[0][nn], fu[m], ai[m][nn], 0, 0, 0); }
    }
    float A[2][8], B[2][8];
#pragma unroll
    for (int m = 0; m < 2; ++m)
#pragma unroll
        for (int nn = 0; nn < 2; ++nn) { const int tt = 32 * wr + 16 * m + li, chb = 32 * wc + 16 * nn + 4 * lq;
            const u32x2 uu = *(const LAS u32x2*)(Ub + tt * TLD + hf * 64 + chb); const float u4[4] = {bflo(uu.x), bfhi(uu.x), bflo(uu.y), bfhi(uu.y)};
            const f32x4 pa = *(const LAS f32x4*)(par + 128 + dir * 64 + chb), px = *(const LAS f32x4*)(par + 256 + dir * 64 + chb), ps = *(const LAS f32x4*)(par + dir * 64 + chb);
#pragma unroll
            for (int e = 0; e < 4; e += 2) {
                const f32x2 xa = {ar[m][nn][e], ar[m][nn][e + 1]}, xi = {ai[m][nn][e], ai[m][nn][e + 1]};
                const f32x2 ta = xa * (-LOG2E) + (f32x2){pa[e], pa[e + 1]}, ti = xi * (-LOG2E) + (f32x2){px[e], px[e + 1]};
                const f32x2 da = (f32x2){__builtin_amdgcn_exp2f(ta[0]), __builtin_amdgcn_exp2f(ta[1])} + 1.f, di = (f32x2){__builtin_amdgcn_exp2f(ti[0]), __builtin_amdgcn_exp2f(ti[1])} + 1.f;
                const f32x2 r = {__builtin_amdgcn_rcpf(da[0]), __builtin_amdgcn_rcpf(da[1])}, ig = {__builtin_amdgcn_rcpf(di[0]), __builtin_amdgcn_rcpf(di[1])};
                const f32x2 l2 = r * (f32x2){ps[e], ps[e + 1]};
                const f32x2 a_ = {__builtin_amdgcn_exp2f(l2[0]), __builtin_amdgcn_exp2f(l2[1])};
                const f32x2 x = l2 * 1.3862943611198906f;
                f32x2 t = x * (1.f / 24.f) + (1.f / 6.f); t = x * t + 0.5f; t = x * t + 1.f;
                const f32x2 p = -x * t, d = 1.f - a_ * a_;
                const float o0 = x[0] < -0.0625f ? d[0] : p[0], o1 = x[1] < -0.0625f ? d[1] : p[1];
                const f32x2 sq = {__builtin_amdgcn_sqrtf(fmaxf(o0, 0.f)), __builtin_amdgcn_sqrtf(fmaxf(o1, 0.f))};
                const f32x2 b_ = sq * (ig * (f32x2){u4[e], u4[e + 1]});
                A[m][4 * nn + e] = a_[0]; A[m][4 * nn + e + 1] = a_[1]; B[m][4 * nn + e] = b_[0]; B[m][4 * nn + e + 1] = b_[1]; } }
    lru_row_scan8<DIR>(A[0], B[0]); lru_row_scan8<DIR>(A[1], B[1]);
    constexpr int mf = DIR ? 1 : 0, ms = 1 - mf, last = DIR ? 0 : 15;
    if (DIR == 0) LRU_CARRY8("row_newbcast:15", A[ms], B[ms], A[mf], B[mf]); else LRU_CARRY8("row_newbcast:0", A[ms], B[ms], A[mf], B[mf]);
    if (li == last) {
#pragma unroll
        for (int nn = 0; nn < 2; ++nn) { const int chb = 32 * wc + 16 * nn + 4 * lq;
            *(LAS f32x4*)(segA + wr * 64 + chb) = (f32x4){A[ms][4 * nn], A[ms][4 * nn + 1], A[ms][4 * nn + 2], A[ms][4 * nn + 3]};
            *(LAS f32x4*)(segH + wr * 64 + chb) = (f32x4){B[ms][4 * nn], B[ms][4 * nn + 1], B[ms][4 * nn + 2], B[ms][4 * nn + 3]}; } }
    __syncthreads();
    const int pos = DIR ? 3 - wr : wr;
    f32x4 c[2], Pp[2];
#pragma unroll
    for (int nn = 0; nn < 2; ++nn) { c[nn] = (f32x4){0.f, 0.f, 0.f, 0.f}; Pp[nn] = (f32x4){1.f, 1.f, 1.f, 1.f}; }
    for (int s2 = 0; s2 < pos; ++s2) { const int w2 = DIR ? 3 - s2 : s2;
#pragma unroll
        for (int nn = 0; nn < 2; ++nn) { const int chb = 32 * wc + 16 * nn + 4 * lq; const f32x4 a = *(const LAS f32x4*)(segA + w2 * 64 + chb), h = *(const LAS f32x4*)(segH + w2 * 64 + chb);
            c[nn] = a * c[nn] + h; Pp[nn] = Pp[nn] * a; } }
    const size_t r0 = (size_t)n * 128;
    if (pos == 3 && li == last) {
        float* LS = WSP(float, WS_LSUM) + (((size_t)n * 2 + dir) * 2) * 1024 + blk * 128 + hf * 64;
#pragma unroll
        for (int nn = 0; nn < 2; ++nn) { const int chb = 32 * wc + 16 * nn + 4 * lq; f32x4 ta, th;
#pragma unroll
            for (int e = 0; e < 4; ++e) { ta[e] = Pp[nn][e] * A[ms][4 * nn + e]; th[e] = A[ms][4 * nn + e] * c[nn][e] + B[ms][4 * nn + e]; }
            *(f32x4*)(LS + chb) = ta; *(f32x4*)(LS + 1024 + chb) = th; } }
#pragma unroll
    for (int m = 0; m < 2; ++m)
#pragma unroll
        for (int nn = 0; nn < 2; ++nn) { const int tt = 32 * wr + 16 * m + li, chb = 32 * wc + 16 * nn + 4 * lq;
            const size_t go = ((size_t)dir * T + r0 + tt) * 1024 + blk * 128 + hf * 64 + chb;
            u32x2 hw, aw;
            const float* Am = A[m] + 4 * nn; const float* Bm = B[m] + 4 * nn;
            hw.x = cvt_pk_bf16(Bm[0] + Am[0] * c[nn][0], Bm[1] + Am[1] * c[nn][1]); hw.y = cvt_pk_bf16(Bm[2] + Am[2] * c[nn][2], Bm[3] + Am[3] * c[nn][3]);
            aw.x = cvt_pk_bf16(Am[0] * Pp[nn][0], Am[1] * Pp[nn][1]); aw.y = cvt_pk_bf16(Am[2] * Pp[nn][2], Am[3] * Pp[nn][3]);
            *(u32x2*)(WSP(bf16_t, WS_LH) + go) = hw; *(u32x2*)(WSP(bf16_t, WS_LA) + go) = aw; }
}
struct LruIn { u32x4 v[7]; };
__device__ __forceinline__ void lru_in_issue(LruIn& X, const Frame& F, int item, int tid, bool live) {
    const int n = item >> 4, blk = (item >> 1) & 7, oc = tid & 15, tq = tid >> 4, c0 = blk * 128 + oc * 8;
    const int r0 = n * 128, seg_lo = (n < 2) ? 0 : CTX, seg_hi = (n < 2) ? CTX : T;
    const bf16_t* P = WSP(bf16_t, WS_P);
#pragma unroll
    for (int q = 0; q < 7; ++q) { const int r = r0 + tq * 4 - 2 + q;
        u32x4 v = {0u, 0u, 0u, 0u}; if (live && r >= seg_lo && r < seg_hi) v = *(const u32x4*)(P + (size_t)r * PW + S_LRU_U + c0); X.v[q] = v; }
}
__device__ __forceinline__ void lru_conv(const LruIn& X, LAS bf16_t* Ub, const LAS float* cw, int tid) {
    const int oc = tid & 15, tq = tid >> 4;
    float w[4][8], bb[8];
#pragma unroll
    for (int j = 0; j < 4; ++j) { const f32x4 a = *(const LAS f32x4*)(cw + j * 128 + oc * 8), b = *(const LAS f32x4*)(cw + j * 128 + oc * 8 + 4);
        w[j][0] = a[0]; w[j][1] = a[1]; w[j][2] = a[2]; w[j][3] = a[3]; w[j][4] = b[0]; w[j][5] = b[1]; w[j][6] = b[2]; w[j][7] = b[3]; }
    { const f32x4 a = *(const LAS f32x4*)(cw + 512 + oc * 8), b = *(const LAS f32x4*)(cw + 512 + oc * 8 + 4);
        bb[0] = a[0]; bb[1] = a[1]; bb[2] = a[2]; bb[3] = a[3]; bb[4] = b[0]; bb[5] = b[1]; bb[6] = b[2]; bb[7] = b[3]; }
    float xin[7][8];
#pragma unroll
    for (int q = 0; q < 7; ++q) { const u32x4 v = X.v[q];
        xin[q][0] = bflo(v.x); xin[q][1] = bfhi(v.x); xin[q][2] = bflo(v.y); xin[q][3] = bfhi(v.y); xin[q][4] = bflo(v.z); xin[q][5] = bfhi(v.z); xin[q][6] = bflo(v.w); xin[q][7] = bfhi(v.w); }
#pragma unroll
    for (int t4 = 0; t4 < 4; ++t4) { float o[8];
#pragma unroll
        for (int e = 0; e < 8; ++e) o[e] = bb[e] + w[0][e] * xin[t4][e] + w[1][e] * xin[t4 + 1][e] + w[2][e] * xin[t4 + 2][e] + w[3][e] * xin[t4 + 3][e];
        u32x4 pk; pk.x = cvt_pk_bf16(o[0], o[1]); pk.y = cvt_pk_bf16(o[2], o[3]); pk.z = cvt_pk_bf16(o[4], o[5]); pk.w = cvt_pk_bf16(o[6], o[7]);
        *(LAS u32x4*)(Ub + (tq * 4 + t4) * TLD + oc * 8) = pk; }
}
__device__ __forceinline__ void lru_loop(const Frame& F, int l, int it0) {
    if (it0 >= NCH * 16) return;
    const int blk = (it0 >> 1) & 7, hf = it0 & 1;
    LAS bf16_t* Ub0 = (LAS bf16_t*)(F.lds + LDS_RING);
    LAS bf16_t* Wl = Ub0 + 2 * 128 * TLD;
    LAS float* segA = (LAS float*)(Wl + 4 * 64 * TLD);
    LAS float* par = segA + 1024;
    LAS float* cw = par + 384;
    LruIn X0; lru_in_issue(X0, F, it0, F.tid, true);
    { const int tid = F.tid;
      if (tid < 128) { const int d = tid >> 6, ch = tid & 63, gc = blk * 128 + hf * 64 + ch;
          par[d * 64 + ch] = -8.f * LOG2E * softplusf_(-F.lam[(l * 2 + d) * 1024 + gc]);
          par[128 + d * 64 + ch] = -LOG2E * F.ba[(l * 2 + d) * 1024 + gc]; par[256 + d * 64 + ch] = -LOG2E * F.bx[(l * 2 + d) * 1024 + gc]; }
      if (tid >= 128 && tid < 128 + 160) { const int i = tid - 128, j = i >> 5, c4 = (i & 31) * 4;
          *(LAS f32x4*)(cw + j * 128 + c4) = (j < 4) ? *(const f32x4*)(F.conv_w + ((size_t)l * 4 + j) * 1024 + blk * 128 + c4) : *(const f32x4*)(F.conv_b + l * 1024 + blk * 128 + c4); }
#pragma unroll
      for (int i = 0; i < 8; ++i) { const int idx = tid + NTHR * i, mat = idx >> 10, row = (idx >> 4) & 63, oc = idx & 15;
          const bf16_t* W = WSP(bf16_t, WS_LRUW) + ((((size_t)l * 2 + (mat >> 1)) * 2 + (mat & 1)) * 8 + blk) * 16384;
          *(LAS bf16x8*)(Wl + (mat * 64 + row) * TLD + oc * 8) = *(const bf16x8*)(W + (hf * 64 + row) * 128 + oc * 8); } }
    __syncthreads();
    lru_conv(X0, Ub0, cw, F.tid);
    __syncthreads();
    int cur = 0;
#pragma unroll 1
    for (int item = it0; item < NCH * 16; item += F.G) {
        int tz_ = F.tid; asm volatile("" : "+v"(tz_));
        const int tid = tz_, lane = tz_ & 63, wave = F.wave, n = item >> 4;
        const bool has_next = item + F.G < NCH * 16;
        LruIn X; lru_in_issue(X, F, has_next ? item + F.G : item, tid, has_next);
        const int wr = wave >> 1, wc = wave & 1, li = lane & 15, lq = lane >> 4;
        const LAS bf16_t* Ub = Ub0 + cur * 128 * TLD;
        lru_dir<0>(F, n, blk, hf, Ub, Wl, segA, par, wr, wc, li, lq, lane);
        lru_dir<1>(F, n, blk, hf, Ub, Wl, segA, par, wr, wc, li, lq, lane);
        if (has_next) lru_conv(X, Ub0 + (cur ^ 1) * 128 * TLD, cw, tid);
        __syncthreads();
        cur ^= 1;
    }
}
struct LruOutIn { u32x4 hf_, af_, hb_, ab_, gt_; f32x4 cf0, cf1, cb0, cb1; int row, c0; };
__device__ __forceinline__ void lru_out_load(LruOutIn& I, const Frame& F, long i, int row_lo) {
    const bf16_t* P = WSP(bf16_t, WS_P); const bf16_t* LH = WSP(bf16_t, WS_LH); const bf16_t* LA = WSP(bf16_t, WS_LA); const float* LC = WSP(float, WS_LCAR);
    const int row = row_lo + (int)(i >> 7), c0 = (int)(i & 127) * 8, n = row >> 7; I.row = row; I.c0 = c0;
    I.hf_ = *(const u32x4*)(LH + (size_t)row * 1024 + c0); I.af_ = *(const u32x4*)(LA + (size_t)row * 1024 + c0);
    I.hb_ = *(const u32x4*)(LH + ((size_t)T + row) * 1024 + c0); I.ab_ = *(const u32x4*)(LA + ((size_t)T + row) * 1024 + c0);
    I.gt_ = *(const u32x4*)(P + (size_t)row * PW + S_LRU_G + c0);
    I.cf0 = *(const f32x4*)(LC + ((size_t)n * 2 + 0) * 1024 + c0); I.cf1 = *(const f32x4*)(LC + ((size_t)n * 2 + 0) * 1024 + c0 + 4);
    I.cb0 = *(const f32x4*)(LC + ((size_t)n * 2 + 1) * 1024 + c0); I.cb1 = *(const f32x4*)(LC + ((size_t)n * 2 + 1) * 1024 + c0 + 4);
}
__device__ __forceinline__ void lru_out_store(const LruOutIn& I, const Frame& F) {
    bf16_t* Y = WSP(bf16_t, WS_Y);
    const unsigned hw[4] = {I.hf_.x, I.hf_.y, I.hf_.z, I.hf_.w}, aw[4] = {I.af_.x, I.af_.y, I.af_.z, I.af_.w}, hbw[4] = {I.hb_.x, I.hb_.y, I.hb_.z, I.hb_.w}, abw[4] = {I.ab_.x, I.ab_.y, I.ab_.z, I.ab_.w}, gw[4] = {I.gt_.x, I.gt_.y, I.gt_.z, I.gt_.w};
    const float cf[8] = {I.cf0[0], I.cf0[1], I.cf0[2], I.cf0[3], I.cf1[0], I.cf1[1], I.cf1[2], I.cf1[3]}, cb[8] = {I.cb0[0], I.cb0[1], I.cb0[2], I.cb0[3], I.cb1[0], I.cb1[1], I.cb1[2], I.cb1[3]};
    unsigned ow[4];
#pragma unroll
    for (int e = 0; e < 4; ++e) {
        const float y0 = (bflo(hw[e]) + bflo(aw[e]) * cf[2 * e] + bflo(hbw[e]) + bflo(abw[e]) * cb[2 * e]) * siluf_(bflo(gw[e]));
        const float y1 = (bfhi(hw[e]) + bfhi(aw[e]) * cf[2 * e + 1] + bfhi(hbw[e]) + bfhi(abw[e]) * cb[2 * e + 1]) * siluf_(bfhi(gw[e]));
        ow[e] = cvt_pk_bf16(y0, y1); }
    u32x4 o; o.x = ow[0]; o.y = ow[1]; o.z = ow[2]; o.w = ow[3];
    *(u32x4*)(Y + (size_t)I.row * DM + I.c0) = o;
}
__device__ __forceinline__ void lru_out(const Frame& F, int row_lo, int blk0) {
    const long total = (long)(T - row_lo) * 128;
    if (F.bid < blk0) return;
    const long stride = (long)(F.G - blk0) * NTHR;
    long i = (long)(F.bid - blk0) * NTHR + F.tid;
#pragma unroll 1
    for (; i + stride < total; i += 2 * stride) { LruOutIn a, b; lru_out_load(a, F, i, row_lo); lru_out_load(b, F, i + stride, row_lo); lru_out_store(a, F); lru_out_store(b, F); }
    if (i < total) { LruOutIn a; lru_out_load(a, F, i, row_lo); lru_out_store(a, F); }
}
__device__ __forceinline__ void lru_carry(const Frame& F, int chain) {
    const int dir = chain >> 10, c = chain & 1023; const float* LS = WSP(float, WS_LSUM); float* LC = WSP(float, WS_LCAR);
    float h = 0.f;
#pragma unroll 1
    for (int s0 = 0; s0 < NCH; s0 += 26) {
        float A[26], hh[26];
#pragma unroll
        for (int j = 0; j < 26; ++j) { const int n = chunk_at(dir, s0 + j); const size_t b = (((size_t)n * 2 + dir) * 2) * 1024 + c; A[j] = LS[b]; hh[j] = LS[b + 1024]; }
#pragma unroll
        for (int j = 0; j < 26; ++j) { const int n = chunk_at(dir, s0 + j); LC[((size_t)n * 2 + dir) * 1024 + c] = h; h = A[j] * h + hh[j]; }
    }
}

struct MlStats { float cum0, cum1, u0, u1; };
__device__ __forceinline__ MlStats ml_cum(const LAS float* lf, const LAS float* ig, int dir, int lane) {
    MlStats s;
    if (dir == 0) { const float e0 = lf[2 * lane], e1 = lf[2 * lane + 1]; const float inc = wave_scan_add(e0 + e1, lane), pre = inc - (e0 + e1);
        s.cum0 = pre + e0; s.cum1 = inc; }
    else { const float e0 = lf[127 - 2 * lane], e1 = lf[126 - 2 * lane]; const float inc = wave_scan_add(e0 + e1, lane), pre = inc - (e0 + e1);
        s.cum0 = pre + e0; s.cum1 = inc; }
    const int t0 = dir == 0 ? 2 * lane : 127 - 2 * lane, t1 = dir == 0 ? 2 * lane + 1 : 126 - 2 * lane;
    s.u0 = ig[t0] - s.cum0; s.u1 = ig[t1] - s.cum1;
    return s;
}

struct ClPre { bf16x8 k[4], v[4]; float g[4]; };
__device__ __forceinline__ void cl_pre_issue(ClPre& R, const Frame& F, int item, int tid, bool live) {
    const int hd = item & 7, n = item >> 3;
    const __amdgpu_buffer_rsrc_t rp = mk_rsrc(WSP(bf16_t, WS_P) + (size_t)n * 128 * PW + hd * 128, live ? (size_t)128 * PW * 2 : 0);
    const unsigned vp = (unsigned)((tid >> 4) * PW + (tid & 15) * 8) * 2u;
#pragma unroll
    for (int i = 0; i < 4; ++i) { R.k[i] = buf_ld16(rp, vp, (unsigned)(i * 32 * PW + S_ML_K) * 2u); R.v[i] = buf_ld16(rp, vp, (unsigned)(i * 32 * PW + S_ML_V) * 2u); }
    if (tid < 128) { const float* g = WSP(float, WS_G) + ((size_t)n * 128 + tid) * 32; R.g[0] = g[8 + hd]; R.g[1] = g[hd]; R.g[2] = g[24 + hd]; R.g[3] = g[16 + hd]; }
}
__device__ __forceinline__ void cl_pre_commit(const ClPre& R, LAS bf16_t* Kt, LAS float* vec, int tid) {
    LAS bf16_t* Vt = Kt + 128 * TLD;
#pragma unroll
    for (int i = 0; i < 4; ++i) { const int idx = tid + NTHR * i, o = (idx >> 4) * TLD + (idx & 15) * 8; *(LAS bf16x8*)(Kt + o) = R.k[i]; *(LAS bf16x8*)(Vt + o) = R.v[i]; }
    if (tid < 128) { vec[tid] = log_sigmoidf_(R.g[0]); vec[128 + tid] = R.g[1]; vec[256 + tid] = log_sigmoidf_(R.g[2]); vec[384 + tid] = R.g[3]; }
}
__device__ __forceinline__ void ml_cloc_loop(const Frame& F, int it0) {
  if (it0 >= NCH * 8) return;
  LAS bf16_t* Kt = (LAS bf16_t*)(F.lds + LDS_RING); LAS bf16_t* Vt = Kt + 128 * TLD; LAS bf16_t* WK0 = Vt + 128 * TLD; LAS bf16_t* WK1 = WK0 + 128 * TLD;
  LAS float* vec = (LAS float*)(WK1 + 128 * TLD);
  { ClPre R0; cl_pre_issue(R0, F, it0, F.tid, true); cl_pre_commit(R0, Kt, vec, F.tid); }
  __syncthreads();
#pragma unroll 1
  for (int item = it0; item < NCH * 8; item += F.G) {
    int tz_ = F.tid; asm volatile("" : "+v"(tz_));
    const int hd = item & 7, n = item >> 3; const int tid = tz_, lane = tz_ & 63, wave = F.wave;
    const bool has_next = item + F.G < NCH * 8;
    ClPre R; cl_pre_issue(R, F, has_next ? item + F.G : item, tid, has_next);
    if (wave < 2) { const int dir = wave; const MlStats s = ml_cum(vec + dir * 256, vec + dir * 256 + 128, dir, lane);
        const float umax = wave_max(fmaxf(s.u0, s.u1));
        const int t0 = dir == 0 ? 2 * lane : 127 - 2 * lane, t1 = dir == 0 ? 2 * lane + 1 : 126 - 2 * lane;
        vec[512 + dir * 128 + t0] = __expf(s.u0 - umax); vec[512 + dir * 128 + t1] = __expf(s.u1 - umax);
        const float gtot = __shfl(s.cum1, 63);
        if (lane == 0) { float* gm = WSP(float, WS_GM) + ((size_t)n * 16 + dir * 8 + hd) * 2; gm[0] = gtot; gm[1] = gtot + umax; } }
    __syncthreads();
#pragma unroll
    for (int i = 0; i < 4; ++i) { const int idx = tid + NTHR * i, r = idx >> 4, oc = idx & 15; const u32x4 kv = *(const LAS u32x4*)(Kt + r * TLD + oc * 8);
        const float k0 = bflo(kv.x), k1 = bfhi(kv.x), k2 = bflo(kv.y), k3 = bfhi(kv.y), k4 = bflo(kv.z), k5 = bfhi(kv.z), k6 = bflo(kv.w), k7 = bfhi(kv.w);
#pragma unroll
        for (int dir = 0; dir < 2; ++dir) { const float w = vec[512 + dir * 128 + r]; u32x4 o; o.x = cvt_pk_bf16(w * k0, w * k1); o.y = cvt_pk_bf16(w * k2, w * k3); o.z = cvt_pk_bf16(w * k4, w * k5); o.w = cvt_pk_bf16(w * k6, w * k7);
            *(LAS u32x4*)((dir ? WK1 : WK0) + r * TLD + oc * 8) = o; } }
    { const int dir = tid >> 8, d = tid & 127, half = (tid >> 7) & 1; float s_ = 0.f;
#pragma unroll 8
        for (int q = 0; q < 64; ++q) s_ += vec[512 + dir * 128 + half * 64 + q] * bf2f(Kt[(half * 64 + q) * TLD + d]);
        vec[768 + tid] = s_; }
    __syncthreads();
    if (tid < 256) { const int dir = tid >> 7, d = tid & 127; WSP(float, WS_NLOC)[((size_t)n * 16 + dir * 8 + hd) * 128 + d] = vec[768 + dir * 256 + d] + vec[768 + dir * 256 + 128 + d]; }
    const int wr = wave >> 2, wc = wave & 3, li = lane & 15, lq = lane >> 4;
#pragma unroll 1
    for (int dir = 0; dir < 2; ++dir) {
        const LAS bf16_t* WK = dir ? WK1 : WK0;
        f32x4 acc[4][2];
#pragma unroll
        for (int m = 0; m < 4; ++m)
#pragma unroll
            for (int nn = 0; nn < 2; ++nn) acc[m][nn] = (f32x4){0.f, 0.f, 0.f, 0.f};
        TrFrag tk[2][4], tv[2][2];
#define CL_ISSUE(ks, st) do { _Pragma("unroll") for (int m = 0; m < 4; ++m) frag_tr_issue(tk[st][m], WK, TLD, 64 * wr + 16 * m, 32 * (ks), lane); \
            _Pragma("unroll") for (int nn = 0; nn < 2; ++nn) frag_tr_issue_p(tv[st][nn], Vt, TLD, 32 * wc, nn, 32 * (ks), lane); } while (0)
#define CL_MMA(st) do { SBAR(); _Pragma("unroll") for (int m = 0; m < 4; ++m) _Pragma("unroll") for (int nn = 0; nn < 2; ++nn) \
            acc[m][nn] = __builtin_amdgcn_mfma_f32_16x16x32_bf16(TRGET(tv[st][nn]), TRGET(tk[st][m]), acc[m][nn], 0, 0, 0); SBAR(); } while (0)
        CL_ISSUE(0, 0);
        CL_ISSUE(1, 1); LDS_WAIT(12); CL_MMA(0);
        CL_ISSUE(2, 0); LDS_WAIT(12); CL_MMA(1);
        CL_ISSUE(3, 1); LDS_WAIT(12); CL_MMA(0);
        LDS_WAIT(0); CL_MMA(1);
#undef CL_ISSUE
#undef CL_MMA
        bf16_t* CL = WSP(bf16_t, WS_CLOC) + ((size_t)n * 16 + dir * 8 + hd) * 16384;
#pragma unroll
        for (int m = 0; m < 4; ++m) *(u32x4*)(CL + (64 * wr + 16 * m + li) * 128 + 32 * wc + 8 * lq) = pack8(acc[m][0], acc[m][1]);
    }
    __syncthreads();
    if (has_next) cl_pre_commit(R, Kt, vec, tid);
    __syncthreads();
  }
}

constexpr int SCB = 13;
__device__ __forceinline__ void ml_scan(const Frame& F, int chain, int q, const LAS float* sg, const LAS float* sml) {
    const int dir = chain >> 3;
    const bf16_t* CL = WSP(bf16_t, WS_CLOC) + (size_t)chain * 16384 + q * 8; bf16_t* CI = WSP(bf16_t, WS_CIN) + (size_t)chain * 16384 + q * 8; float* MI = WSP(float, WS_MIN) + chain;
    f32x4 C0 = {0.f, 0.f, 0.f, 0.f}, C1 = {0.f, 0.f, 0.f, 0.f}; float m = 0.f;
    u32x4 ca[SCB], cb[SCB];
#define SC_LOAD(buf, s0) do { _Pragma("unroll") for (int j = 0; j < SCB; ++j) { const int n = chunk_at(dir, (s0) + j); buf[j] = *(const u32x4*)(CL + (size_t)n * (16 * 16384)); } } while (0)
#define SC_STEP(buf, s0) do { _Pragma("unroll") for (int j = 0; j < SCB; ++j) { const int s = (s0) + j, n = chunk_at(dir, s); const float g = sg[s], ml = sml[s]; \
        *(u32x4*)(CI + (size_t)n * (16 * 16384)) = pack8(C0, C1); if (q == 0) MI[n * 16] = m; \
        const float mnew = fmaxf(g + m, ml), a = __expf(g + m - mnew), e = __expf(ml - mnew); const u32x4 cl = buf[j]; \
        const f32x4 l0 = {bflo(cl.x), bfhi(cl.x), bflo(cl.y), bfhi(cl.y)}, l1 = {bflo(cl.z), bfhi(cl.z), bflo(cl.w), bfhi(cl.w)}; \
        C0 = C0 * a + l0 * e; C1 = C1 * a + l1 * e; m = mnew; } } while (0)
    SC_LOAD(ca, 0);
#pragma unroll 1
    for (int s0 = 0; s0 < NCH - 2 * SCB; s0 += 2 * SCB) { SC_LOAD(cb, s0 + SCB); SC_STEP(ca, s0); SC_LOAD(ca, s0 + 2 * SCB); SC_STEP(cb, s0 + SCB); }
    SC_LOAD(cb, NCH - SCB); SC_STEP(ca, NCH - 2 * SCB); SC_STEP(cb, NCH - SCB);
#undef SC_LOAD
#undef SC_STEP
}
__device__ __forceinline__ void ml_nscan(const Frame& F, int chain, int q4, const LAS float* sg, const LAS float* sml) {
    const int dir = chain >> 3;
    const float* NL = WSP(float, WS_NLOC) + (size_t)chain * 128 + q4 * 4; float* NI = WSP(float, WS_NIN) + (size_t)chain * 128 + q4 * 4;
    f32x4 nv = {0.f, 0.f, 0.f, 0.f}; float m = 0.f;
#pragma unroll 1
    for (int s0 = 0; s0 < NCH; s0 += SCB) {
        f32x4 nl[SCB];
#pragma unroll
        for (int j = 0; j < SCB; ++j) { const int n = chunk_at(dir, s0 + j); nl[j] = *(const f32x4*)(NL + (size_t)n * 2048); }
#pragma unroll
        for (int j = 0; j < SCB; ++j) { const int s = s0 + j, n = chunk_at(dir, s); const float g = sg[s], ml = sml[s];
            *(f32x4*)(NI + (size_t)n * 2048) = nv;
            const float mnew = fmaxf(g + m, ml), a = __expf(g + m - mnew), e = __expf(ml - mnew);
            nv = nv * a + nl[j] * e; m = mnew; }
    }
}

struct MlPre { bf16x8 q[4], k[4], v[4], c[4]; float g[4], nin, min_; };
__device__ __forceinline__ void ml_pre_issue(MlPre& R, const Frame& F, int item, int tid, int wave, bool live = true) {
    const int hd = item & 7, n = item >> 3;
    const bf16_t* P = WSP(bf16_t, WS_P);
    const __amdgpu_buffer_rsrc_t rp = mk_rsrc(P + (size_t)n * 128 * PW + hd * 128, live ? (size_t)128 * PW * 2 : 0), rc = mk_rsrc(WSP(bf16_t, WS_CIN) + ((size_t)n * 16 + hd) * 16384, live ? 32768 : 0);
    const unsigned vp = (unsigned)((tid >> 4) * PW + (tid & 15) * 8) * 2u;
#pragma unroll
    for (int i = 0; i < 4; ++i) { R.q[i] = buf_ld16(rp, vp, (unsigned)(i * 32 * PW + S_ML_Q) * 2u); R.k[i] = buf_ld16(rp, vp, (unsigned)(i * 32 * PW + S_ML_K) * 2u);
        R.v[i] = buf_ld16(rp, vp, (unsigned)(i * 32 * PW + S_ML_V) * 2u); R.c[i] = buf_ld16(rc, (unsigned)tid * 16u, (unsigned)i * 8192u); }
    if (tid < 128) { const float* g = WSP(float, WS_G) + ((size_t)n * 128 + tid) * 32; R.g[0] = g[8 + hd]; R.g[1] = g[hd]; R.g[2] = g[24 + hd]; R.g[3] = g[16 + hd]; }
    if (tid < 256) R.nin = WSP(float, WS_NIN)[((size_t)n * 16 + (tid >> 7) * 8 + hd) * 128 + (tid & 127)];
    if (wave < 2) R.min_ = WSP(float, WS_MIN)[(size_t)n * 16 + wave * 8 + hd];
}
__device__ __forceinline__ void ml_pre_commit(const MlPre& R, LAS bf16_t* Qt, LAS float* vec, int tid) {
    LAS bf16_t* KP = Qt + 128 * TLD; LAS bf16_t* Vt = KP + 128 * TLD; LAS bf16_t* Ct = Vt + 128 * TLD;
#pragma unroll
    for (int i = 0; i < 4; ++i) { const int idx = tid + NTHR * i, o = (idx >> 4) * TLD + (idx & 15) * 8;
        *(LAS bf16x8*)(Qt + o) = R.q[i]; *(LAS bf16x8*)(KP + o) = R.k[i]; *(LAS bf16x8*)(Vt + o) = R.v[i]; *(LAS bf16x8*)(Ct + o) = R.c[i]; }
    if (tid < 128) { vec[tid] = log_sigmoidf_(R.g[0]); vec[128 + tid] = R.g[1]; vec[256 + tid] = log_sigmoidf_(R.g[2]); vec[384 + tid] = R.g[3]; }
    if (tid < 256) vec[2688 + tid] = R.nin;
}
__device__ __forceinline__ void ml_out_loop(const Frame& F, int l, int it0, const MlPre& R0) {
  if (it0 >= NCH * 8) return;
  LAS bf16_t* Qt = (LAS bf16_t*)(F.lds + LDS_RING); LAS bf16_t* KP = Qt + 128 * TLD; LAS bf16_t* Vt = KP + 128 * TLD; LAS bf16_t* Ct = Vt + 128 * TLD;
  LAS float* vec = (LAS float*)(Ct + 128 * TLD);
  float m_cur;
  { ml_pre_commit(R0, Qt, vec, F.tid); m_cur = R0.min_; }
  __syncthreads();
#pragma unroll 1
  for (int item = it0; item < NCH * 8; item += F.G) {
    int tz_ = F.tid; asm volatile("" : "+v"(tz_));
    const int hd = item & 7, n = item >> 3; const int tid = tz_, lane = tz_ & 63, wave = F.wave;
    const bf16_t* P = WSP(bf16_t, WS_P);
    const size_t r0 = (size_t)n * 128;
    bf16x8 c1r[4];
    if (wave < 2) { const int dir = wave; const MlStats s = ml_cum(vec + dir * 256, vec + dir * 256 + 128, dir, lane);
        const float m_in = m_cur;
        const float inc = wave_scan_max(fmaxf(s.u0, s.u1), lane); float pre = __shfl_up(inc, 1); if (lane == 0) pre = -3.0e38f;
        const float M0 = fmaxf(pre, s.u0), M1 = inc;
        const float mu0 = fmaxf(m_in, M0), mu1 = fmaxf(m_in, M1);
        const int t0 = dir == 0 ? 2 * lane : 127 - 2 * lane, t1 = dir == 0 ? 2 * lane + 1 : 126 - 2 * lane;
        LAS float* v = vec + 512 + dir * 512;
        v[t0] = s.u0; v[t1] = s.u1; v[128 + t0] = mu0; v[128 + t1] = mu1; v[256 + t0] = __expf(m_in - mu0); v[256 + t1] = __expf(m_in - mu1);
        v[384 + t0] = __expf(-(s.cum0 + mu0)); v[384 + t1] = __expf(-(s.cum1 + mu1)); }
    const int wr = wave >> 2, wc = wave & 3, li = lane & 15, lq = lane >> 4;
    f32x4 sacc[4][2];
#pragma unroll
    for (int m = 0; m < 4; ++m)
#pragma unroll
        for (int nn = 0; nn < 2; ++nn) sacc[m][nn] = (f32x4){0.f, 0.f, 0.f, 0.f};
#pragma unroll
    for (int ks = 0; ks < 4; ++ks) {
        bf16x8 fq_[4], fk_[2];
#pragma unroll
        for (int m = 0; m < 4; ++m) fq_[m] = frag_kc(Qt, TLD, 64 * wr + 16 * m, 32 * ks, lane);
#pragma unroll
        for (int nn = 0; nn < 2; ++nn) fk_[nn] = frag_kc(KP, TLD, 32 * wc + 16 * nn, 32 * ks, lane);
#pragma unroll
        for (int m = 0; m < 4; ++m)
#pragma unroll
            for (int nn = 0; nn < 2; ++nn) sacc[m][nn] = __builtin_amdgcn_mfma_f32_16x16x32_bf16(fk_[nn], fq_[m], sacc[m][nn], 0, 0, 0);
    }
    __syncthreads();
    f32x4 hs[4][2];
#pragma unroll
    for (int m = 0; m < 4; ++m)
#pragma unroll
        for (int nn = 0; nn < 2; ++nn) hs[m][nn] = (f32x4){0.f, 0.f, 0.f, 0.f};
#pragma unroll 1
    for (int dir = 0; dir < 2; ++dir) {
        const LAS float* v = vec + 512 + dir * 512; const size_t cc = (size_t)n * 16 + dir * 8 + hd;
        if (dir == 1) { const __amdgpu_buffer_rsrc_t rc = __builtin_amdgcn_make_buffer_rsrc((void*)(WSP(bf16_t, WS_CIN) + cc * 16384), (short)0, 32768, 0x00020000);
#pragma unroll
            for (int i = 0; i < 4; ++i) c1r[i] = buf_ld16(rc, (unsigned)tid * 16u, (unsigned)i * 8192u); }
#pragma unroll
        for (int m = 0; m < 4; ++m) { const int j = 64 * wr + 16 * m + li; const float muj = v[128 + j]; float ps = 0.f;
#pragma unroll
            for (int nn = 0; nn < 2; ++nn) { const int s0 = 32 * wc + 16 * nn + 4 * lq; float pv[4];
#pragma unroll
                for (int e = 0; e < 4; ++e) { const int s = s0 + e; const bool ok = dir == 0 ? (s <= j) : (s >= j);
                    pv[e] = ok ? __expf(v[s] - muj) * sacc[m][nn][e] : 0.f; ps += pv[e]; }
                u32x2 w; w.x = cvt_pk_bf16(pv[0], pv[1]); w.y = cvt_pk_bf16(pv[2], pv[3]); *(LAS u32x2*)(KP + j * TLD + s0) = w; }
            ps += __shfl_xor(ps, 16); ps += __shfl_xor(ps, 32);
            if (lq == 0) vec[1664 + j * 4 + wc] = ps; }
        if (dir == 1) {
#pragma unroll
            for (int i = 0; i < 4; ++i) { const int idx = tid + NTHR * i, r = idx >> 4, oc = idx & 15; *(LAS bf16x8*)(Ct + r * TLD + oc * 8) = c1r[i]; } }
        { const int j = tid >> 2, qd = tid & 3; float s_ = 0.f;
          const LAS f32x4* np = (const LAS f32x4*)(vec + 2688 + dir * 128 + qd * 32);
#pragma unroll
          for (int d4 = 0; d4 < 8; ++d4) { const f32x4 nv = np[d4]; const u32x2 qq = *(const LAS u32x2*)(Qt + j * TLD + qd * 32 + d4 * 4);
              s_ += bflo(qq.x) * nv[0] + bfhi(qq.x) * nv[1] + bflo(qq.y) * nv[2] + bfhi(qq.y) * nv[3]; }
          s_ += __shfl_xor(s_, 1); s_ += __shfl_xor(s_, 2);
          if (qd == 0) vec[1536 + j] = s_; }
        __syncthreads();
        f32x4 acc[4][2];
#pragma unroll
        for (int m = 0; m < 4; ++m)
#pragma unroll
            for (int nn = 0; nn < 2; ++nn) acc[m][nn] = (f32x4){0.f, 0.f, 0.f, 0.f};
        { TrFrag tc[2][2]; bf16x8 fq_[4];
#define OC_ISSUE(ks, st) do { _Pragma("unroll") for (int nn = 0; nn < 2; ++nn) frag_tr_issue_p(tc[st][nn], Ct, TLD, 32 * wc, nn, 32 * (ks), lane); } while (0)
#define OC_STEP(ks, st, NW_) do { _Pragma("unroll") for (int m = 0; m < 4; ++m) fq_[m] = frag_kc(Qt, TLD, 64 * wr + 16 * m, 32 * (ks), lane); \
            if ((ks) < 3) OC_ISSUE((ks) + 1, 1 - (st)); if ((ks) < 3) LDS_WAIT(4); else LDS_WAIT(0); SBAR(); \
            _Pragma("unroll") for (int m = 0; m < 4; ++m) _Pragma("unroll") for (int nn = 0; nn < 2; ++nn) \
                acc[m][nn] = __builtin_amdgcn_mfma_f32_16x16x32_bf16(TRGET(tc[st][nn]), fq_[m], acc[m][nn], 0, 0, 0); SBAR(); } while (0)
          OC_ISSUE(0, 0); OC_STEP(0, 0, 0); OC_STEP(1, 1, 0); OC_STEP(2, 0, 0); OC_STEP(3, 1, 0);
#undef OC_ISSUE
#undef OC_STEP
        }
#pragma unroll
        for (int m = 0; m < 4; ++m) { const float ej = v[256 + 64 * wr + 16 * m + li];
#pragma unroll
            for (int nn = 0; nn < 2; ++nn) acc[m][nn] *= ej; }
        { TrFrag tv[2][2]; bf16x8 fp_[4];
#define OV_ISSUE(ks, st) do { _Pragma("unroll") for (int nn = 0; nn < 2; ++nn) frag_tr_issue_p(tv[st][nn], Vt, TLD, 32 * wc, nn, 32 * (ks), lane); } while (0)
#define OV_STEP(ks, st) do { _Pragma("unroll") for (int m = 0; m < 4; ++m) fp_[m] = frag_kc(KP, TLD, 64 * wr + 16 * m, 32 * (ks), lane); \
            if ((ks) < 3) OV_ISSUE((ks) + 1, 1 - (st)); if ((ks) < 3) LDS_WAIT(4); else LDS_WAIT(0); SBAR(); \
            _Pragma("unroll") for (int m = 0; m < 4; ++m) _Pragma("unroll") for (int nn = 0; nn < 2; ++nn) \
                acc[m][nn] = __builtin_amdgcn_mfma_f32_16x16x32_bf16(TRGET(tv[st][nn]), fp_[m], acc[m][nn], 0, 0, 0); SBAR(); } while (0)
          OV_ISSUE(0, 0); OV_STEP(0, 0); OV_STEP(1, 1); OV_STEP(2, 0); OV_STEP(3, 1);
#undef OV_ISSUE
#undef OV_STEP
        }
#pragma unroll
        for (int m = 0; m < 4; ++m) { const int j = 64 * wr + 16 * m + li;
            const float den = v[256 + j] * vec[1536 + j] + (vec[1664 + j * 4] + vec[1664 + j * 4 + 1] + vec[1664 + j * 4 + 2] + vec[1664 + j * 4 + 3]);
            const float inv = __builtin_amdgcn_rcpf(fmaxf(fabsf(den), v[384 + j]));
#pragma unroll
            for (int nn = 0; nn < 2; ++nn) hs[m][nn] += acc[m][nn] * inv; }
        __syncthreads();
    }
    const bool has_next = item + F.G < NCH * 8;
    MlPre R;
    ml_pre_issue(R, F, has_next ? item + F.G : item, tid, wave, has_next);
#pragma unroll
    for (int m = 0; m < 4; ++m) { float ss = dot4(hs[m][0]) + dot4(hs[m][1]); ss += __shfl_xor(ss, 16); ss += __shfl_xor(ss, 32);
        if (lq == 0) vec[2176 + (64 * wr + 16 * m + li) * 4 + wc] = ss; }
    __syncthreads();
    bf16_t* Y = WSP(bf16_t, WS_Y);
#pragma unroll
    for (int m = 0; m < 4; ++m) { const int j = 64 * wr + 16 * m + li; const size_t row = r0 + j;
        const float rstd = rsqrtf((vec[2176 + j * 4] + vec[2176 + j * 4 + 1] + vec[2176 + j * 4 + 2] + vec[2176 + j * 4 + 3]) * (1.f / 128.f) + EPS);
        { const int e0 = 32 * wc + 8 * lq;
            const f32x4 hn0 = *(const f32x4*)(F.head_norm + l * 1024 + hd * 128 + e0), hn1 = *(const f32x4*)(F.head_norm + l * 1024 + hd * 128 + e0 + 4);
            const u32x4 ov = *(const u32x4*)(P + row * PW + S_ML_O + hd * 128 + e0), gv = *(const u32x4*)(P + row * PW + S_ML_G + hd * 128 + e0);
            const float ow[8] = {bflo(ov.x), bfhi(ov.x), bflo(ov.y), bfhi(ov.y), bflo(ov.z), bfhi(ov.z), bflo(ov.w), bfhi(ov.w)};
            const float gw[8] = {bflo(gv.x), bfhi(gv.x), bflo(gv.y), bfhi(gv.y), bflo(gv.z), bfhi(gv.z), bflo(gv.w), bfhi(gv.w)};
            f32x4 y0, y1;
#pragma unroll
            for (int e = 0; e < 4; ++e) {
                y0[e] = (hs[m][0][e] * rstd * hn0[e]) * (gw[e] * __builtin_amdgcn_rcpf((1.f + __expf(-ow[e])) * (1.f + __expf(-gw[e]))));
                y1[e] = (hs[m][1][e] * rstd * hn1[e]) * (gw[4 + e] * __builtin_amdgcn_rcpf((1.f + __expf(-ow[4 + e])) * (1.f + __expf(-gw[4 + e])))); }
            *(u32x4*)(Y + row * DM + 3072 + hd * 128 + e0) = pack8(y0, y1); }
        __builtin_amdgcn_sched_barrier(0); }
    if (has_next) { ml_pre_commit(R, Qt, vec, tid); m_cur = R.min_; }
    __syncthreads();
  }
}

template <int DQK, int LDROW>
__device__ __forceinline__ unsigned dma_src_off(int c, int lane, int kcol, int vcol, int rcol) {
    constexpr int KP_ = DQK * 2 + 16, KB_ = 64 * KP_;
    const int B = 1024 * c + 16 * lane;
    if (B < KB_) { const int row = B / KP_, cb = B - row * KP_;
        const int col = cb < 256 ? kcol * 2 + cb : ((DQK == 192 && cb < 384) ? rcol * 2 + (cb - 256) : kcol * 2);
        return (unsigned)(row * (LDROW * 2) + col); }
    const int Bv = B - KB_, sid = Bv >> 9, w16 = (Bv & 511) >> 4, kk = (sid >> 2) * 8 + (w16 >> 2);
    const int key = (kk & ~0xC) | ((kk & 4) << 1) | ((kk & 8) >> 1), col = (sid & 3) * 32 + (w16 & 3) * 8;
    return (unsigned)(key * (LDROW * 2) + (vcol + col) * 2);
}
template <int DQK, bool MASK, int LDROW, class TS, int ABL, bool ODD = false>
__device__ __forceinline__ void attn_dma(const bf16_t* __restrict__ Qrow, const bf16_t* __restrict__ base, int kcol, int vcol, int rcol, const TS ts, int NT, float m_init, float l_init, int qtok,
                                         const bf16_t* __restrict__ Gb, int ldg, bf16_t* __restrict__ Ob, int ldo, LAS unsigned char* ldsb, const int tid_, const int wave) {
    constexpr int KP_ = DQK * 2 + 16, ND = DQK / 16, DMA_KB = 64 * KP_, DMA_STAGE = DMA_KB + 16384, DMA_NCH = DMA_STAGE / 1024, NPW = (DMA_NCH + 7) / 8;
    static_assert(DMA_KB % 1024 == 0, "K region must be whole 1 KiB chunks");
    int tl = tid_; asm volatile("" : "+v"(tl));
    const int tid = tl, lane = tid & 63, r32 = lane & 31, hi = lane >> 5;
    float m_reg = m_init, l_reg = l_init; f32x16 o[4] = {}; bf16x8 qr[ND];
    f32x16 negm;
#pragma unroll
    for (int r = 0; r < 16; ++r) negm[r] = -m_init;
    const bf16_t* Qw = Qrow + hi * 8;
#pragma unroll
    for (int d0 = 0; d0 < ND; ++d0) qr[d0] = *reinterpret_cast<const bf16x8*>(Qw + d0 * 16);
    const __amdgpu_buffer_rsrc_t rs = __builtin_amdgcn_make_buffer_rsrc((void*)base, (short)0, (int)((size_t)T * LDROW * 2), 0x00020000);
    unsigned vsrc[NPW];
#pragma unroll
    for (int i = 0; i < NPW; ++i) { const int c = wave + 8 * i; vsrc[i] = dma_src_off<DQK, LDROW>(c < DMA_NCH ? c : wave, lane, kcol, vcol, rcol); }
    const int krow0 = (int)(uintptr_t)ldsb + r32 * KP_ + hi * 16, vb00 = (int)(uintptr_t)ldsb + DMA_KB + v_rd_base(lane);
#define DMA_TILE(j, stg) do { if (ABL != 2) { const unsigned so_ = (unsigned)ts.row(j) * (unsigned)(LDROW * 2); _Pragma("unroll") for (int i = 0; i < NPW - 1; ++i) \
        __builtin_amdgcn_raw_ptr_buffer_load_lds(rs, (LAS void*)(ldsb + (stg) + 1024 * (wave + 8 * i)), 16, (int)vsrc[i], (int)so_, 0, 0); \
        if (wave + 8 * (NPW - 1) < DMA_NCH) __builtin_amdgcn_raw_ptr_buffer_load_lds(rs, (LAS void*)(ldsb + (stg) + 1024 * (wave + 8 * (NPW - 1))), 16, (int)vsrc[NPW - 1], (int)so_, 0, 0); } } while (0)
#define DMA_WAIT_BAR() do { asm volatile("s_waitcnt vmcnt(0)" ::: "memory"); __builtin_amdgcn_s_barrier(); asm volatile("" ::: "memory"); } while (0)
#define RESC(a) do { if (__any((a) < 1.f)) { const float a_ = (a); _Pragma("unroll") for (int d = 0; d < 4; ++d) _Pragma("unroll") for (int r = 0; r < 16; ++r) o[d][r] *= a_; \
    { const float nm_ = -m_reg; _Pragma("unroll") for (int r = 0; r < 16; ++r) negm[r] = nm_; } } } while (0)
#define KRD(d0, KB_, B0, B1) do { const int ad_ = (KB_) + (d0) * 32; B0 = *(const LAS bf16x8*)(ad_); B1 = *(const LAS bf16x8*)(ad_ + 32 * KP_); } while (0)
#define QKT(P0, P1, KB_) do { \
    bf16x8 kf0[3], kf1[3]; KRD(0, KB_, kf0[0], kf1[0]); KRD(1, KB_, kf0[1], kf1[1]); \
    _Pragma("unroll") for (int d0 = 0; d0 < ND; ++d0) { \
        if (d0 + 2 < ND) KRD(d0 + 2, KB_, kf0[(d0 + 2) % 3], kf1[(d0 + 2) % 3]); \
        if (d0 == 0) { P0 = __builtin_amdgcn_mfma_f32_32x32x16_bf16(kf0[0], qr[0], negm, 0, 0, 0); P1 = __builtin_amdgcn_mfma_f32_32x32x16_bf16(kf1[0], qr[0], negm, 0, 0, 0); }     \
        else { P0 = __builtin_amdgcn_mfma_f32_32x32x16_bf16(kf0[d0 % 3], qr[d0], P0, 0, 0, 0); P1 = __builtin_amdgcn_mfma_f32_32x32x16_bf16(kf1[d0 % 3], qr[d0], P1, 0, 0, 0); } } \
    __builtin_amdgcn_sched_group_barrier(0x100, 4, 0); sg_rmv<ND - 2>(); sg_mv<2>(); } while (0)
#define AMASK(P0, P1, j) do { if (MASK && ts.masked(j)) { const int kt0 = ts.tok(j); _Pragma("unroll") for (int r = 0; r < 16; ++r) { \
    const int k0_ = kt0 + crow(r, hi), k1_ = k0_ + 32; const int d0_ = qtok - k0_, d1_ = qtok - k1_; \
    if (d0_ > 128 || d0_ < -128 || k0_ < 0 || k0_ >= SEQ) P0[r] = -1e30f; if (d1_ > 128 || d1_ < -128 || k1_ < 0 || k1_ >= SEQ) P1[r] = -1e30f; } } } while (0)
    f32x16 pA0, pA1, pB0, pB1; float alA, alB; bf16x8 pa0, pa1, pa2, pa3;
    int s_prev = 0, s_cur = DMA_STAGE, s_next = 2 * DMA_STAGE;
    DMA_TILE(0, 0); DMA_TILE(1, DMA_STAGE); DMA_WAIT_BAR();
    QKT(pA0, pA1, krow0); AMASK(pA0, pA1, 0); partialSM<ABL>(pA0, pA1, m_reg, alA);
    RESC(alA);
    for (int j = 1; j + 1 < NT; j += 2) {
        DMA_TILE(j + 1, s_next);
        SBAR(); QKT(pB0, pB1, krow0 + s_cur); AMASK(pB0, pB1, j);
        finishSM<ABL>(pA0, pA1, alA, l_reg, pa0, pa1, pa2, pa3); SBAR();
        pv_d0(o, vb00 + s_prev, pa0, pa1, pa2, pa3); partialSM<ABL>(pB0, pB1, m_reg, alB);
        RESC(alB); DMA_WAIT_BAR();
        { const int t_ = s_prev; s_prev = s_cur; s_cur = s_next; s_next = t_; }
        if (j + 2 < NT) DMA_TILE(j + 2, s_next);
        SBAR(); QKT(pA0, pA1, krow0 + s_cur); AMASK(pA0, pA1, j + 1);
        finishSM<ABL>(pB0, pB1, alB, l_reg, pa0, pa1, pa2, pa3); SBAR();
        pv_d0(o, vb00 + s_prev, pa0, pa1, pa2, pa3); partialSM<ABL>(pA0, pA1, m_reg, alA);
        RESC(alA); DMA_WAIT_BAR();
        { const int t_ = s_prev; s_prev = s_cur; s_cur = s_next; s_next = t_; }
    }
    if (!ODD) {
        SBAR(); QKT(pB0, pB1, krow0 + s_cur); AMASK(pB0, pB1, NT - 1);
        finishSM<ABL>(pA0, pA1, alA, l_reg, pa0, pa1, pa2, pa3); SBAR();
        pv_d0(o, vb00 + s_prev, pa0, pa1, pa2, pa3); partialSM<ABL>(pB0, pB1, m_reg, alB);
        RESC(alB);
        finishSM<ABL>(pB0, pB1, alB, l_reg, pa0, pa1, pa2, pa3); SBAR();
        pv_d0(o, vb00 + s_cur, pa0, pa1, pa2, pa3);
    } else {
        finishSM<ABL>(pA0, pA1, alA, l_reg, pa0, pa1, pa2, pa3); SBAR();
        pv_d0(o, vb00 + s_prev, pa0, pa1, pa2, pa3);
    }
    { const float rl = __builtin_amdgcn_rcpf(l_reg);
      int lz = lane; asm volatile("" : "+v"(lz));
      const int qz = lz & 31, hz = lz >> 5;
      const bf16_t* grow = Gb + (size_t)qz * ldg + 4 * hz; bf16_t* orow = Ob + (size_t)qz * ldo + 8 * hz;
      u32x2 gav[8], gbv[8];
      if (DQK == 128) {
#pragma unroll
          for (int kk = 0; kk < 8; ++kk) { gav[kk] = *(const u32x2*)(grow + 16 * kk); gbv[kk] = *(const u32x2*)(grow + 16 * kk + 8); } }
#pragma unroll
      for (int d0 = 0; d0 < 4; ++d0)
#pragma unroll
          for (int gp = 0; gp < 2; ++gp) {
              const int k = 4 * d0 + 2 * gp;
              u32x2 ga, gb;
              if (DQK == 128) { ga = gav[2 * d0 + gp]; gb = gbv[2 * d0 + gp]; } else { ga = *(const u32x2*)(grow + 8 * k); gb = *(const u32x2*)(grow + 8 * k + 8); }
              const f32x16& od = o[d0];
              const float a0 = od[8 * gp + 0] * rl * siluf_(bflo(ga.x)), a1 = od[8 * gp + 1] * rl * siluf_(bfhi(ga.x)), a2 = od[8 * gp + 2] * rl * siluf_(bflo(ga.y)), a3 = od[8 * gp + 3] * rl * siluf_(bfhi(ga.y));
              const float b0 = od[8 * gp + 4] * rl * siluf_(bflo(gb.x)), b1 = od[8 * gp + 5] * rl * siluf_(bfhi(gb.x)), b2 = od[8 * gp + 6] * rl * siluf_(bflo(gb.y)), b3 = od[8 * gp + 7] * rl * siluf_(bfhi(gb.y));
              const unsigned ax = cvt_pk_bf16(a0, a1), ay = cvt_pk_bf16(a2, a3), bx = cvt_pk_bf16(b0, b1), by = cvt_pk_bf16(b2, b3);
              auto rx = __builtin_amdgcn_permlane32_swap(ax, bx, false, false); auto ry = __builtin_amdgcn_permlane32_swap(ay, by, false, false);
              u32x4 w; w.x = rx[0]; w.y = ry[0]; w.z = rx[1]; w.w = ry[1];
              *(u32x4*)(orow + 8 * k) = w; } }
    __builtin_amdgcn_s_barrier();
#undef DMA_TILE
#undef DMA_WAIT_BAR
#undef RESC
#undef KRD
#undef QKT
#undef AMASK
}

constexpr float SCALE_SWA = 0.08838834764831845f, SCALE_MLA = 0.07216878364870322f;
__device__ __forceinline__ void swa_unit(const Frame& F, int l, int unit) {
    const bf16_t* P = WSP(bf16_t, WS_P); bf16_t* Y = WSP(bf16_t, WS_Y);
    const bf16_t* Pq = P; asm volatile("" : "+s"(Pq), "+s"(Y));
    int lz = F.lane; asm volatile("" : "+v"(lz));
    const int r32 = lz & 31;
    const bool is_ctx = unit >= 512; const int u2 = is_ctx ? unit - 512 : unit, g2 = u2 & 1, qc = u2 >> 1;
    const int hq = 4 * g2 + (F.wave >> 1), rloc = 32 * (F.wave & 1);
    const int row0 = (is_ctx ? 0 : CTX) + qc * 64 + rloc;
    const bf16_t* Qrow = Pq + (size_t)(row0 + r32) * PW + S_SWA_Q + hq * 128;
    const bf16_t* Gb = Pq + (size_t)row0 * PW + S_SWA_G + hq * 128; bf16_t* Ob = Y + (size_t)row0 * DM + 1024 + hq * 128;
    const float m_init = F.sink[l * 8 + hq] * LOG2E;
    if (!is_ctx) { TsSwa ts; ts.tb = qc * 64 - 128;
        attn_dma<128, true, PW, TsSwa, 0, true>(Qrow, P, S_SWA_K + g2 * 128, S_SWA_V + g2 * 128, 0, ts, 9, m_init, 1.f, qc * 64 + rloc + r32, Gb, PW, Ob, DM, F.lds + LDS_RING, F.tid, F.wave); }
    else { TsDense ts;
        attn_dma<128, false, PW, TsDense, 0>(Qrow, P, S_SWA_K + g2 * 128, S_SWA_V + g2 * 128, 0, ts, 4, m_init, 1.f, 0, Gb, PW, Ob, DM, F.lds + LDS_RING, F.tid, F.wave); }
}
template <int ABL = 0>
__device__ __forceinline__ void mla_unit(const Frame& F, int unit) {
    const bf16_t* P = WSP(bf16_t, WS_P); bf16_t* Y = WSP(bf16_t, WS_Y); const bf16_t* QM = WSP(bf16_t, WS_QM); const bf16_t* KV = WSP(bf16_t, WS_KV);
    asm volatile("" : "+s"(P), "+s"(Y), "+s"(QM));
    int lz = F.lane; asm volatile("" : "+v"(lz));
    const int r32 = lz & 31;
    const bool is_ctx = unit >= 512; const int h = unit & 7, qb = is_ctx ? 0 : (unit >> 3);
    const int row0 = (is_ctx ? 0 : CTX + qb * 256) + 32 * F.wave;
    const bf16_t* Qrow = QM + (size_t)(row0 + r32) * 1536 + h * 192;
    const bf16_t* Gb = P + (size_t)row0 * PW + S_MLA_G + h * 128; bf16_t* Ob = (ABL ? WSP(bf16_t, WS_H) : Y) + (size_t)row0 * DM + 2048 + h * 128;
    attn_dma<192, false, LDKV, TsDense, ABL>(Qrow, KV, h * 256, h * 256 + 128, 2048, TsDense(), is_ctx ? 4 : T / 64, 0.f, 0.f, 0, Gb, PW, Ob, DM, F.lds + LDS_RING, F.tid, F.wave);
}

#ifndef PHMASK
#define PHMASK 0xFFFF
#endif
#define EN(b) ((PHMASK >> (b)) & 1)
#define IN(k) ph_in(lds, (k))
#define SEAM(k) do { if (IN(k) && IN((k) + 1)) grid_barrier(lds); } while (0)

template <int l>
__device__ __forceinline__ void layer_phases(LAS unsigned char* lds, const int wave0) {
        const int pb = 1 + 7 * l;
        const bool need_ctx = (l == 0);
        if (EN(1) && IN(pb + 0)) REP(1) {
            const Frame F = load_frame(lds, wave0);
            if (l == 0) norm_phase(F, 0, 0, T, 0, F.G);
            else {
                if (F.bid < 16) {
                    pg8::Gemm g{WSP(bf16_t, WS_Y), WSP(bf16_t, WS_WOUT) + (size_t)(l - 1) * DM * DM, CTX, DM, DM, DM, DM};
                    pg8::StaticOrder S; S.init(CTX, DM, 16, F.bid);
                    EpiOut E{WSP(bf16_t, WS_Z), WSP(float, WS_ST2), 0};
                    pg8::gemm_phase<EpiOut>(F.lds + LDS_RING, g, S, E, F.tid);
                }
                { const Frame F2 = load_frame(lds, wave0); norm_phase(F2, l, CTX, T, 16, F2.G - 16); }
            }
        }
        if (l > 0) SEAM(pb + 0);
        if (l > 0 && EN(1) && IN(pb + 1)) { const Frame F = load_frame(lds, wave0); norm_phase(F, l, 0, CTX, 0, F.G); }
        SEAM(pb + 1);
        if (EN(2) && IN(pb + 2)) REP(2) {
            const Frame F = load_frame(lds, wave0);
            pg8::Gemm g{WSP(bf16_t, WS_H), WSP(bf16_t, WS_WIN) + (size_t)l * NPAD * DM, T, NPAD, DM, DM, DM};
            pg8::StaticOrder S; S.init(T, NPAD, F.G, F.bid);
            LAS float* lt32 = (LAS float*)(F.lds + LDS_RING + pg8::STAGE_BYTES);
#pragma unroll
            for (int i = 0; i < 2; ++i) *(LAS f32x4*)(lt32 + 4 * (F.tid + NTHR * i)) = *(const f32x4*)(WSP(float, WS_TAB32) + 4 * (F.tid + NTHR * i));
            __syncthreads();
            EpiIn E{WSP(bf16_t, WS_P), WSP(bf16_t, WS_KV), WSP(float, WS_G), WSP(float, WS_ST1), WSP(float, WS_TAB16), WSP(float, WS_TAB32), F.gate_b + l * 32, lt32};
            pg8::gemm_phase<EpiIn>(F.lds + LDS_RING, g, S, E, F.tid);
        }
        SEAM(pb + 2);
        if (IN(pb + 3)) {
            if (EN(3)) REP(3) { const Frame F = load_frame(lds, wave0); pg8::Gemm g{WSP(bf16_t, WS_P) + S_CQ, WSP(bf16_t, WS_WUQ) + (size_t)l * 1536 * 768, T, 1536, 768, PW, 768};
              pg8::StaticOrder S; S.init(T, 1536, F.G, F.bid);
              LAS float* lt16 = (LAS float*)(F.lds + LDS_RING + pg8::STAGE_BYTES);
              *(LAS f32x4*)(lt16 + 4 * F.tid) = *(const f32x4*)(WSP(float, WS_TAB16) + 4 * F.tid);
              __syncthreads();
              EpiUq E{WSP(bf16_t, WS_QM), WSP(float, WS_ST1), WSP(float, WS_TAB16), lt16};
              pg8::gemm_phase<EpiUq>(F.lds + LDS_RING, g, S, E, F.tid); }
            if (EN(4)) REP(4) { const Frame F = load_frame(lds, wave0); pg8::Gemm g{WSP(bf16_t, WS_P) + S_CKV, WSP(bf16_t, WS_WUKV) + (size_t)l * 2048 * 256, T, 2048, 256, PW, 256};
              pg8::StaticOrder S; S.init(T, 2048, F.G, (F.bid + F.G - 136) % F.G);
              EpiUkv E{WSP(bf16_t, WS_KV), WSP(float, WS_ST1)};
              pg8::gemm_phase<EpiUkv>(F.lds + LDS_RING, g, S, E, F.tid); }
            const int nswa = 512 + (need_ctx ? 8 : 0);
            if (EN(5)) REP(5) { const Frame F = load_frame(lds, wave0); for (int u = (F.bid + F.G - 144) % F.G; u < nswa; u += F.G) swa_unit(F, l, u); }
            if (EN(6)) REP(6) { const Frame F = load_frame(lds, wave0); ml_cloc_loop(F, (F.bid + F.G - 152) % F.G); }
            if (EN(7)) REP(7) { const Frame F = load_frame(lds, wave0); lru_loop(F, l, (F.bid + F.G - 168) % F.G); }
        }
        SEAM(pb + 3);
        if (IN(pb + 4)) {
            if (EN(8)) REP(8) { const Frame F = load_frame(lds, wave0);
                LAS float* sg = (LAS float*)(F.lds + LDS_RING); LAS float* sml = sg + 192;
                const int chain = F.bid >> 4;
                if (F.tid < NCH) { const int n = chunk_at(chain >> 3, F.tid); const float* gm = WSP(float, WS_GM) + ((size_t)n * 16 + chain) * 2; sg[F.tid] = gm[0]; sml[F.tid] = gm[1]; }
                __syncthreads();
                if (F.tid < 128) ml_scan(F, chain, (F.bid & 15) * 128 + F.tid, sg, sml);
                else if (F.tid < 160 && (F.bid & 15) == 0) ml_nscan(F, chain, F.tid - 128, sg, sml);
                else if (F.tid >= 256 && F.bid < 8) lru_carry(F, F.bid * 256 + (F.tid - 256));
                __syncthreads(); }
            const int nmla = 512 + (need_ctx ? 8 : 0);
            if (EN(9)) { const Frame F = load_frame(lds, wave0); for (int u = F.bid; u < nmla; u += F.G) mla_unit<0>(F, u); }
            if (EN(9) && ((REPMASK >> 9) & 1)) { const Frame F = load_frame(lds, wave0); for (int u = F.bid; u < nmla; u += F.G) mla_unit<ABL_KIND>(F, u); }
        }
        SEAM(pb + 4);
        if (IN(pb + 5)) {
            const int n0 = need_ctx ? 0 : 2;
            if (EN(10) && EN(11)) { const Frame F = load_frame(lds, wave0);
                const int it0 = n0 * 8 + F.bid; MlPre R0; ml_pre_issue(R0, F, it0 < NCH * 8 ? it0 : 0, F.tid, F.wave);
                lru_out(F, n0 * 128, need_ctx ? 16 : 0);
                ml_out_loop(F, l, it0, R0); }
        }
        SEAM(pb + 5);
        if (EN(12) && IN(pb + 6)) REP(12) {
            const Frame F = load_frame(lds, wave0);
            pg8::Gemm g{WSP(bf16_t, WS_Y) + (size_t)CTX * DM, WSP(bf16_t, WS_WOUT) + (size_t)l * DM * DM, SEQ, DM, DM, DM, DM};
            pg8::StaticOrder S; S.init(SEQ, DM, F.G, F.bid);
            EpiOut E{WSP(bf16_t, WS_Z), WSP(float, WS_ST2), CTX};
            pg8::gemm_phase<EpiOut>(F.lds + LDS_RING, g, S, E, F.tid);
        }
        SEAM(pb + 6);
}

constexpr int N_PHASES = 16;
__global__ void __launch_bounds__(NTHR, 2) hybrid_fwd(Args args) {
    extern __shared__ __attribute__((aligned(16))) unsigned char lds_raw[];
    LAS unsigned char* const lds = (LAS unsigned char*)lds_raw;
    const int wave0 = __builtin_amdgcn_readfirstlane((int)threadIdx.x >> 6);
    if (threadIdx.x < 16) ((LAS unsigned*)(lds + LDS_MISC))[threadIdx.x] = 0u;
    if (threadIdx.x < 26) { const unsigned long long p = threadIdx.x < 24 ? (unsigned long long)args.in[threadIdx.x] : (threadIdx.x == 24 ? (unsigned long long)args.out : (unsigned long long)args.ws);
        ((LAS unsigned*)(lds + LDS_PTRS))[2 * threadIdx.x] = (unsigned)p; ((LAS unsigned*)(lds + LDS_PTRS))[2 * threadIdx.x + 1] = (unsigned)(p >> 32); }
    if (threadIdx.x == 0) { ((LAS int*)(lds + LDS_MISC))[8] = args.ph_lo; ((LAS int*)(lds + LDS_MISC))[9] = args.ph_hi; }
    __syncthreads();
    const int lo = args.ph_lo, hi = args.ph_hi;
    if (hi - lo > 1) (void)xcd_barrier_post((unsigned*)(args.ws + WS_CTL), (volatile LAS unsigned*)(lds + LDS_MISC));

    if (EN(0) && IN(0)) REP(0) { const Frame F = load_frame(lds, wave0); p0_prologue(F); }
    SEAM(0);
    layer_phases<0>(lds, wave0);
    layer_phases<1>(lds, wave0);
    if (EN(13) && IN(15)) { const Frame F = load_frame(lds, wave0); norm_phase(F, 2, CTX, T, 0, F.G); }
#undef IN
#undef SEAM
}

#ifndef N_LAUNCHES
#define N_LAUNCHES 1
#endif
extern "C" void kernel_launch(void* const* d_in, const int* in_sizes, int n_in, void* d_out, int out_size, void* d_ws, size_t ws_size, hipStream_t stream) {
    static int grid = 0;
    if (grid == 0) {
        if (n_in != 24 || in_sizes[0] != SEQ * DM || out_size != SEQ * DM || ws_size < WS_END) {
            fprintf(stderr, "kernel_launch: unexpected shapes (n_in %d, in0 %d, out %d, ws %zu, need %zu); nothing launched\n", n_in, n_in > 0 ? in_sizes[0] : -1, out_size, ws_size, (size_t)WS_END); grid = -1; return; }
        int dev = 0, cus = 0;
        if (hipGetDevice(&dev) != hipSuccess || hipDeviceGetAttribute(&cus, hipDeviceAttributeMultiprocessorCount, dev) != hipSuccess) { grid = -1; return; }
        if (hipFuncSetAttribute((const void*)hybrid_fwd, hipFuncAttributeMaxDynamicSharedMemorySize, LDS_BYTES) != hipSuccess) { fprintf(stderr, "kernel_launch: hipFuncSetAttribute failed\n"); grid = -1; return; }
        int per_cu = 0;
        if (hipOccupancyMaxActiveBlocksPerMultiprocessor(&per_cu, (const void*)hybrid_fwd, NTHR, LDS_BYTES) != hipSuccess || per_cu < 1) { fprintf(stderr, "kernel_launch: occupancy query says %d\n", per_cu); }
        (void)hipGetLastError();
        grid = cus;
    }
    if (grid < 0) return;
    (void)hipMemsetAsync((char*)d_ws + WS_CTL, 0, CTL_BYTES + (size_t)2 * 2 * 12288 * 4, stream);
    Args a{};
    for (int i = 0; i < 24; ++i) a.in[i] = (const float*)d_in[i];
    a.out = (float*)d_out; a.ws = (unsigned char*)d_ws;
#ifndef MAX_PHASE
#define MAX_PHASE N_PHASES
#endif
    for (int li = 0; li < N_LAUNCHES && li < MAX_PHASE; ++li) {
        a.ph_lo = (N_LAUNCHES == 1) ? 0 : li; a.ph_hi = (N_LAUNCHES == 1) ? MAX_PHASE : li + 1;
        hipLaunchKernelGGL(hybrid_fwd, dim3(grid), dim3(NTHR), LDS_BYTES, stream, a);
    }
}
```
